# Optimizing an MI355X kernel written in HIP

```python
import math
import jax, jax.numpy as jnp
from jax import lax
import numpy as np


D_MODEL = 1024
BATCH = 8
SEQ = 8192
DEPTH = 1

PLE_DIM = 256
NSA_HEADS = 8
NSA_KV_GROUPS = 2
NSA_REP = NSA_HEADS // NSA_KV_GROUPS
NSA_DH = 64
NSA_WIDTH = NSA_HEADS * NSA_DH
NSA_KV = NSA_KV_GROUPS * NSA_DH
CMP_LEN = 32
CMP_STRIDE = 16
CMP_HIDDEN = 256
SEL_BLOCK = 64
TOP_N = 16
N_LOCAL = 2
WINDOW = 512
Q_BLOCK = 128
GLA_HEADS = 4
GLA_DK = 64
GLA_DV = 128
GLA_WIDTH = GLA_HEADS * GLA_DV
GLA_RANK = 16
GLA_TAU = 16.0
GLA_CHUNK = 64
MIX_WIDTH = NSA_WIDTH + GLA_WIDTH
NUM_BUCKETS = 32
MAX_DISTANCE = 128
ALPHA = (2.0 * DEPTH) ** 0.25
BETA = (8.0 * DEPTH) ** -0.25
EPS = 1e-5
NEG_INF = -1e30
POS_INF = 1e30
IN_WIDTHS = (NSA_WIDTH, NSA_KV, NSA_KV, NSA_KV, NSA_KV, NSA_KV, NSA_KV, 3 * NSA_HEADS, NSA_WIDTH,
             GLA_HEADS * GLA_DK, GLA_HEADS * GLA_DK, GLA_WIDTH, GLA_RANK, GLA_WIDTH)
IN_SPLIT_POINTS = tuple(int(v) for v in np.cumsum(IN_WIDTHS)[:-1])
D_IN = sum(IN_WIDTHS)

kernel_name = 'hymba_nsa_gla_deepnorm'


def layer_norm(x, g, b):
    xf = x.astype(jnp.float32)
    mu = jnp.mean(xf, axis=-1, keepdims=True)
    var = jnp.mean(jnp.square(xf - mu), axis=-1, keepdims=True)
    return (xf - mu) * lax.rsqrt(var + EPS) * g + b


def rms_norm(x, g):
    xf = x.astype(jnp.float32)
    return xf * lax.rsqrt(jnp.mean(jnp.square(xf), axis=-1, keepdims=True) + EPS) * g


def t5_bucket(dist):
    n = jnp.maximum(dist, 0)
    max_exact = NUM_BUCKETS // 2
    nf = jnp.maximum(n, 1).astype(jnp.float32)
    large = max_exact + (jnp.log(nf / max_exact) / math.log(MAX_DISTANCE / max_exact)
                         * (NUM_BUCKETS - max_exact)).astype(jnp.int32)
    large = jnp.minimum(large, NUM_BUCKETS - 1)
    return jnp.where(n < max_exact, n, large)


def compress_blocks(kv, pos, w1, b1, w2):
    B, S, G, DH = kv.shape
    ch = kv.transpose(0, 2, 1, 3).reshape(B, G, S // CMP_STRIDE, CMP_STRIDE, DH)
    blocks = jnp.concatenate([ch[:, :, :-1], ch[:, :, 1:]], axis=3) + pos
    nc = blocks.shape[2]
    h = jax.nn.gelu(blocks.reshape(B, G, nc, CMP_LEN * DH) @ w1 + b1)
    return h @ w2


def nsa_attention(q, kc, vc, ks, vs, kw, vw, gates, rel_bias):
    B, S = q.shape[0], q.shape[1]
    G, R, DH = NSA_KV_GROUPS, NSA_REP, NSA_DH
    qg = q.reshape(B, S, G, R, DH).transpose(0, 2, 3, 1, 4)
    nc = kc.shape[2]
    nsel = S // SEL_BLOCK
    top_n = min(TOP_N, nsel)
    ks_blk = ks.transpose(0, 2, 1, 3).reshape(B, G, nsel, SEL_BLOCK, DH)
    vs_blk = vs.transpose(0, 2, 1, 3).reshape(B, G, nsel, SEL_BLOCK, DH)
    pad = ((0, 0), (0, 0), (WINDOW, 0), (0, 0))
    kw_pad = jnp.pad(kw.transpose(0, 2, 1, 3), pad)
    vw_pad = jnp.pad(vw.transpose(0, 2, 1, 3), pad)
    rb = rel_bias.reshape(NUM_BUCKETS, G, R)
    scale = DH ** -0.5
    cmp_end = jnp.arange(nc) * CMP_STRIDE + CMP_LEN - 1
    c_start = jnp.arange(nc) * CMP_STRIDE
    b_start = jnp.arange(nsel) * SEL_BLOCK
    overlap = jnp.clip(jnp.minimum(c_start[:, None] + CMP_LEN, b_start[None, :] + SEL_BLOCK)
                       - jnp.maximum(c_start[:, None], b_start[None, :]), 0, None).astype(jnp.float32) / CMP_LEN
    c_win = jnp.arange(Q_BLOCK + WINDOW)
    dist_w = jnp.arange(Q_BLOCK)[:, None] + WINDOW - c_win[None, :]
    band = (dist_w >= 0) & (dist_w < WINDOW)
    bias_w = rb[t5_bucket(dist_w)].transpose(2, 3, 0, 1)
    blk = jnp.arange(nsel)
    g_idx = jnp.arange(G)[None, :, None, None]
    gather = jax.vmap(jax.vmap(lambda blocks, ix: blocks[ix]))

    def block(i):
        t0 = i * Q_BLOCK
        t = t0 + jnp.arange(Q_BLOCK)
        qb = lax.dynamic_slice_in_dim(qg, t0, Q_BLOCK, axis=3)
        valid_c = cmp_end[None, :] <= t[:, None]
        bias_c = rb[t5_bucket(t[:, None] - cmp_end[None, :])].transpose(2, 3, 0, 1)
        s_c = jnp.einsum('bgrqd,bgcd->bgrqc', qb, kc).astype(jnp.float32) * scale + bias_c
        p_c = jnp.where(valid_c, jax.nn.softmax(jnp.where(valid_c, s_c, NEG_INF), axis=-1), 0.0)
        o_c = jnp.einsum('bgrqc,bgcd->bgrqd', p_c, vc)
        imp = jnp.einsum('bgrqc,cn->bgqn', p_c, overlap)
        cur = (t // SEL_BLOCK)[:, None]
        causal_b = blk[None, :] <= cur
        forced = causal_b & ((blk[None, :] == 0) | (blk[None, :] >= cur - (N_LOCAL - 1)))
        imp = jnp.where(forced, POS_INF, jnp.where(causal_b, imp, NEG_INF))
        _, idx = lax.top_k(imp, top_n)
        k_sel = gather(ks_blk, idx).reshape(B, G, Q_BLOCK, top_n * SEL_BLOCK, DH)
        v_sel = gather(vs_blk, idx).reshape(B, G, Q_BLOCK, top_n * SEL_BLOCK, DH)
        pos = (idx[..., None] * SEL_BLOCK + jnp.arange(SEL_BLOCK)).reshape(B, G, Q_BLOCK, top_n * SEL_BLOCK)
        dist_s = t[:, None] - pos
        bias_s = jnp.moveaxis(rb[t5_bucket(dist_s), g_idx], -1, 2)
        s_s = jnp.einsum('bgrqd,bgqmd->bgrqm', qb, k_sel).astype(jnp.float32) * scale + bias_s
        p_s = jax.nn.softmax(jnp.where(dist_s[:, :, None] >= 0, s_s, NEG_INF), axis=-1)
        o_s = jnp.einsum('bgrqm,bgqmd->bgrqd', p_s, v_sel)
        kwb = lax.dynamic_slice_in_dim(kw_pad, t0, Q_BLOCK + WINDOW, axis=2)
        vwb = lax.dynamic_slice_in_dim(vw_pad, t0, Q_BLOCK + WINDOW, axis=2)
        valid_w = band & ((t0 - WINDOW + c_win) >= 0)[None, :]
        s_w = jnp.einsum('bgrqd,bgkd->bgrqk', qb, kwb).astype(jnp.float32) * scale + bias_w
        p_w = jax.nn.softmax(jnp.where(valid_w, s_w, NEG_INF), axis=-1)
        o_w = jnp.einsum('bgrqk,bgkd->bgrqd', p_w, vwb)
        gb = lax.dynamic_slice_in_dim(gates, t0, Q_BLOCK, axis=1)
        gb = gb.reshape(B, Q_BLOCK, G, R, 3).transpose(0, 2, 3, 1, 4)
        return gb[..., 0:1] * o_c + gb[..., 1:2] * o_s + gb[..., 2:3] * o_w

    out = lax.map(block, jnp.arange(S // Q_BLOCK))
    return out.transpose(1, 0, 4, 2, 3, 5).reshape(B, S, G * R * DH)


def gla_chunked(q, k, v, log_a):
    B, S, H, DK = q.shape
    DV = v.shape[-1]
    C = GLA_CHUNK
    N = S // C

    def to_chunks(a):
        return a.astype(jnp.float32).reshape(B, N, C, H, a.shape[-1]).transpose(0, 3, 1, 2, 4)

    q, k, v, log_a = to_chunks(q), to_chunks(k), to_chunks(v), to_chunks(log_a)
    b = jnp.cumsum(log_a, axis=3)
    b_last = b[:, :, :, -1:, :]
    q_e = q * (DK ** -0.5) * jnp.exp(b)
    k_e = k * jnp.exp(-b)
    k_last = k * jnp.exp(b_last - b)
    causal = jnp.tril(jnp.ones((C, C), dtype=bool))
    attn = jnp.where(causal, jnp.einsum('bhncd,bhnsd->bhncs', q_e, k_e), 0.0)
    o_intra = jnp.einsum('bhncs,bhnsv->bhncv', attn, v)
    kv = jnp.einsum('bhnsd,bhnsv->bhndv', k_last, v)
    decay = jnp.exp(b_last[:, :, :, 0, :])

    def step(state, inp):
        q_n, kv_n, d_n = inp
        o = jnp.einsum('bhcd,bhdv->bhcv', q_n, state)
        return d_n[..., None] * state + kv_n, o

    state0 = jnp.zeros((B, H, DK, DV), jnp.float32)
    _, o_inter = lax.scan(step, state0, (jnp.moveaxis(q_e, 2, 0), jnp.moveaxis(kv, 2, 0), jnp.moveaxis(decay, 2, 0)))
    o = o_intra + jnp.moveaxis(o_inter, 0, 2)
    return o.transpose(0, 2, 3, 1, 4).reshape(B, S, H, DV)


def hybrid_layer(x, p_l, rel_bias, w_in, w_a2, b_a, gla_norm_w, pos_cmp, w_ck1, b_ck1, w_ck2,
                 w_cv1, b_cv1, w_cv2, w_out, w_pe, w_pg, b_pg, ln_g, ln_b):
    B, S, _ = x.shape
    u = x @ w_in
    (q_n, kc_r, vc_r, ks_r, vs_r, kw_r, vw_r, g_n, z_n,
     q_g, k_g, v_g, a_low, z_g) = jnp.split(u, IN_SPLIT_POINTS, axis=-1)
    kvs = lambda a: a.reshape(B, S, NSA_KV_GROUPS, NSA_DH)
    kc = compress_blocks(kvs(kc_r), pos_cmp, w_ck1, b_ck1, w_ck2)
    vc = compress_blocks(kvs(vc_r), pos_cmp, w_cv1, b_cv1, w_cv2)
    gates = jax.nn.sigmoid(g_n.reshape(B, S, NSA_HEADS, 3))
    o_nsa = nsa_attention(q_n.reshape(B, S, NSA_HEADS, NSA_DH), kc, vc, kvs(ks_r), kvs(vs_r),
                          kvs(kw_r), kvs(vw_r), gates, rel_bias)
    o_nsa = o_nsa * jax.nn.silu(z_n)
    log_a = jax.nn.log_sigmoid((a_low @ w_a2 + b_a).astype(jnp.float32)) / GLA_TAU
    o_gla = gla_chunked(q_g.reshape(B, S, GLA_HEADS, GLA_DK), k_g.reshape(B, S, GLA_HEADS, GLA_DK),
                        v_g.reshape(B, S, GLA_HEADS, GLA_DV), log_a.reshape(B, S, GLA_HEADS, GLA_DK))
    o_gla = rms_norm(o_gla, gla_norm_w).reshape(B, S, GLA_WIDTH) * jax.nn.silu(z_g)
    y = jnp.concatenate([o_nsa, o_gla], axis=-1) @ w_out
    r = ALPHA * x + y
    r = r + jax.nn.sigmoid(r @ w_pg + b_pg) * (p_l @ w_pe)
    return layer_norm(r, ln_g, ln_b)


def setup_inputs(seed: int = 0) -> dict:
    key = jax.random.key(seed)
    ks = jax.random.split(key, 22)

    def nrm(k, shape, scale):
        return jax.random.normal(k, shape, jnp.float32) * scale

    return {
        'x': nrm(ks[0], (BATCH, SEQ, D_MODEL), 1.0),
        'p': nrm(ks[1], (DEPTH, BATCH, SEQ, PLE_DIM), 1.0),
        'ln0_g': 1.0 + nrm(ks[2], (D_MODEL,), 0.05),
        'ln0_b': nrm(ks[3], (D_MODEL,), 0.02),
        'rel_bias': nrm(ks[4], (NUM_BUCKETS, NSA_HEADS), 0.3),
        'w_in': nrm(ks[5], (DEPTH, D_MODEL, D_IN), D_MODEL ** -0.5),
        'w_a2': nrm(ks[6], (DEPTH, GLA_RANK, GLA_HEADS * GLA_DK), GLA_RANK ** -0.5),
        'b_a': nrm(ks[7], (DEPTH, GLA_HEADS * GLA_DK), 0.1),
        'gla_norm_w': 1.0 + nrm(ks[8], (DEPTH, GLA_DV), 0.05),
        'pos_cmp': nrm(ks[9], (DEPTH, CMP_LEN, NSA_DH), 0.1),
        'w_ck1': nrm(ks[10], (DEPTH, CMP_LEN * NSA_DH, CMP_HIDDEN), (CMP_LEN * NSA_DH) ** -0.5),
        'b_ck1': nrm(ks[11], (DEPTH, CMP_HIDDEN), 0.02),
        'w_ck2': nrm(ks[12], (DEPTH, CMP_HIDDEN, NSA_DH), CMP_HIDDEN ** -0.5),
        'w_cv1': nrm(ks[13], (DEPTH, CMP_LEN * NSA_DH, CMP_HIDDEN), (CMP_LEN * NSA_DH) ** -0.5),
        'b_cv1': nrm(ks[14], (DEPTH, CMP_HIDDEN), 0.02),
        'w_cv2': nrm(ks[15], (DEPTH, CMP_HIDDEN, NSA_DH), CMP_HIDDEN ** -0.5),
        'w_out': nrm(ks[16], (DEPTH, MIX_WIDTH, D_MODEL), MIX_WIDTH ** -0.5 * BETA),
        'w_pe': nrm(ks[17], (DEPTH, PLE_DIM, D_MODEL), PLE_DIM ** -0.5 * BETA),
        'w_pg': nrm(ks[18], (DEPTH, D_MODEL, D_MODEL), D_MODEL ** -0.5),
        'b_pg': nrm(ks[19], (DEPTH, D_MODEL), 0.02),
        'ln_g': 1.0 + nrm(ks[20], (DEPTH, D_MODEL), 0.05),
        'ln_b': nrm(ks[21], (DEPTH, D_MODEL), 0.02),
    }


def reference(x, p, ln0_g, ln0_b, rel_bias, w_in, w_a2, b_a, gla_norm_w, pos_cmp, w_ck1, b_ck1, w_ck2,
              w_cv1, b_cv1, w_cv2, w_out, w_pe, w_pg, b_pg, ln_g, ln_b):
    h = layer_norm(x, ln0_g, ln0_b)
    for i in range(DEPTH):
        h = hybrid_layer(h, p[i], rel_bias, w_in[i], w_a2[i], b_a[i], gla_norm_w[i], pos_cmp[i],
                         w_ck1[i], b_ck1[i], w_ck2[i], w_cv1[i], b_cv1[i], w_cv2[i], w_out[i],
                         w_pe[i], w_pg[i], b_pg[i], ln_g[i], ln_b[i])
    return h
```

```cpp
#include <hip/hip_runtime.h>
#include <hip/hip_bf16.h>
#include <cstdio>
#include <cstdint>
namespace pg8 {
#define PG8_LAS __attribute__((address_space(3)))
typedef unsigned short bf16_t;
typedef short bf16x8 __attribute__((ext_vector_type(8)));
typedef float f32x4 __attribute__((ext_vector_type(4)));
typedef unsigned u32x4 __attribute__((ext_vector_type(4)));
constexpr int BM = 256, BK = 64, HALF = 128, HTB = HALF * BK * 2  , STAGE_BYTES = 8 * HTB, NXCD = 8, WGM = 8;

__host__ __device__ __forceinline__ int lds_byte(int r, int c) { const int st = (r >> 4) * 2 + (c >> 5), rr = r & 15, cc = c & 31, ob = rr * 64 + cc * 2; return st * 1024 + (ob ^ (((ob >> 9) & 1) << 5)); }
__host__ __device__ __forceinline__ void stage_rc(int b, int& R, int& C) { const int st = b / 1024, sb = b % 1024, swz = sb ^ (((sb >> 9) & 1) << 5); R = (st >> 1) * 16 + swz / 64; C = (st & 1) * 32 + (swz % 64) / 2; }
__host__ __device__ __forceinline__ int perm32(int rho) { const int n = rho >> 4, i = rho & 15; return 8 * (i >> 2) + 4 * n + (i & 3); }

struct Unit { int pm, pn; };
struct Gemm { const bf16_t* A; const bf16_t* Bt; int M, N, K; };

struct StaticOrder {
    int nM, nN, nwg, G, c;
    __host__ __device__ void init(int M, int N, int G_, int c_) { nM = M / BM; nN = N / BM; nwg = nM * nN; G = G_; c = c_; }
    __host__ __device__ bool next(int i, Unit& u) const {
        const long L = (long)i * G + c; if (L >= nwg) return false;
        int wgid = (int)L; { const int q = nwg / NXCD, r = nwg % NXCD, xcd = wgid % NXCD, off = wgid / NXCD; wgid = (xcd < r ? xcd * (q + 1) : r * (q + 1) + (xcd - r) * q) + off; }
        const int nig = WGM * nN, gid = wgid / nig, fm = gid * WGM, gsz = (nM - fm) < WGM ? (nM - fm) : WGM;
        u.pm = fm + ((wgid % nig) % gsz); u.pn = (wgid % nig) / gsz; return true;
    }
    __device__ __forceinline__ void a_ready(const Unit&) const {}
    __device__ __forceinline__ void done(const Unit&) const {}
};
__device__ __forceinline__ unsigned cvt_pk_bf16(float lo, float hi) { unsigned r; asm volatile("v_cvt_pk_bf16_f32 %0, %1, %2" : "=v"(r) : "v"(lo), "v"(hi)); return r; }
struct EpiBf16 {
    static constexpr bool PERM = true, AFTER_DRAIN = false;
    bf16_t* O; int ldc;
    __device__ __forceinline__ void operator()(const f32x4 (&acc)[2][2][4][2], const Unit& u, int wr, int wc, int fr, int fq) const {
        const int row0 = u.pm * BM + wr * 64 + fr; const int col0 = u.pn * BM + wc * 32 + 8 * fq;
#pragma unroll
        for (int ai = 0; ai < 2; ++ai)
#pragma unroll
            for (int m = 0; m < 4; ++m) { bf16_t* rowp = O + (size_t)(row0 + ai * HALF + m * 16) * ldc + col0;
#pragma unroll
                for (int bj = 0; bj < 2; ++bj) { const f32x4 v0 = acc[ai][bj][m][0], v1 = acc[ai][bj][m][1];
                    u32x4 w; w.x = cvt_pk_bf16(v0[0], v0[1]); w.y = cvt_pk_bf16(v0[2], v0[3]); w.z = cvt_pk_bf16(v1[0], v1[1]); w.w = cvt_pk_bf16(v1[2], v1[3]);
                    *(u32x4*)(rowp + bj * HALF) = w; } }
    }
};
struct EpiResid {
    static constexpr bool PERM = true, AFTER_DRAIN = false;
    const float* x; const float* stats; const float* g; const float* b; float* out; bf16_t* rb; float alpha;
    __device__ __forceinline__ void operator()(const f32x4 (&acc)[2][2][4][2], const Unit& u, int wr, int wc, int fr, int fq) const {
        const int row0 = u.pm * BM + wr * 64 + fr; const int col0 = u.pn * BM + wc * 32 + 8 * fq;
        f32x4 gv[2][2], bv[2][2];
#pragma unroll
        for (int bj = 0; bj < 2; ++bj)
#pragma unroll
            for (int n = 0; n < 2; ++n) { gv[bj][n] = *(const f32x4*)(g + col0 + bj * HALF + 4 * n) * alpha; bv[bj][n] = *(const f32x4*)(b + col0 + bj * HALF + 4 * n) * alpha; }
#pragma unroll
        for (int ai = 0; ai < 2; ++ai)
#pragma unroll
            for (int m = 0; m < 4; ++m) { const int row = row0 + ai * HALF + m * 16; const size_t off = (size_t)row * 1024 + col0;
                const float mean = stats[2 * row], rstd = stats[2 * row + 1];
#pragma unroll
                for (int bj = 0; bj < 2; ++bj) {
                    const f32x4 x0 = *(const f32x4*)(x + off + bj * HALF), x1 = *(const f32x4*)(x + off + bj * HALF + 4);
                    const f32x4 v0 = ((x0 - mean) * rstd) * gv[bj][0] + bv[bj][0] + acc[ai][bj][m][0];
                    const f32x4 v1 = ((x1 - mean) * rstd) * gv[bj][1] + bv[bj][1] + acc[ai][bj][m][1];
                    *(f32x4*)(out + off + bj * HALF) = v0; *(f32x4*)(out + off + bj * HALF + 4) = v1;
                    u32x4 w; w.x = cvt_pk_bf16(v0[0], v0[1]); w.y = cvt_pk_bf16(v0[2], v0[3]); w.z = cvt_pk_bf16(v1[0], v1[1]); w.w = cvt_pk_bf16(v1[2], v1[3]);
                    *(u32x4*)(rb + off + bj * HALF) = w; } }
    }
};
__device__ __forceinline__ float bf_lo(unsigned w) { return __uint_as_float(w << 16); }
__device__ __forceinline__ float bf_hi(unsigned w) { return __uint_as_float(w & 0xffff0000u); }
__device__ __forceinline__ float sigmoidf_(float v) { return __builtin_amdgcn_rcpf(1.0f + __builtin_amdgcn_exp2f(-1.4426950408889634f * v)); }
struct EpiGate {
    static constexpr bool PERM = true, AFTER_DRAIN = false;
    float* out; const bf16_t* E; const float* bias;
    __device__ __forceinline__ void operator()(const f32x4 (&acc)[2][2][4][2], const Unit& u, int wr, int wc, int fr, int fq) const {
        const int row0 = u.pm * BM + wr * 64 + fr; const int col0 = u.pn * BM + wc * 32 + 8 * fq;
        f32x4 bv[2][2];
#pragma unroll
        for (int bj = 0; bj < 2; ++bj)
#pragma unroll
            for (int n = 0; n < 2; ++n) bv[bj][n] = *(const f32x4*)(bias + col0 + bj * HALF + 4 * n);
#pragma unroll
        for (int ai = 0; ai < 2; ++ai)
#pragma unroll
            for (int m = 0; m < 4; ++m) { const int row = row0 + ai * HALF + m * 16; const size_t off = (size_t)row * 1024 + col0;
#pragma unroll
                for (int bj = 0; bj < 2; ++bj) {
                    const f32x4 r0 = *(const f32x4*)(out + off + bj * HALF), r1 = *(const f32x4*)(out + off + bj * HALF + 4);
                    const u32x4 e = *(const u32x4*)(E + off + bj * HALF);
                    const f32x4 a0 = acc[ai][bj][m][0] + bv[bj][0], a1 = acc[ai][bj][m][1] + bv[bj][1];
                    f32x4 v0, v1;
                    v0[0] = r0[0] + sigmoidf_(a0[0]) * bf_lo(e.x); v0[1] = r0[1] + sigmoidf_(a0[1]) * bf_hi(e.x);
                    v0[2] = r0[2] + sigmoidf_(a0[2]) * bf_lo(e.y); v0[3] = r0[3] + sigmoidf_(a0[3]) * bf_hi(e.y);
                    v1[0] = r1[0] + sigmoidf_(a1[0]) * bf_lo(e.z); v1[1] = r1[1] + sigmoidf_(a1[1]) * bf_hi(e.z);
                    v1[2] = r1[2] + sigmoidf_(a1[2]) * bf_lo(e.w); v1[3] = r1[3] + sigmoidf_(a1[3]) * bf_hi(e.w);
                    *(f32x4*)(out + off + bj * HALF) = v0; *(f32x4*)(out + off + bj * HALF + 4) = v1; } }
    }
};
template <class Epi, class Sched, bool ALIGN_EPI = false, bool SP2 = false>
__device__ __forceinline__ void gemm_phase(PG8_LAS unsigned char* lds, const Gemm g, const Sched& S, const Epi& E) {
    const int tid = threadIdx.x, wid = __builtin_amdgcn_readfirstlane(tid >> 6), lane = tid & 63, wr = wid >> 2, wc = wid & 3, fr = lane & 15, fq = lane >> 4;
    const int K = g.K, nt = K / BK;
    unsigned voffA[2], voffB[2];
#pragma unroll
    for (int i = 0; i < 2; ++i) { int R, C; stage_rc(tid * 16 + i * 8192, R, C); const int Rb = Epi::PERM ? ((R & ~31) + perm32(R & 31)) : R;
        voffA[i] = (unsigned)(R * K + C) * 2u; voffB[i] = (unsigned)(Rb * K + C) * 2u; }
    const size_t kstep = (size_t)(BK * 2);
    const size_t hstep = (size_t)HALF * K * 2;
    const size_t tstep = 2 * hstep;
    const unsigned ldsw = (unsigned)wid * 1024u;
    const int aoff = lds_byte(wr * 64 + fr, fq * 8), boff = lds_byte(wc * 32 + fr, fq * 8);
#define PG8_SA(b, h) (((b) * 2 + (h)) * HTB)
#define PG8_SB(b, h) ((4 + (b) * 2 + (h)) * HTB)
#define PG8_STAGE(bufoff, gbase, voff) do { _Pragma("unroll") for (int _i = 0; _i < 2; ++_i) \
        __builtin_amdgcn_global_load_lds((const unsigned*)((const char*)(gbase) + (voff)[_i]), (PG8_LAS unsigned*)(lds + (bufoff) + ldsw + _i * 8192), 16, 0, 0); } while (0)
#define PG8_LDA(dst, b, h) do { _Pragma("unroll") for (int m = 0; m < 4; ++m) _Pragma("unroll") for (int k = 0; k < 2; ++k) dst[m][k] = *(const PG8_LAS bf16x8*)(lds + PG8_SA(b, h) + aoff + m * 2048 + k * 1024); } while (0)
#define PG8_LDB(dst, b, h) do { _Pragma("unroll") for (int n = 0; n < 2; ++n) _Pragma("unroll") for (int k = 0; k < 2; ++k) dst[n][k] = *(const PG8_LAS bf16x8*)(lds + PG8_SB(b, h) + boff + n * 2048 + k * 1024); } while (0)
#define PG8_MMA(ai, bj, At, Bt) do { __builtin_amdgcn_s_setprio(1); _Pragma("unroll") for (int m = 0; m < 4; ++m) _Pragma("unroll") for (int n = 0; n < 2; ++n) _Pragma("unroll") for (int k = 0; k < 2; ++k) \
        acc[ai][bj][m][n] = __builtin_amdgcn_mfma_f32_16x16x32_bf16(Bt[n][k], At[m][k], acc[ai][bj][m][n], 0, 0, 0); __builtin_amdgcn_s_setprio(0); } while (0)
#define PG8_WAIT_V(n) asm volatile("s_waitcnt vmcnt(" #n ")" ::: "memory")
#define PG8_WAIT_L(n) asm volatile("s_waitcnt lgkmcnt(" #n ")" ::: "memory")
#define PG8_BAR __builtin_amdgcn_s_barrier()
#define PG8_SCHED __builtin_amdgcn_sched_barrier(0)
    Unit cur, nxt; int ui = 0;
    if (!S.next(0, cur)) return;
    f32x4 acc[2][2][4][2];
#pragma unroll
    for (int a = 0; a < 2; ++a)
#pragma unroll
        for (int b = 0; b < 2; ++b)
#pragma unroll
            for (int m = 0; m < 4; ++m)
#pragma unroll
                for (int n = 0; n < 2; ++n) acc[a][b][m][n] = (f32x4){0.f, 0.f, 0.f, 0.f};
    bf16x8 At[4][2], B0[2][2], B1[2][2];
    const char* cA = (const char*)g.A + (size_t)cur.pm * tstep; const char* cB = (const char*)g.Bt + (size_t)cur.pn * tstep;
    S.a_ready(cur);
    if constexpr (SP2) {
        PG8_STAGE(PG8_SB(0, 0), cB, voffB); PG8_STAGE(PG8_SB(0, 1), cB + hstep, voffB); PG8_STAGE(PG8_SA(0, 0), cA, voffA); PG8_STAGE(PG8_SA(0, 1), cA + hstep, voffA);
        if (wr == 1) PG8_BAR;
        PG8_WAIT_V(2); PG8_BAR;
        PG8_STAGE(PG8_SB(1, 0), cB + kstep, voffB); PG8_STAGE(PG8_SA(1, 0), cA + kstep, voffA); PG8_STAGE(PG8_SB(1, 1), cB + hstep + kstep, voffB);
        PG8_WAIT_V(6); PG8_BAR;
    } else {
        PG8_STAGE(PG8_SB(0, 0), cB, voffB); PG8_STAGE(PG8_SA(0, 0), cA, voffA); PG8_STAGE(PG8_SB(0, 1), cB + hstep, voffB); PG8_STAGE(PG8_SA(0, 1), cA + hstep, voffA);
        if (wr == 1) PG8_BAR;
        PG8_WAIT_V(4); PG8_BAR;
        PG8_STAGE(PG8_SB(1, 0), cB + kstep, voffB); PG8_STAGE(PG8_SA(1, 0), cA + kstep, voffA); PG8_STAGE(PG8_SB(1, 1), cB + hstep + kstep, voffB);
        PG8_WAIT_V(6); PG8_BAR;
    }
    for (;;) {
        const bool has_next = S.next(ui + 1, nxt);
        const char* nA = has_next ? (const char*)g.A + (size_t)nxt.pm * tstep : cA; const char* nB = has_next ? (const char*)g.Bt + (size_t)nxt.pn * tstep : cB;
        for (int t = 0; t < nt; t += 2) {
            const bool last = (t == nt - 2);
            const char* a1 = cA + (size_t)(t + 1) * kstep;
            const char* a2 = last ? nA : cA + (size_t)(t + 2) * kstep; const char* b2 = last ? nB : cB + (size_t)(t + 2) * kstep;
            const char* a3 = a2 + kstep; const char* b3 = b2 + kstep;
            if (last && has_next) S.a_ready(nxt);
            if constexpr (SP2) {
            PG8_LDB(B0, 0, 0); PG8_LDB(B1, 0, 1); PG8_SCHED; PG8_LDA(At, 0, 0); PG8_STAGE(PG8_SA(1, 1), a1 + hstep, voffA);
            PG8_WAIT_V(8); PG8_WAIT_L(0); PG8_BAR; PG8_MMA(0, 0, At, B0); PG8_MMA(0, 1, At, B1); PG8_BAR; PG8_SCHED;
            PG8_LDA(At, 0, 1); PG8_STAGE(PG8_SB(0, 0), b2, voffB); PG8_STAGE(PG8_SB(0, 1), b2 + hstep, voffB); PG8_STAGE(PG8_SA(0, 0), a2, voffA);
            PG8_WAIT_V(8); PG8_WAIT_L(0); PG8_BAR; PG8_MMA(1, 0, At, B0); PG8_MMA(1, 1, At, B1); PG8_BAR; PG8_SCHED;
            PG8_LDB(B0, 1, 0); PG8_LDB(B1, 1, 1); PG8_SCHED; PG8_LDA(At, 1, 0); PG8_STAGE(PG8_SA(0, 1), a2 + hstep, voffA);
            PG8_WAIT_V(8); PG8_WAIT_L(0); PG8_BAR; PG8_MMA(0, 0, At, B0); PG8_MMA(0, 1, At, B1); PG8_BAR; PG8_SCHED;
            PG8_LDA(At, 1, 1); PG8_STAGE(PG8_SB(1, 0), b3, voffB); PG8_STAGE(PG8_SB(1, 1), b3 + hstep, voffB); PG8_STAGE(PG8_SA(1, 0), a3, voffA);
            PG8_WAIT_V(8); PG8_WAIT_L(0); PG8_BAR; PG8_MMA(1, 0, At, B0); PG8_MMA(1, 1, At, B1); PG8_BAR; PG8_SCHED;
            } else {
            PG8_LDB(B0, 0, 0); PG8_SCHED; PG8_LDA(At, 0, 0); PG8_STAGE(PG8_SA(1, 1), a1 + hstep, voffA);
            PG8_WAIT_L(8); PG8_BAR; PG8_WAIT_L(0); PG8_MMA(0, 0, At, B0); PG8_BAR; PG8_SCHED;
            PG8_LDB(B1, 0, 1); PG8_STAGE(PG8_SB(0, 0), b2, voffB);
            PG8_BAR; PG8_WAIT_L(0); PG8_MMA(0, 1, At, B1); PG8_BAR;
            PG8_LDA(At, 0, 1); PG8_STAGE(PG8_SA(0, 0), a2, voffA);
            PG8_BAR; PG8_WAIT_L(0); PG8_MMA(1, 0, At, B0); PG8_BAR; PG8_SCHED;
            PG8_STAGE(PG8_SB(0, 1), b2 + hstep, voffB);
            PG8_WAIT_V(6); PG8_BAR; PG8_MMA(1, 1, At, B1); PG8_BAR;
            PG8_LDB(B0, 1, 0); PG8_SCHED; PG8_LDA(At, 1, 0); PG8_STAGE(PG8_SA(0, 1), a2 + hstep, voffA);
            PG8_WAIT_L(8); PG8_BAR; PG8_WAIT_L(0); PG8_MMA(0, 0, At, B0); PG8_BAR; PG8_SCHED;
            PG8_LDB(B1, 1, 1); PG8_STAGE(PG8_SB(1, 0), b3, voffB);
            PG8_BAR; PG8_WAIT_L(0); PG8_MMA(0, 1, At, B1); PG8_BAR;
            PG8_LDA(At, 1, 1); PG8_STAGE(PG8_SA(1, 0), a3, voffA);
            PG8_BAR; PG8_WAIT_L(0); PG8_MMA(1, 0, At, B0); PG8_BAR; PG8_SCHED;
            PG8_STAGE(PG8_SB(1, 1), b3 + hstep, voffB);
            PG8_WAIT_V(6); PG8_BAR; PG8_MMA(1, 1, At, B1); PG8_BAR;
            }
        }
        if constexpr (ALIGN_EPI) { if (wr == 0) PG8_BAR; }
        if constexpr (!Epi::AFTER_DRAIN) { E(acc, cur, wr, wc, fr, fq); S.done(cur); }
        if (!has_next) break;
#pragma unroll
        for (int a = 0; a < 2; ++a)
#pragma unroll
            for (int b = 0; b < 2; ++b)
#pragma unroll
                for (int m = 0; m < 4; ++m)
#pragma unroll
                    for (int n = 0; n < 2; ++n) acc[a][b][m][n] = (f32x4){0.f, 0.f, 0.f, 0.f};
        cur = nxt; cA = nA; cB = nB; ++ui;
        if constexpr (ALIGN_EPI) { if (wr == 1) PG8_BAR; }
    }
    PG8_WAIT_V(0);
    if constexpr (!ALIGN_EPI) { if (wr == 0) PG8_BAR; }
    PG8_BAR;
    if constexpr (Epi::AFTER_DRAIN) { E.fused(acc, cur, wr, wc, fr, fq, lds, wid, lane); S.done(cur); }
#undef PG8_SA
#undef PG8_SB
#undef PG8_STAGE
#undef PG8_LDA
#undef PG8_LDB
#undef PG8_MMA
#undef PG8_WAIT_V
#undef PG8_WAIT_L
#undef PG8_BAR
#undef PG8_SCHED
}
}
constexpr int NWAVES = 8;
#ifndef MK_N_LAUNCHES
#define MK_N_LAUNCHES 1
#endif
constexpr int BATCH = 8, SEQ = 8192, DM = 1024, M = BATCH * SEQ;
constexpr int PLE = 256, DIN = 3368, DINP = 3584;
constexpr int NSA_H = 8, NSA_G = 2, NSA_R = 4, DH = 64, NC = 511, NCP = 512;
constexpr int CMPH = 256, CMPK = 2048;
constexpr int GLA_H = 4, GDK = 64, GDV = 128, GRANK = 16, GCH = 64, NCHUNK = SEQ / GCH;
constexpr int C_QN = 0, C_KC = 512, C_VC = 640, C_KS = 768, C_VS = 896, C_KW = 1024, C_VW = 1152, C_GN = 1280, C_ZN = 1304,
              C_QG = 1816, C_KG = 2072, C_VG = 2328, C_AL = 2840, C_ZG = 2856;
constexpr float LN_EPS = 1e-5f;
constexpr float ALPHA_ = 1.189207115002721f;
constexpr float LOG2E = 1.4426950408889634f;

constexpr size_t MiB = 1u << 20;
constexpr size_t WS_CTL = 0, CTL_ZERO_BYTES = 1 * MiB;
constexpr size_t WS_WIN = 1 * MiB;
constexpr size_t WS_WOUT = 8 * MiB, WS_WPG = 10 * MiB;
constexpr size_t WS_WPE = 12 * MiB;
constexpr size_t WS_WCK1 = 13 * MiB, WS_WCV1 = 14 * MiB;
constexpr size_t WS_SMALL = 15 * MiB;
constexpr size_t SM_WCK2 = 0, SM_WCV2 = 32768, SM_WA2 = 65536, SM_CB1K = 73728, SM_CB1V = 74752;
constexpr size_t WS_STATS = 16 * MiB;
constexpr size_t WS_KC = 17 * MiB, WS_VC = 18 * MiB;
constexpr size_t WS_DEC = 19 * MiB;
constexpr size_t WS_XN = 20 * MiB;
constexpr size_t WS_MIX = WS_XN;
constexpr size_t WS_PB = 148 * MiB;
constexpr size_t WS_U = 180 * MiB;
constexpr size_t WS_EB = WS_U;
constexpr size_t WS_OW = 629 * MiB;
constexpr size_t WS_QE = 693 * MiB;
constexpr size_t WS_KV = 725 * MiB;
constexpr size_t WS_RB = WS_KV;
constexpr size_t WS_OI = 853 * MiB;
constexpr size_t WS_VST = 917 * MiB;
constexpr size_t WS_PARK = 933 * MiB;
constexpr size_t WS_END = 965 * MiB;
constexpr int CW_BAR = 4096;

constexpr int RING_OFF = 0, RING_BYTES = 155648;
constexpr int LDSCTL_OFF = RING_BYTES, MISC_OFF = LDSCTL_OFF + 320;
constexpr int LDS_BYTES = 163840;

#define GAS __attribute__((address_space(1)))
#define LAS __attribute__((address_space(3)))
typedef unsigned short bf16;
typedef unsigned v4u __attribute__((ext_vector_type(4)));
typedef unsigned v2u __attribute__((ext_vector_type(2)));
typedef float f32x4 __attribute__((ext_vector_type(4)));
typedef float f32x16 __attribute__((ext_vector_type(16)));
typedef short bf16x8 __attribute__((ext_vector_type(8)));
typedef GAS unsigned gu32;
#define RLX_AGENT __ATOMIC_RELAXED, __HIP_MEMORY_SCOPE_AGENT
#define LDS_WAIT() asm volatile("s_waitcnt lgkmcnt(0)" ::: "memory")
#define VM_WAIT() asm volatile("s_waitcnt vmcnt(0)" ::: "memory")
__device__ __forceinline__ unsigned f2bf(float f) { unsigned u = __builtin_bit_cast(unsigned, f); return (u + 0x7fffu + ((u >> 16) & 1u)) >> 16; }
__device__ __forceinline__ unsigned pk2(float lo, float hi) { return f2bf(lo) | (f2bf(hi) << 16); }
__device__ __forceinline__ float bflo(unsigned w) { return __uint_as_float(w << 16); }
__device__ __forceinline__ float bfhi(unsigned w) { return __uint_as_float(w & 0xffff0000u); }
__device__ __forceinline__ float sigmoidf2(float v) { return __builtin_amdgcn_rcpf(1.0f + __builtin_amdgcn_exp2f(-1.4426950408889634f * v)); }
#define XB_TMO      128
#define XB_XCNT(j)  (256  + 64 * (j))
#define XB_XSUB(j)  (1280 + 64 * (j))
#define XB_XGEN(j)  (2304 + 64 * (j))
#define XB_TOP      3328
#define XB_TOPGEN   3392
#define XCD_BAR_WORDS 3456
#define XB_SPIN_CAP (1u << 18)

__device__ __forceinline__ unsigned xb_ld(unsigned* p)              { return __hip_atomic_load(p, __ATOMIC_RELAXED, __HIP_MEMORY_SCOPE_AGENT); }
__device__ __forceinline__ unsigned xb_add(unsigned* p, unsigned v) { return __hip_atomic_fetch_add(p, v, __ATOMIC_RELAXED, __HIP_MEMORY_SCOPE_AGENT); }
__device__ __forceinline__ unsigned xb_xcc_id() { return (unsigned)__builtin_amdgcn_s_getreg((3 << 11) | 20) & 0xFu; }
#define XB_SPIN(cond, bar) do { unsigned _sp = 0; while (cond) { __builtin_amdgcn_s_sleep(1); \
    if ((++_sp & 255u) == 0u) { if (xb_ld(&(bar)[XB_TMO])) break; if (_sp > XB_SPIN_CAP) { atomicAdd(&(bar)[XB_TMO], 1u); break; } } } } while (0)

struct XcdBarrier {
    unsigned* bar; unsigned x;
    volatile LAS unsigned* st;
};

__device__ __forceinline__ XcdBarrier xcd_barrier_post(unsigned* bar, volatile LAS unsigned* st) {
    XcdBarrier b; b.bar = bar; b.x = xb_xcc_id(); b.st = st;
    if (threadIdx.x == 0) (void)xb_add(&bar[XB_XCNT(b.x)], 1u);
    return b;
}
__device__ __forceinline__ void xcd_barrier_complete(unsigned* bar, unsigned x, unsigned& nloc, unsigned& nx) {
    const unsigned G = gridDim.x * gridDim.y * gridDim.z;
    unsigned sum, cnt, mine, sp = 0u;
    for (;;) {
        sum = 0u; cnt = 0u; mine = 0u;
#pragma unroll
        for (unsigned j = 0; j < 16; ++j) { const unsigned c = xb_ld(&bar[XB_XCNT(j)]); sum += c; cnt += (c > 0u) ? 1u : 0u; mine = (j == x) ? c : mine; }
        if (sum == G) break;
        __builtin_amdgcn_s_sleep(1);
        if ((++sp & 255u) == 0u) { if (xb_ld(&bar[XB_TMO])) break; if (sp > XB_SPIN_CAP) { atomicAdd(&bar[XB_TMO], 1u); break; } }
    }
    nloc = mine > 0u ? mine : 1u; nx = cnt > 0u ? cnt : 1u;
}

__device__ __forceinline__ void xcd_barrier(const XcdBarrier& b) {
    asm volatile("s_waitcnt vmcnt(0)" ::: "memory");
    __syncthreads();
    if (threadIdx.x == 0) {
        unsigned* bar = b.bar;
        __builtin_amdgcn_s_waitcnt(0);
        unsigned nloc = b.st[0], nx = b.st[1];
        if (nloc == 0u) { xcd_barrier_complete(bar, b.x, nloc, nx); b.st[0] = nloc; b.st[1] = nx; }
        const unsigned old = xb_add(&bar[XB_XSUB(b.x)], 1u);
        const unsigned gen = old / nloc;
        if (old + 1u == (gen + 1u) * nloc) {
            __builtin_amdgcn_fence(__ATOMIC_RELEASE, "agent");
            asm volatile("s_waitcnt vmcnt(0)" ::: "memory");
            const unsigned og = xb_add(&bar[XB_TOP], 1u);
            const unsigned tg = og / nx;
            if (og + 1u == (tg + 1u) * nx) xb_add(&bar[XB_TOPGEN], 1u);
            else XB_SPIN(xb_ld(&bar[XB_TOPGEN]) == tg, bar);
            __builtin_amdgcn_fence(__ATOMIC_ACQUIRE, "agent");
            xb_add(&bar[XB_XGEN(b.x)], 1u);
            asm volatile("s_waitcnt vmcnt(0)" ::: "memory");
        } else {
            XB_SPIN(xb_ld(&bar[XB_XGEN(b.x)]) == gen, bar);
            __builtin_amdgcn_fence(__ATOMIC_ACQUIRE, "agent");
            asm volatile("s_waitcnt vmcnt(0)" ::: "memory");
        }
    }
    __syncthreads();
}
struct Frame {
    LAS unsigned char* lds;
    volatile LAS unsigned* MISC;
    gu32* ctl;
    int tid, lane, wave;
    int vcu, G;
    float* out; unsigned char* ws;
};
enum { I_X = 0, I_P, I_LN0G, I_LN0B, I_RELB, I_WIN, I_WA2, I_BA, I_GNW, I_POS, I_WCK1, I_BCK1, I_WCK2, I_WCV1, I_BCV1, I_WCV2, I_WOUT, I_WPE, I_WPG, I_BPG, I_LNG, I_LNB };

__device__ __forceinline__ float wave_sum(float v) {
#pragma unroll
    for (int o = 1; o < 64; o <<= 1) v += __shfl_xor(v, o);
    return v;
}
__device__ __forceinline__ void p0_transpose_item(const float* W, int K, int N, int nblk, bf16* WT, LAS float* scr, int item, int lane) {
    const int kb = item / nblk, nb = item % nblk, k0 = 64 * kb, n0 = 32 * nb;
    const int nn = n0 + (lane & 31);
#pragma unroll 8
    for (int i = 0; i < 32; ++i) { const int kk = 2 * i + (lane >> 5); scr[kk * 33 + (lane & 31)] = (nn < N) ? W[(size_t)(k0 + kk) * N + nn] : 0.f; }
    LDS_WAIT(); asm volatile("" ::: "memory");
    const int c = lane & 7;
#pragma unroll
    for (int j = 0; j < 4; ++j) { const int n = (lane >> 3) + 8 * j; const LAS float* s = scr + (8 * c) * 33 + n;
        v4u o; o.x = pk2(s[0 * 33], s[1 * 33]); o.y = pk2(s[2 * 33], s[3 * 33]); o.z = pk2(s[4 * 33], s[5 * 33]); o.w = pk2(s[6 * 33], s[7 * 33]);
        *(v4u*)(WT + (size_t)(n0 + n) * K + k0 + 8 * c) = o; }
    LDS_WAIT(); asm volatile("" ::: "memory");
}
__device__ __forceinline__ void ln0_row(const float* xrow, const float* g, const float* b, bf16* orow, float* st, int lane) {
    const f32x4* xr = (const f32x4*)xrow + lane;
    f32x4 v[4]; float s = 0.f;
#pragma unroll
    for (int j = 0; j < 4; ++j) { v[j] = xr[64 * j]; s += (v[j].x + v[j].y) + (v[j].z + v[j].w); }
    const float mean = wave_sum(s) * (1.f / DM); float s2 = 0.f;
#pragma unroll
    for (int j = 0; j < 4; ++j) { v[j] = v[j] - mean; s2 += (v[j].x * v[j].x + v[j].y * v[j].y) + (v[j].z * v[j].z + v[j].w * v[j].w); }
    const float rstd = 1.f / sqrtf(wave_sum(s2) * (1.f / DM) + LN_EPS);
    if (lane == 0) { st[0] = mean; st[1] = rstd; }
    unsigned long long* o8 = (unsigned long long*)orow + lane;
#pragma unroll
    for (int j = 0; j < 4; ++j) { const f32x4 gg = ((const f32x4*)g)[lane + 64 * j], bb = ((const f32x4*)b)[lane + 64 * j]; const f32x4 y = v[j] * rstd * gg + bb;
        o8[64 * j] = (unsigned long long)pk2(y.x, y.y) | ((unsigned long long)pk2(y.z, y.w) << 32); }
}
template <class AT> __device__ __forceinline__ void p0_prologue(Frame& F, const AT& A) {
    LAS float* scr = (LAS float*)(F.lds + RING_OFF + F.wave * 16384);
    const int gw = F.vcu * NWAVES + F.wave, NGW = F.G * NWAVES;
    unsigned char* ws = F.ws;
    constexpr int I_IN = (DM / 64) * (DINP / 32), I_SQ = (DM / 64) * (DM / 32), I_PE = (PLE / 64) * (DM / 32), I_C1 = (CMPK / 64) * (CMPH / 32), I_C2 = (CMPH / 64) * (DH / 32);
    constexpr int NITEMS = I_IN + 2 * I_SQ + I_PE + 2 * I_C1 + 2 * I_C2;
    for (int it = gw; it < NITEMS; it += NGW) {
        int r = it;
        if (r < I_IN) { p0_transpose_item(A.in[I_WIN], DM, DIN, DINP / 32, (bf16*)(ws + WS_WIN), scr, r, F.lane); continue; } r -= I_IN;
        if (r < I_SQ) { p0_transpose_item(A.in[I_WOUT], DM, DM, DM / 32, (bf16*)(ws + WS_WOUT), scr, r, F.lane); continue; } r -= I_SQ;
        if (r < I_SQ) { p0_transpose_item(A.in[I_WPG], DM, DM, DM / 32, (bf16*)(ws + WS_WPG), scr, r, F.lane); continue; } r -= I_SQ;
        if (r < I_PE) { p0_transpose_item(A.in[I_WPE], PLE, DM, DM / 32, (bf16*)(ws + WS_WPE), scr, r, F.lane); continue; } r -= I_PE;
        if (r < I_C1) { p0_transpose_item(A.in[I_WCK1], CMPK, CMPH, CMPH / 32, (bf16*)(ws + WS_WCK1), scr, r, F.lane); continue; } r -= I_C1;
        if (r < I_C1) { p0_transpose_item(A.in[I_WCV1], CMPK, CMPH, CMPH / 32, (bf16*)(ws + WS_WCV1), scr, r, F.lane); continue; } r -= I_C1;
        if (r < I_C2) { p0_transpose_item(A.in[I_WCK2], CMPH, DH, DH / 32, (bf16*)(ws + WS_SMALL + SM_WCK2), scr, r, F.lane); continue; } r -= I_C2;
        p0_transpose_item(A.in[I_WCV2], CMPH, DH, DH / 32, (bf16*)(ws + WS_SMALL + SM_WCV2), scr, r, F.lane);
    }
    { const int gt = gw * 64 + F.lane; if (gt < 256 * 16) { const int n = gt >> 4, k = gt & 15; ((bf16*)(ws + WS_SMALL + SM_WA2))[gt] = (bf16)f2bf(A.in[I_WA2][k * 256 + n]); } }
    { const int w2 = NGW - 1 - gw; if (w2 >= 0 && w2 < 512) { const int which = w2 >> 8, hcol = w2 & 255; const float* W1 = A.in[which ? I_WCV1 : I_WCK1]; const float* pos = A.in[I_POS];
        float s = 0.f;
        for (int k = F.lane; k < CMPK; k += 64) s += pos[k] * W1[(size_t)k * CMPH + hcol];
        s = wave_sum(s);
        if (F.lane == 0) ((float*)(ws + WS_SMALL + (which ? SM_CB1V : SM_CB1K)))[hcol] = s + A.in[which ? I_BCV1 : I_BCK1][hcol]; } }
    for (int m = gw; m < M; m += NGW) ln0_row(A.in[I_X] + (size_t)m * DM, A.in[I_LN0G], A.in[I_LN0B], (bf16*)(ws + WS_XN) + (size_t)m * DM, (float*)(ws + WS_STATS) + 2 * m, F.lane);
    { const f32x4* ps = (const f32x4*)A.in[I_P]; v2u* pd = (v2u*)(ws + WS_PB); const size_t n4 = (size_t)M * PLE / 4;
      for (size_t i = (size_t)gw * 64 + F.lane; i < n4; i += (size_t)NGW * 64) { const f32x4 v = ps[i]; v2u o; o.x = pk2(v.x, v.y); o.y = pk2(v.z, v.w); pd[i] = o; } }
}
__device__ __forceinline__ void final_ln(Frame& F, const float* g, const float* b) {
    const int gw = F.vcu * NWAVES + F.wave, NGW = F.G * NWAVES; const int lane = F.lane;
    for (int m = gw; m < M; m += NGW) {
        f32x4* xr = (f32x4*)(F.out + (size_t)m * DM) + lane;
        f32x4 v[4]; float s = 0.f;
#pragma unroll
        for (int j = 0; j < 4; ++j) { v[j] = xr[64 * j]; s += (v[j].x + v[j].y) + (v[j].z + v[j].w); }
        const float mean = wave_sum(s) * (1.f / DM); float s2 = 0.f;
#pragma unroll
        for (int j = 0; j < 4; ++j) { v[j] = v[j] - mean; s2 += (v[j].x * v[j].x + v[j].y * v[j].y) + (v[j].z * v[j].z + v[j].w * v[j].w); }
        const float rstd = 1.f / sqrtf(wave_sum(s2) * (1.f / DM) + LN_EPS);
#pragma unroll
        for (int j = 0; j < 4; ++j) { const f32x4 gg = ((const f32x4*)g)[lane + 64 * j], bb = ((const f32x4*)b)[lane + 64 * j]; xr[64 * j] = v[j] * rstd * gg + bb; }
    }
}
typedef short v4i16_t __attribute__((ext_vector_type(4)));
#define MFMA32(a, b, c) __builtin_amdgcn_mfma_f32_32x32x16_bf16(a, b, c, 0, 0, 0)
__device__ __forceinline__ int crow(int r, int hi) { return (r & 3) + 8 * (r >> 2) + 4 * hi; }
__device__ __forceinline__ unsigned cvtpk(float lo, float hi) { typedef float f2_t __attribute__((ext_vector_type(2))); typedef __bf16 b2_t __attribute__((ext_vector_type(2)));
    f2_t v = {lo, hi}; b2_t b = __builtin_convertvector(v, b2_t); return __builtin_bit_cast(unsigned, b); }
__device__ __forceinline__ bf16x8 pack8(float a0, float a1, float a2, float a3, float a4, float a5, float a6, float a7) {
    v4u w; w.x = cvtpk(a0, a1); w.y = cvtpk(a2, a3); w.z = cvtpk(a4, a5); w.w = cvtpk(a6, a7); return __builtin_bit_cast(bf16x8, w); }
__device__ __forceinline__ bf16x8 pack8r(const f32x16& p, int base) { return pack8(p[base], p[base + 1], p[base + 2], p[base + 3], p[base + 4], p[base + 5], p[base + 6], p[base + 7]); }
__device__ __forceinline__ v4i16_t vtr(const LAS unsigned char* p) { return __builtin_amdgcn_ds_read_tr16_b64_v4i16((LAS v4i16_t*)p); }
__device__ __forceinline__ float swap_lo(float v, float& hiv) { auto rr = __builtin_amdgcn_permlane32_swap(__float_as_uint(v), __float_as_uint(v), false, false); hiv = __uint_as_float(rr[1]); return __uint_as_float(rr[0]); }
__device__ __forceinline__ float fexp(float v) { return __builtin_amdgcn_exp2f(v * LOG2E); }
__device__ __forceinline__ void stage_tr_image(const bf16* src, int pitch, LAS unsigned char* img, int lane_in) {
    int lane = lane_in; asm volatile("" : "+v"(lane));
    const bf16* sp = src + (size_t)(lane >> 3) * pitch + (lane & 7) * 8;
    LAS unsigned char* dp = img + ((lane & 7) >> 2) * 4096 + (lane >> 3) * 64 + (lane & 3) * 16;
    v4u val[8];
#pragma unroll
    for (int i = 0; i < 8; ++i) { val[i] = *(const v4u*)sp; sp += (size_t)8 * pitch; }
#pragma unroll
    for (int i = 0; i < 8; ++i) *(LAS v4u*)(dp + i * 512) = val[i];
}
__device__ __forceinline__ bf16x8 tr_frag(const LAS unsigned char* img, int ch32, int ks, int lane) {
    const int hi = lane >> 5;
    const LAS unsigned char* p = img + ch32 * 4096 + ks * 1024 + ((lane >> 4) & 1) * 32 + (lane & 3) * 8 + (4 * hi + ((lane & 15) >> 2)) * 64;
    const v4i16_t lo = vtr(p), hv = vtr(p + 512);
    return (bf16x8){lo[0], lo[1], lo[2], lo[3], hv[0], hv[1], hv[2], hv[3]};
}
__device__ __forceinline__ void gla_pass_a(Frame& F, const float* b_a, int cid, LAS unsigned char* wl) {
    int lane_ = F.lane; asm volatile("" : "+v"(lane_));
    const int lane = lane_, r32 = lane & 31, hi = lane >> 5;
    const int bh = cid >> 7, n = cid & 127, b = bh >> 2, h = bh & 3;
    const size_t T0 = (size_t)b * SEQ + (size_t)n * GCH;
    const bf16* U = (const bf16*)(F.ws + WS_U);
    const bf16* wa2t = (const bf16*)(F.ws + WS_SMALL + SM_WA2);
    LAS unsigned char* kimg = wl; LAS unsigned char* vimg = wl + 8192;
    stage_tr_image(U + T0 * DINP + C_KG + h * 64, DINP, kimg, lane);
    asm volatile("" ::: "memory");
    f32x16 bC[2][2];
    {
        bf16x8 af[2], wf[2];
#pragma unroll
        for (int ct = 0; ct < 2; ++ct) af[ct] = *(const bf16x8*)(U + (T0 + 32 * ct + r32) * DINP + C_AL + 8 * hi);
#pragma unroll
        for (int dt = 0; dt < 2; ++dt) wf[dt] = *(const bf16x8*)(wa2t + (h * 64 + 32 * dt + r32) * 16 + 8 * hi);
        const f32x16 z16 = {};
#pragma unroll
        for (int ct = 0; ct < 2; ++ct)
#pragma unroll
            for (int dt = 0; dt < 2; ++dt) bC[ct][dt] = MFMA32(af[ct], wf[dt], z16);
#pragma unroll
        for (int dt = 0; dt < 2; ++dt) { const float ba = b_a[h * 64 + 32 * dt + r32];
#pragma unroll
            for (int ct = 0; ct < 2; ++ct)
#pragma unroll
                for (int r = 0; r < 16; ++r) { const float xv = bC[ct][dt][r] + ba;
                    const float ls = fminf(xv, 0.f) - __logf(1.0f + fexp(-fabsf(xv)));
                    bC[ct][dt][r] = ls * (1.0f / 16.0f); } }
    }
    asm volatile("" ::: "memory");
    f32x16 bT[2][2];
    {
#pragma unroll
        for (int ct = 0; ct < 2; ++ct) {
            f32x16 acc0 = {}, acc1 = {};
#pragma unroll
            for (int ks = 0; ks < 4; ++ks) { if (ct == 0 && ks >= 2) continue;
                v4u tw;
                { unsigned e[8];
#pragma unroll
                  for (int j = 0; j < 8; ++j) { const int cp = 16 * ks + 8 * (j >> 2) + 4 * hi + (j & 3); e[j] = (cp <= 32 * ct + r32) ? 0x3F80u : 0u; }
                  tw.x = e[0] | (e[1] << 16); tw.y = e[2] | (e[3] << 16); tw.z = e[4] | (e[5] << 16); tw.w = e[6] | (e[7] << 16); }
                const bf16x8 LT = __builtin_bit_cast(bf16x8, tw);
#pragma unroll
                for (int dt = 0; dt < 2; ++dt) { const f32x16& x = bC[ks >> 1][dt]; const int base = 8 * (ks & 1);
                    float hv[8], lv[8];
#pragma unroll
                    for (int j = 0; j < 8; ++j) { hv[j] = __uint_as_float(f2bf(x[base + j]) << 16); lv[j] = x[base + j] - hv[j]; }
                    const bf16x8 ah = pack8(hv[0], hv[1], hv[2], hv[3], hv[4], hv[5], hv[6], hv[7]);
                    const bf16x8 al = pack8(lv[0], lv[1], lv[2], lv[3], lv[4], lv[5], lv[6], lv[7]);
                    if (dt == 0) { acc0 = MFMA32(ah, LT, acc0); acc0 = MFMA32(al, LT, acc0); } else { acc1 = MFMA32(ah, LT, acc1); acc1 = MFMA32(al, LT, acc1); } }
            }
            bT[0][ct] = acc0; bT[1][ct] = acc1;
        }
    }
    asm volatile("" ::: "memory");
    float blast[2];
#pragma unroll
    for (int dt = 0; dt < 2; ++dt) { float run = 0.f;
#pragma unroll
        for (int ct = 0; ct < 2; ++ct)
#pragma unroll
            for (int a = 0; a < 4; ++a) { f32x16& x = bC[ct][dt];
                const float g0 = x[4 * a], g1 = g0 + x[4 * a + 1], g2 = g1 + x[4 * a + 2], g3 = g2 + x[4 * a + 3];
                float t1; const float t0 = swap_lo(g3, t1);
                const float off = run + (hi ? t0 : 0.f);
                x[4 * a] = off + g0; x[4 * a + 1] = off + g1; x[4 * a + 2] = off + g2; x[4 * a + 3] = off + g3;
                run += t0 + t1; }
        blast[dt] = run; }
    asm volatile("" ::: "memory");
    bf16x8 kl[2][4];
#pragma unroll
    for (int dt = 0; dt < 2; ++dt)
#pragma unroll
        for (int ks = 0; ks < 4; ++ks) { const bf16x8 kf = tr_frag(kimg, dt, ks, lane); float o8[8];
#pragma unroll
            for (int j = 0; j < 8; ++j) o8[j] = __uint_as_float(((unsigned)(unsigned short)kf[j]) << 16) * fexp(blast[dt] - bC[ks >> 1][dt][8 * (ks & 1) + j]);
            kl[dt][ks] = pack8(o8[0], o8[1], o8[2], o8[3], o8[4], o8[5], o8[6], o8[7]); }
    if (hi == 0) { float* dec = (float*)(F.ws + WS_DEC) + (size_t)cid * 64; dec[r32] = fexp(blast[0]); dec[32 + r32] = fexp(blast[1]); }
    asm volatile("" ::: "memory");
    bf16x8 qe[2][4], ke[2][4];
    bf16* QE = (bf16*)(F.ws + WS_QE) + (size_t)cid * 4096;
#pragma unroll
    for (int ct = 0; ct < 2; ++ct) { const bf16* rowp = U + (T0 + 32 * ct + r32) * DINP;
#pragma unroll
        for (int ds = 0; ds < 4; ++ds) {
            const v2u q0 = *(const v2u*)(rowp + C_QG + h * 64 + 16 * ds + 4 * hi), q1 = *(const v2u*)(rowp + C_QG + h * 64 + 16 * ds + 8 + 4 * hi);
            const v2u k0 = *(const v2u*)(rowp + C_KG + h * 64 + 16 * ds + 4 * hi), k1 = *(const v2u*)(rowp + C_KG + h * 64 + 16 * ds + 8 + 4 * hi);
            const float qv[8] = {bflo(q0.x), bfhi(q0.x), bflo(q0.y), bfhi(q0.y), bflo(q1.x), bfhi(q1.x), bflo(q1.y), bfhi(q1.y)};
            const float kv_[8] = {bflo(k0.x), bfhi(k0.x), bflo(k0.y), bfhi(k0.y), bflo(k1.x), bfhi(k1.x), bflo(k1.y), bfhi(k1.y)};
            float qo[8], ko[8];
#pragma unroll
            for (int j = 0; j < 8; ++j) { const float e = bT[ds >> 1][ct][8 * (ds & 1) + j]; qo[j] = qv[j] * 0.125f * fexp(e); ko[j] = kv_[j] * fexp(-e); }
            qe[ct][ds] = pack8(qo[0], qo[1], qo[2], qo[3], qo[4], qo[5], qo[6], qo[7]);
            ke[ct][ds] = pack8(ko[0], ko[1], ko[2], ko[3], ko[4], ko[5], ko[6], ko[7]);
            *(bf16x8*)(QE + ((ct * 4 + ds) * 64 + lane) * 8) = qe[ct][ds];
            if (ds & 1) asm volatile("" ::: "memory");
        } }
    asm volatile("" ::: "memory");
    bf16x8 at0[2], at1[4];
    {
        f32x16 a00 = {}, a01 = {}, a11 = {};
#pragma unroll
        for (int ds = 0; ds < 4; ++ds) { a00 = MFMA32(ke[0][ds], qe[0][ds], a00); a01 = MFMA32(ke[0][ds], qe[1][ds], a01); a11 = MFMA32(ke[1][ds], qe[1][ds], a11); }
#pragma unroll
        for (int r = 0; r < 16; ++r) { const bool keep = crow(r, hi) <= r32; a00[r] = keep ? a00[r] : 0.f; a11[r] = keep ? a11[r] : 0.f; }
        at0[0] = pack8r(a00, 0); at0[1] = pack8r(a00, 8);
        at1[0] = pack8r(a01, 0); at1[1] = pack8r(a01, 8); at1[2] = pack8r(a11, 0); at1[3] = pack8r(a11, 8);
    }
    asm volatile("" ::: "memory");
    bf16* KVF = (bf16*)(F.ws + WS_KV) + (size_t)cid * 8192;
    bf16* OI = (bf16*)(F.ws + WS_OI) + (size_t)cid * 8192;
#pragma unroll
    for (int vh = 0; vh < 2; ++vh) {
        stage_tr_image(U + T0 * DINP + C_VG + h * 128 + vh * 64, DINP, vimg, lane);
#pragma unroll
        for (int v2 = 0; v2 < 2; ++v2) { const int vt = 2 * vh + v2;
            bf16x8 vf[4];
#pragma unroll
            for (int ks = 0; ks < 4; ++ks) vf[ks] = tr_frag(vimg, v2, ks, lane);
            f32x16 o0 = {}, o1 = {};
#pragma unroll
            for (int ks = 0; ks < 4; ++ks) { if (ks < 2) o0 = MFMA32(vf[ks], at0[ks], o0); o1 = MFMA32(vf[ks], at1[ks], o1); }
            { v4u w0, w1;
              w0.x = cvtpk(o0[0], o0[1]); w0.y = cvtpk(o0[2], o0[3]); w0.z = cvtpk(o0[4], o0[5]); w0.w = cvtpk(o0[6], o0[7]);
              w1.x = cvtpk(o0[8], o0[9]); w1.y = cvtpk(o0[10], o0[11]); w1.z = cvtpk(o0[12], o0[13]); w1.w = cvtpk(o0[14], o0[15]);
              v4u* d0 = (v4u*)(OI + ((vt * 2 + 0) * 64 + lane) * 16); d0[0] = w0; d0[1] = w1;
              w0.x = cvtpk(o1[0], o1[1]); w0.y = cvtpk(o1[2], o1[3]); w0.z = cvtpk(o1[4], o1[5]); w0.w = cvtpk(o1[6], o1[7]);
              w1.x = cvtpk(o1[8], o1[9]); w1.y = cvtpk(o1[10], o1[11]); w1.z = cvtpk(o1[12], o1[13]); w1.w = cvtpk(o1[14], o1[15]);
              v4u* d1 = (v4u*)(OI + ((vt * 2 + 1) * 64 + lane) * 16); d1[0] = w0; d1[1] = w1; }
            f32x16 kv0 = {}, kv1 = {};
#pragma unroll
            for (int ks = 0; ks < 4; ++ks) { kv0 = MFMA32(kl[0][ks], vf[ks], kv0); kv1 = MFMA32(kl[1][ks], vf[ks], kv1); }
            { v4u w0, w1;
              w0.x = cvtpk(kv0[0], kv0[1]); w0.y = cvtpk(kv0[2], kv0[3]); w0.z = cvtpk(kv0[4], kv0[5]); w0.w = cvtpk(kv0[6], kv0[7]);
              w1.x = cvtpk(kv0[8], kv0[9]); w1.y = cvtpk(kv0[10], kv0[11]); w1.z = cvtpk(kv0[12], kv0[13]); w1.w = cvtpk(kv0[14], kv0[15]);
              v4u* d0 = (v4u*)(KVF + ((vt * 2 + 0) * 64 + lane) * 16); d0[0] = w0; d0[1] = w1;
              w0.x = cvtpk(kv1[0], kv1[1]); w0.y = cvtpk(kv1[2], kv1[3]); w0.z = cvtpk(kv1[4], kv1[5]); w0.w = cvtpk(kv1[6], kv1[7]);
              w1.x = cvtpk(kv1[8], kv1[9]); w1.y = cvtpk(kv1[10], kv1[11]); w1.z = cvtpk(kv1[12], kv1[13]); w1.w = cvtpk(kv1[14], kv1[15]);
              v4u* d1 = (v4u*)(KVF + ((vt * 2 + 1) * 64 + lane) * 16); d1[0] = w0; d1[1] = w1; }
        }
    }
}
struct ScanLoads { bf16x8 qf[4]; v4u k0a, k0b, k1a, k1b; v4u oi0, oi1; v2u zz[4]; };
__device__ __forceinline__ void scan_load(ScanLoads& L, const unsigned char* ws, int cid, size_t tok, int h, int ct, int vt, int lane, int hi) {
    const bf16* QE = (const bf16*)(ws + WS_QE) + (size_t)cid * 4096;
    const bf16* KVF = (const bf16*)(ws + WS_KV) + (size_t)cid * 8192;
    const bf16* OI = (const bf16*)(ws + WS_OI) + (size_t)cid * 8192;
    const bf16* U = (const bf16*)(ws + WS_U);
#pragma unroll
    for (int ds = 0; ds < 4; ++ds) L.qf[ds] = *(const bf16x8*)(QE + ((ct * 4 + ds) * 64 + lane) * 8);
    { const v4u* p0 = (const v4u*)(KVF + ((vt * 2 + 0) * 64 + lane) * 16); const v4u* p1 = (const v4u*)(KVF + ((vt * 2 + 1) * 64 + lane) * 16);
      L.k0a = p0[0]; L.k0b = p0[1]; L.k1a = p1[0]; L.k1b = p1[1]; }
    L.oi0 = *(const v4u*)(OI + ((vt * 2 + ct) * 64 + lane) * 16); L.oi1 = *(const v4u*)(OI + ((vt * 2 + ct) * 64 + lane) * 16 + 8);
#pragma unroll
    for (int a = 0; a < 4; ++a) L.zz[a] = *(const v2u*)(U + tok * DINP + C_ZG + h * 128 + 32 * vt + 8 * a + 4 * hi);
}
__device__ __forceinline__ void scan_step(const ScanLoads& L, f32x16& S0, f32x16& S1, const LAS float* gnl, LAS float* part, const LAS float* decb, bf16* MIX, size_t tok, int n, int h, int ct, int vt, int r32, int hi) {
    f32x16 o = {};
    o = MFMA32(pack8r(S0, 0), L.qf[0], o); o = MFMA32(pack8r(S0, 8), L.qf[1], o); o = MFMA32(pack8r(S1, 0), L.qf[2], o); o = MFMA32(pack8r(S1, 8), L.qf[3], o);
    const unsigned oiw[8] = {L.oi0.x, L.oi0.y, L.oi0.z, L.oi0.w, L.oi1.x, L.oi1.y, L.oi1.z, L.oi1.w};
    float ss = 0.f;
#pragma unroll
    for (int r = 0; r < 16; ++r) { const float add = (r & 1) ? bfhi(oiw[r >> 1]) : bflo(oiw[r >> 1]); o[r] += add; ss += o[r] * o[r]; }
    { const unsigned k0w[8] = {L.k0a.x, L.k0a.y, L.k0a.z, L.k0a.w, L.k0b.x, L.k0b.y, L.k0b.z, L.k0b.w}, k1w[8] = {L.k1a.x, L.k1a.y, L.k1a.z, L.k1a.w, L.k1b.x, L.k1b.y, L.k1b.z, L.k1b.w};
#pragma unroll
      for (int a = 0; a < 4; ++a) { const f32x4 x0 = *(const LAS f32x4*)(decb + 8 * a + 4 * hi), x1 = *(const LAS f32x4*)(decb + 32 + 8 * a + 4 * hi);
        S0[4 * a] = x0.x * S0[4 * a] + bflo(k0w[2 * a]); S0[4 * a + 1] = x0.y * S0[4 * a + 1] + bfhi(k0w[2 * a]); S0[4 * a + 2] = x0.z * S0[4 * a + 2] + bflo(k0w[2 * a + 1]); S0[4 * a + 3] = x0.w * S0[4 * a + 3] + bfhi(k0w[2 * a + 1]);
        S1[4 * a] = x1.x * S1[4 * a] + bflo(k1w[2 * a]); S1[4 * a + 1] = x1.y * S1[4 * a + 1] + bfhi(k1w[2 * a]); S1[4 * a + 2] = x1.z * S1[4 * a + 2] + bflo(k1w[2 * a + 1]); S1[4 * a + 3] = x1.w * S1[4 * a + 3] + bfhi(k1w[2 * a + 1]); } }
    { float t1; const float t0 = swap_lo(ss, t1); ss = t0 + t1; }
    LAS float* pb = part + (n & 1) * 256;
    if (hi == 0) pb[vt * 64 + 32 * ct + r32] = ss;
    __syncthreads();
    const float tot = (pb[32 * ct + r32] + pb[64 + 32 * ct + r32]) + (pb[128 + 32 * ct + r32] + pb[192 + 32 * ct + r32]);
    const float rstd = 1.0f / sqrtf(tot * (1.0f / GDV) + LN_EPS);
#pragma unroll
    for (int a = 0; a < 4; ++a) { const float z0 = bflo(L.zz[a].x), z1 = bfhi(L.zz[a].x), z2 = bflo(L.zz[a].y), z3 = bfhi(L.zz[a].y); const f32x4 gna = *(const LAS f32x4*)(gnl + 32 * vt + 8 * a + 4 * hi);
        const float y0 = o[4 * a] * rstd * gna.x * z0 * sigmoidf2(z0), y1 = o[4 * a + 1] * rstd * gna.y * z1 * sigmoidf2(z1);
        const float y2 = o[4 * a + 2] * rstd * gna.z * z2 * sigmoidf2(z2), y3 = o[4 * a + 3] * rstd * gna.w * z3 * sigmoidf2(z3);
        v2u ov; ov.x = cvtpk(y0, y1); ov.y = cvtpk(y2, y3);
        *(v2u*)(MIX + tok * DM + 512 + h * 128 + 32 * vt + 8 * a + 4 * hi) = ov; }
}
__device__ __forceinline__ void gla_scan_unit(Frame& F, const float* gnw, int bh, LAS float* part) {
    const int lane = F.lane, r32 = lane & 31, hi = lane >> 5, w = F.wave, ct = w & 1, vt = w >> 1;
    const int b = bh >> 2, h = bh & 3;
    bf16* MIX = (bf16*)(F.ws + WS_MIX);
    LAS float* decb = part + 512;
    const float* DEC = (const float*)(F.ws + WS_DEC) + (size_t)bh * NCHUNK * 64;
    f32x16 S0 = {}, S1 = {};
    LAS float* gnl = part + 640;
    if (w == 1) { gnl[lane] = gnw[lane]; gnl[64 + lane] = gnw[64 + lane]; }
    const size_t tokb = (size_t)b * SEQ + 32 * ct + r32;
    ScanLoads LA, LB;
    scan_load(LA, F.ws, bh * NCHUNK, tokb, h, ct, vt, lane, hi);
    if (w == 0) decb[lane] = DEC[lane];
    __syncthreads();
    for (int n = 0; n < NCHUNK; n += 2) {
        scan_load(LB, F.ws, bh * NCHUNK + n + 1, tokb + (size_t)(n + 1) * GCH, h, ct, vt, lane, hi);
        if (w == 0) decb[64 + lane] = DEC[(n + 1) * 64 + lane];
        scan_step(LA, S0, S1, gnl, part, decb, MIX, tokb + (size_t)n * GCH, n, h, ct, vt, r32, hi);
        if (n + 2 < NCHUNK) { scan_load(LA, F.ws, bh * NCHUNK + n + 2, tokb + (size_t)(n + 2) * GCH, h, ct, vt, lane, hi); if (w == 0) decb[lane] = DEC[(n + 2) * 64 + lane]; }
        scan_step(LB, S0, S1, gnl, part, decb + 64, MIX, tokb + (size_t)(n + 1) * GCH, n + 1, h, ct, vt, r32, hi);
    }
    __syncthreads();
}
constexpr int L_KV = 0;
constexpr int L_TB = 32768;
constexpr int L_WSF = 36864;
constexpr int L_SELM = 38912;
constexpr int L_MREF = 39936;
constexpr int L_LACC = 40960;
constexpr int L_CNT = 41984;
constexpr int L_ITEMS = 43520;
constexpr int L_TOKL = 44032;
constexpr int L_SL2 = 52224;
constexpr int L_OACC = 84992;
constexpr int L_IMP = L_OACC;
constexpr int IMP_LD = 129;
constexpr float NEGBIG = -1e30f;
constexpr float C2S = 0.125f * LOG2E;
constexpr float THR_RESC = 8.0f;

__device__ __forceinline__ int t5_bucket(int n) {
    if (n < 16) return n;
    const int th[15] = {19, 21, 24, 27, 31, 35, 40, 46, 52, 59, 67, 77, 87, 99, 113};
    int b = 16;
#pragma unroll
    for (int i = 0; i < 15; ++i) b += (n >= th[i]) ? 1 : 0;
    return b;
}
__device__ __forceinline__ void build_bias_table(Frame& F, const float* rel_bias) {
    LAS float* tb = (LAS float*)(F.lds + L_TB);
    for (int i = F.tid; i < 8 * 128; i += NWAVES * 64) { const int hd = i >> 7, n = i & 127; tb[i] = rel_bias[t5_bucket(n) * 8 + hd] * LOG2E; }
}
struct KVRegs { v4u k, v; };
__device__ __forceinline__ KVRegs kv_load(const bf16* Kb, const bf16* Vb, size_t pitch, int row0, int w, int lane) {
    KVRegs r;
    r.k = *(const v4u*)(Kb + (size_t)(row0 + lane) * pitch + w * 8);
    r.v = *(const v4u*)(Vb + (size_t)(row0 + 16 * (w & 3) + (lane >> 2)) * pitch + (w >> 2) * 32 + (lane & 3) * 8);
    return r;
}
__device__ __forceinline__ void kv_store(LAS unsigned char* slot, const KVRegs& r, int tid) {
    *(LAS v4u*)(slot + tid * 16) = r.k; *(LAS v4u*)(slot + 8192 + tid * 16) = r.v;
}
struct SmState { float mhat, lsum; f32x16 o0, o1; };
__device__ __forceinline__ void qk_tile(const LAS unsigned char* kslot, const bf16x8 (&qr)[4], f32x16& p0, f32x16& p1, int r32, int hi) {
    const LAS unsigned char* kp = kslot + hi * 1024 + r32 * 16;
    p0 = (f32x16){}; p1 = (f32x16){};
#pragma unroll
    for (int d0 = 0; d0 < 4; ++d0) { const bf16x8 k0 = *(const LAS bf16x8*)(kp + d0 * 2048), k1 = *(const LAS bf16x8*)(kp + d0 * 2048 + 512);
        p0 = MFMA32(k0, qr[d0], p0); p1 = MFMA32(k1, qr[d0], p1); }
}
__device__ __forceinline__ float rowmax32(const f32x16& p0, const f32x16& p1) {
    float a = fmaxf(p0[0], p1[0]);
#pragma unroll
    for (int r = 1; r < 16; ++r) a = fmaxf(a, fmaxf(p0[r], p1[r]));
    float t1; const float t0 = swap_lo(a, t1); return fmaxf(t0, t1);
}
__device__ __forceinline__ void pv_tail(SmState& st, const f32x16& p0, const f32x16& p1, const LAS unsigned char* vslot, int lane) {
    const bf16x8 pa0 = pack8r(p0, 0), pa1 = pack8r(p0, 8), pa2 = pack8r(p1, 0), pa3 = pack8r(p1, 8);
#pragma unroll
    for (int d0 = 0; d0 < 2; ++d0) {
        const bf16x8 v0 = tr_frag(vslot, d0, 0, lane), v1 = tr_frag(vslot, d0, 1, lane), v2 = tr_frag(vslot, d0, 2, lane), v3 = tr_frag(vslot, d0, 3, lane);
        f32x16 o = d0 ? st.o1 : st.o0;
        o = MFMA32(pa0, v0, o); o = MFMA32(pa1, v1, o); o = MFMA32(pa2, v2, o); o = MFMA32(pa3, v3, o);
        if (d0) st.o1 = o; else st.o0 = o;
    }
}
__device__ __forceinline__ void softmax_pv(SmState& st, f32x16& p0, f32x16& p1, const LAS unsigned char* vslot, LAS float* wsf, int lane, int r32, int hi) {
    const float rm = rowmax32(p0, p1);
    if (__any(rm > st.mhat + THR_RESC)) {
        const float mnew = fmaxf(st.mhat, rm); const float f = __builtin_amdgcn_exp2f(st.mhat - mnew);
        st.lsum *= f; st.mhat = mnew;
        if (hi == 0) wsf[r32] = f;
        LDS_WAIT();
#pragma unroll
        for (int r = 0; r < 16; ++r) { const float fr = wsf[crow(r, hi)]; st.o0[r] *= fr; st.o1[r] *= fr; }
    }
    float s = 0.f;
#pragma unroll
    for (int r = 0; r < 16; ++r) { p0[r] = __builtin_amdgcn_exp2f(p0[r] - st.mhat); p1[r] = __builtin_amdgcn_exp2f(p1[r] - st.mhat); s += p0[r] + p1[r]; }
    st.lsum += s;
    pv_tail(st, p0, p1, vslot, lane);
}
__device__ __forceinline__ void softmax_pv_fast(SmState& st, f32x16& p0, f32x16& p1, float sc, float bias, const LAS unsigned char* vslot, LAS float* wsf, int lane, int r32, int hi) {
    const float rm = __builtin_fmaf(rowmax32(p0, p1), sc, bias);
    if (__any(rm > st.mhat + THR_RESC)) {
        const float mnew = fmaxf(st.mhat, rm); const float f = __builtin_amdgcn_exp2f(st.mhat - mnew);
        st.lsum *= f; st.mhat = mnew;
        if (hi == 0) wsf[r32] = f;
        LDS_WAIT();
#pragma unroll
        for (int r = 0; r < 16; ++r) { const float fr = wsf[crow(r, hi)]; st.o0[r] *= fr; st.o1[r] *= fr; }
    }
    const float nb = bias - st.mhat; float s = 0.f;
#pragma unroll
    for (int r = 0; r < 16; ++r) { p0[r] = __builtin_amdgcn_exp2f(__builtin_fmaf(p0[r], sc, nb)); p1[r] = __builtin_amdgcn_exp2f(__builtin_fmaf(p1[r], sc, nb)); s += p0[r] + p1[r]; }
    st.lsum += s;
    pv_tail(st, p0, p1, vslot, lane);
}
__device__ __forceinline__ void stage_tile(LAS bf16* stg, const f32x16& a0, const f32x16& a1, int r32, int hi) {
#pragma unroll
    for (int r = 0; r < 16; ++r) { stg[crow(r, hi) * 64 + r32] = (bf16)f2bf(a0[r]); stg[crow(r, hi) * 64 + 32 + r32] = (bf16)f2bf(a1[r]); }
}
__device__ __forceinline__ void finish_rows(SmState& st, LAS float* wsf, int r32, int hi, bool zero_row) {
    float t1; const float t0 = swap_lo(st.lsum, t1); const float l = t0 + t1;
    if (hi == 0) wsf[32 + r32] = zero_row ? 0.f : __builtin_amdgcn_rcpf(l);
    LDS_WAIT();
#pragma unroll
    for (int r = 0; r < 16; ++r) { const float il = wsf[32 + crow(r, hi)]; st.o0[r] *= il; st.o1[r] *= il; }
}
__device__ __forceinline__ void load_q(bf16x8 (&qr)[4], const bf16* U, size_t tok0, int g, int w, int r32, int hi) {
    const bf16* qp = U + (tok0 + 8 * w + (r32 >> 2)) * DINP + C_QN + (4 * g + (r32 & 3)) * 64 + 8 * hi;
#pragma unroll
    for (int d0 = 0; d0 < 4; ++d0) qr[d0] = *(const bf16x8*)(qp + 16 * d0);
}
template <bool NEAR>
__device__ __forceinline__ void bias_mask(f32x16& p0, f32x16& p1, const LAS float* tbh, int dist0, int kstep, int loD, int hiD, bool rowok, int hi) {
    const float cfar = tbh[127];
#pragma unroll
    for (int r = 0; r < 16; ++r) {
        const int k0 = crow(r, hi), k1 = k0 + 32;
        const int dA = dist0 - kstep * k0, dB = dist0 - kstep * k1;
        float bA, bB;
        if (NEAR) { bA = tbh[min(max(dA, 0), 127)]; bB = tbh[min(max(dB, 0), 127)]; } else { bA = cfar; bB = cfar; }
        const bool vA = rowok && dA >= loD && dA < hiD, vB = rowok && dB >= loD && dB < hiD;
        p0[r] = vA ? __builtin_fmaf(p0[r], C2S, bA) : NEGBIG;
        p1[r] = vB ? __builtin_fmaf(p1[r], C2S, bB) : NEGBIG;
    }
}
__device__ __forceinline__ void window_unit(Frame& F, int unit) {
    int tid_ = F.tid; asm volatile("" : "+v"(tid_));
    const int tid = tid_, lane = tid & 63, r32 = lane & 31, hi = lane >> 5, w = F.wave;
    const int bg = unit >> 7, i = unit & 127, b = bg >> 1, g = bg & 1;
    const bf16* U = (const bf16*)(F.ws + WS_U);
    const size_t tok0 = (size_t)b * SEQ + (size_t)i * 64;
    const bf16* Kb = U + (size_t)b * SEQ * DINP + C_KW + g * 64; const bf16* Vb = U + (size_t)b * SEQ * DINP + C_VW + g * 64;
    LAS unsigned char* kv = F.lds + L_KV; LAS float* wsf = (LAS float*)(F.lds + L_WSF) + w * 64;
    const LAS float* tbh = (const LAS float*)(F.lds + L_TB) + (4 * g + (r32 & 3)) * 128;
    bf16x8 qr[4]; load_q(qr, U, tok0, g, w, r32, hi);
    SmState st; st.mhat = NEGBIG; st.lsum = 0.f; st.o0 = (f32x16){}; st.o1 = (f32x16){};
    const int tql = 8 * w + (r32 >> 2);
    const int nb = (i < 8 ? i : 8) + 1;
    { const KVRegs r0 = kv_load(Kb, Vb, DINP, i * 64, w, lane); kv_store(kv, r0, tid); }
    __syncthreads();
    for (int s = 0; s < nb; ++s) {
        const int blk = i - s; LAS unsigned char* slot = kv + (s & 1) * 16384;
        KVRegs nx; if (s + 1 < nb) nx = kv_load(Kb, Vb, DINP, (blk - 1) * 64, w, lane);
        f32x16 p0, p1; qk_tile(slot, qr, p0, p1, r32, hi);
        const int dist0 = 64 * s + tql;
        if (s <= 2) { bias_mask<true>(p0, p1, tbh, dist0, 1, 0, 512, true, hi); softmax_pv(st, p0, p1, slot + 8192, wsf, lane, r32, hi); }
        else if (s == 8) { bias_mask<false>(p0, p1, tbh, dist0, 1, 0, 512, true, hi); softmax_pv(st, p0, p1, slot + 8192, wsf, lane, r32, hi); }
        else softmax_pv_fast(st, p0, p1, C2S, tbh[127], slot + 8192, wsf, lane, r32, hi);
        if (s + 1 < nb) kv_store(kv + ((s + 1) & 1) * 16384, nx, tid);
        __syncthreads();
    }
    finish_rows(st, wsf, r32, hi, false);
    bf16* OW = (bf16*)(F.ws + WS_OW);
    LAS bf16* stg = (LAS bf16*)(F.lds + L_IMP) + w * 2048;
    stage_tile(stg, st.o0, st.o1, r32, hi);
    LDS_WAIT();
#pragma unroll
    for (int it = 0; it < 4; ++it) { const int row = it * 8 + (lane >> 3), ch = lane & 7;
        const v4u t = *(const LAS v4u*)(stg + row * 64 + ch * 8);
        *(v4u*)(OW + (tok0 + 8 * w + (row >> 2)) * 512 + (4 * g + (row & 3)) * 64 + ch * 8) = t; }
    LDS_WAIT();
}
constexpr int CA_ROWS = 528, L_CH = 69632, CH_LD = 264;
__device__ __forceinline__ float gelu_tanh(float x) { const float u = 0.7978845608028654f * (x + 0.044715f * x * x * x); const float e = __builtin_amdgcn_exp2f(2.0f * LOG2E * u); return x * (1.0f - __builtin_amdgcn_rcpf(e + 1.0f)); }
__device__ __forceinline__ void compress_unit(Frame& F, int unit) {
    int tid_ = F.tid; asm volatile("" : "+v"(tid_));
    const int tid = tid_, lane = tid & 63, r32 = lane & 31, hi = lane >> 5, w = F.wave;
    const int which = unit >> 8, bg = (unit >> 4) & 15, jb = unit & 15, b = bg >> 1, g = bg & 1;
    const bf16* U = (const bf16*)(F.ws + WS_U);
    const bf16* src = U + ((size_t)b * SEQ + 512 * jb) * DINP + (which ? C_VC : C_KC) + g * 64;
    const bf16* W1t = (const bf16*)(F.ws + (which ? WS_WCV1 : WS_WCK1));
    const bf16* W2t = (const bf16*)(F.ws + WS_SMALL + (which ? SM_WCV2 : SM_WCK2));
    const float* cb1 = (const float*)(F.ws + WS_SMALL + (which ? SM_CB1V : SM_CB1K));
    bf16* dst = (bf16*)(F.ws + (which ? WS_VC : WS_KC)) + ((size_t)bg * NCP + 32 * jb) * 64;
    LAS unsigned char* A = F.lds; LAS bf16* H = (LAS bf16*)(F.lds + L_CH);
    for (int p = tid; p < CA_ROWS * 8; p += NWAVES * 64) { const int t = p >> 3, ch = p & 7;
        const v4u val = *(const v4u*)(src + (size_t)t * DINP + ch * 8);
        *(LAS v4u*)(A + t * 128 + ((ch ^ ((t >> 4) & 7)) << 4)) = val; }
    __syncthreads();
    f32x16 acc = {};
    const bf16* wp = W1t + (size_t)(32 * w + r32) * CMPK + 8 * hi;
#pragma unroll 4
    for (int kk = 0; kk < 128; ++kk) { const int tok = kk >> 2, t = 16 * r32 + tok, ch = 2 * (kk & 3) + hi;
        const bf16x8 a = *(const LAS bf16x8*)(A + t * 128 + ((ch ^ ((t >> 4) & 7)) << 4));
        const bf16x8 bw = *(const bf16x8*)(wp + 16 * kk);
        acc = MFMA32(a, bw, acc); }
    { const float cb = cb1[32 * w + r32];
#pragma unroll
      for (int r = 0; r < 16; ++r) H[crow(r, hi) * CH_LD + 32 * w + r32] = (bf16)f2bf(gelu_tanh(acc[r] + cb)); }
    __syncthreads();
    if (w < 2) {
        f32x16 o = {};
        const bf16* w2p = W2t + (size_t)(32 * w + r32) * CMPH + 8 * hi;
#pragma unroll
        for (int kk = 0; kk < 16; ++kk) { const bf16x8 a = *(const LAS bf16x8*)(H + r32 * CH_LD + 16 * kk + 8 * hi); const bf16x8 bw = *(const bf16x8*)(w2p + 16 * kk); o = MFMA32(a, bw, o); }
#pragma unroll
        for (int r = 0; r < 16; ++r) dst[crow(r, hi) * 64 + 32 * w + r32] = (bf16)f2bf(o[r]);
    }
    __syncthreads();
}
__device__ __forceinline__ void nsa_unit(Frame& F, int unit) {
    int tid_ = F.tid; asm volatile("" : "+v"(tid_));
    const int tid = tid_, lane = tid & 63, r32 = lane & 31, hi = lane >> 5, w = F.wave;
    const int bg = unit >> 7, i = unit & 127, b = bg >> 1, g = bg & 1;
    const bf16* U = (const bf16*)(F.ws + WS_U);
    const size_t tok0 = (size_t)b * SEQ + (size_t)i * 64;
    LAS unsigned char* kv = F.lds + L_KV; LAS float* wsf = (LAS float*)(F.lds + L_WSF) + w * 64;
    const LAS float* tbh = (const LAS float*)(F.lds + L_TB) + (4 * g + (r32 & 3)) * 128;
    LAS float* imp = (LAS float*)(F.lds + L_IMP); LAS unsigned* selm = (LAS unsigned*)(F.lds + L_SELM);
    bf16x8 qr[4]; load_q(qr, U, tok0, g, w, r32, hi);
    const int tql = 8 * w + (r32 >> 2), tq = i * 64 + tql;
    for (int x = tid; x < 64 * IMP_LD; x += NWAVES * 64) imp[x] = 0.f;
    const bf16* KCb = (const bf16*)(F.ws + WS_KC) + (size_t)bg * NCP * 64; const bf16* VCb = (const bf16*)(F.ws + WS_VC) + (size_t)bg * NCP * 64;
    const int ncv = 4 * i + 3, nct = (ncv + 63) >> 6;
    SmState st; st.mhat = NEGBIG; st.lsum = 0.f; st.o0 = (f32x16){}; st.o1 = (f32x16){};
    { const KVRegs r0 = kv_load(KCb, VCb, 64, 0, w, lane); kv_store(kv, r0, tid); }
    __syncthreads();
    for (int s = 0; s < nct; ++s) {
        LAS unsigned char* slot = kv + (s & 1) * 16384;
        KVRegs nx; if (s + 1 < nct) nx = kv_load(KCb, VCb, 64, (s + 1) * 64, w, lane);
        f32x16 p0, p1; qk_tile(slot, qr, p0, p1, r32, hi);
        const int dist0 = tq - 31 - 1024 * s;
        if (64 * i - 31 - 1024 * s - 16 * 63 < 113) { bias_mask<true>(p0, p1, tbh, dist0, 16, 0, 0x7fffffff, true, hi); softmax_pv(st, p0, p1, slot + 8192, wsf, lane, r32, hi); }
        else softmax_pv_fast(st, p0, p1, C2S, tbh[127], slot + 8192, wsf, lane, r32, hi);
        if (s + 1 < nct) kv_store(kv + ((s + 1) & 1) * 16384, nx, tid);
        __syncthreads();
    }
    const bool norow = tq < 31;
    float lc; { float t1; const float t0 = swap_lo(st.lsum, t1); lc = t0 + t1; }
    const float mfin = st.mhat, ilc = norow ? 0.f : __builtin_amdgcn_rcpf(lc);
    finish_rows(st, wsf, r32, hi, norow);
    unsigned ocw[16];
    { const bf16* gp = U + (tok0 + tql) * DINP + C_GN + (4 * g + (r32 & 3)) * 3;
      const float g0 = sigmoidf2(bflo((unsigned)gp[0]));
      if (hi == 0) wsf[r32] = g0;
      LDS_WAIT();
#pragma unroll
      for (int r = 0; r < 16; ++r) { const float gg = wsf[crow(r, hi)]; ocw[r] = cvtpk(st.o0[r] * gg, st.o1[r] * gg); } }
    unsigned* park = (unsigned*)(F.ws + WS_PARK) + ((size_t)blockIdx.x * NWAVES + w) * 4096 + lane;
#pragma unroll
    for (int r = 0; r < 16; ++r) park[r * 64] = ocw[r];
    __syncthreads();
    { const KVRegs r0 = kv_load(KCb, VCb, 64, 0, w, lane); kv_store(kv, r0, tid); }
    __syncthreads();
    for (int s = 0; s < nct; ++s) {
        LAS unsigned char* slot = kv + (s & 1) * 16384;
        KVRegs nx; if (s + 1 < nct) nx = kv_load(KCb, VCb, 64, (s + 1) * 64, w, lane);
        f32x16 p0, p1; qk_tile(slot, qr, p0, p1, r32, hi);
        const int dist0 = tq - 31 - 1024 * s;
        if (64 * i - 31 - 1024 * s - 16 * 63 < 113) { bias_mask<true>(p0, p1, tbh, dist0, 16, 0, 0x7fffffff, true, hi);
#pragma unroll
            for (int r = 0; r < 16; ++r) { p0[r] = __builtin_amdgcn_exp2f(p0[r] - mfin) * ilc; p1[r] = __builtin_amdgcn_exp2f(p1[r] - mfin) * ilc; } }
        else { const float nb = tbh[127] - mfin;
#pragma unroll
            for (int r = 0; r < 16; ++r) { p0[r] = __builtin_amdgcn_exp2f(__builtin_fmaf(p0[r], C2S, nb)) * ilc; p1[r] = __builtin_amdgcn_exp2f(__builtin_fmaf(p1[r], C2S, nb)) * ilc; } }
        LAS float* irow = imp + tql * IMP_LD + 16 * s + hi;
#pragma unroll
        for (int A = 0; A < 8; ++A) { const f32x16& p = (A < 4) ? p0 : p1; const int a = A & 3;
            float own = p[4 * a] + p[4 * a + 1] + p[4 * a + 2] + 0.5f * p[4 * a + 3], car = 0.5f * p[4 * a + 3];
            own += __shfl_xor(own, 1); own += __shfl_xor(own, 2); car += __shfl_xor(car, 1); car += __shfl_xor(car, 2);
            if ((r32 & 3) == 0) { (void)__hip_atomic_fetch_add(irow + 2 * A, own, __ATOMIC_RELAXED, __HIP_MEMORY_SCOPE_WORKGROUP); (void)__hip_atomic_fetch_add(irow + 2 * A + 1, car, __ATOMIC_RELAXED, __HIP_MEMORY_SCOPE_WORKGROUP); } }
        if (s + 1 < nct) kv_store(kv + ((s + 1) & 1) * 16384, nx, tid);
        __syncthreads();
    }
    {
        const int tl = 8 * w + (lane >> 3), slot8 = lane & 7; const int cur = i;
        unsigned m0 = 0u, m1 = 0u, m2 = 0u, m3 = 0u;
        if (cur < 16) { m0 = (cur == 31) ? 0xffffffffu : ((1u << (cur + 1)) - 1u); }
        else {
            unsigned key[16];
#pragma unroll
            for (int k = 0; k < 16; ++k) { const int n = slot8 + 8 * k; const float v = imp[tl * IMP_LD + n];
                key[k] = (n >= 1 && n <= cur - 2) ? ((__float_as_uint(v) & ~127u) | (unsigned)(127 - n)) : 0u; }
            for (int it = 0; it < 13; ++it) {
                unsigned mx = key[0];
#pragma unroll
                for (int k = 1; k < 16; ++k) mx = max(mx, key[k]);
                mx = max(mx, (unsigned)__shfl_xor((int)mx, 1)); mx = max(mx, (unsigned)__shfl_xor((int)mx, 2)); mx = max(mx, (unsigned)__shfl_xor((int)mx, 4));
                const int nsel = 127 - (int)(mx & 127u);
#pragma unroll
                for (int k = 0; k < 16; ++k) key[k] = (key[k] == mx) ? 0u : key[k];
                const unsigned bit = 1u << (nsel & 31); const int wd = nsel >> 5;
                m0 |= (wd == 0) ? bit : 0u; m1 |= (wd == 1) ? bit : 0u; m2 |= (wd == 2) ? bit : 0u; m3 |= (wd == 3) ? bit : 0u;
            }
            m0 |= 1u;
            { const int n1 = cur - 1, n2 = cur; const unsigned b1 = 1u << (n1 & 31), b2 = 1u << (n2 & 31);
              m0 |= ((n1 >> 5) == 0 ? b1 : 0u) | ((n2 >> 5) == 0 ? b2 : 0u); m1 |= ((n1 >> 5) == 1 ? b1 : 0u) | ((n2 >> 5) == 1 ? b2 : 0u);
              m2 |= ((n1 >> 5) == 2 ? b1 : 0u) | ((n2 >> 5) == 2 ? b2 : 0u); m3 |= ((n1 >> 5) == 3 ? b1 : 0u) | ((n2 >> 5) == 3 ? b2 : 0u); }
        }
        if (slot8 == 0) { selm[tl * 4 + 0] = m0; selm[tl * 4 + 1] = m1; selm[tl * 4 + 2] = m2; selm[tl * 4 + 3] = m3; }
    }
    LDS_WAIT();
    __syncthreads();
    const bool sparse = i >= 16;
    LAS float* mrefs = (LAS float*)(F.lds + L_MREF); LAS float* lacc = (LAS float*)(F.lds + L_LACC); LAS float* oacc = (LAS float*)(F.lds + L_OACC);
    LAS int* cnt = (LAS int*)(F.lds + L_CNT); LAS int* off = cnt + 128; LAS unsigned short* items = (LAS unsigned short*)(F.lds + L_ITEMS);
    LAS unsigned char* tokl = F.lds + L_TOKL;
    if (sparse) {
        if (tid < 128) { const int n = tid; int c = 0;
            if (n >= 1 && n <= i - 2) { const int wd = n >> 5, bt = n & 31;
                for (int t = 0; t < 64; ++t) if ((selm[t * 4 + wd] >> bt) & 1u) { tokl[n * 64 + c] = (unsigned char)t; ++c; } }
            cnt[n] = c; }
        for (int x = tid; x < 256 * 64 / 4; x += NWAVES * 64) ((LAS f32x4*)oacc)[x] = (f32x4){0.f, 0.f, 0.f, 0.f};
        if (tid < 256) lacc[tid] = 0.f;
        __syncthreads();
        if (tid == 0) {
            int nr = 0, n = 1;
            while (n <= i - 2) { int nb = 0, tl = 0; const int n0 = n;
                while (n <= i - 2 && nb < 4 && tl < 8) { tl += (cnt[n] + 7) >> 3; ++nb; ++n; }
                items[nr++] = (unsigned short)(n0 | (nb << 8)); }
            off[128] = nr; }
    }
    const bf16* Kb = U + (size_t)b * SEQ * DINP + C_KS + g * 64; const bf16* Vb = U + (size_t)b * SEQ * DINP + C_VS + g * 64;
    st.mhat = NEGBIG; st.lsum = 0.f; st.o0 = (f32x16){}; st.o1 = (f32x16){};
    const int nd = sparse ? 3 : i + 1;
    load_q(qr, U, tok0, g, w, r32, hi);
    { const KVRegs r0 = kv_load(Kb, Vb, DINP, 0, w, lane); kv_store(kv, r0, tid); }
    __syncthreads();
    for (int sdx = 0; sdx < nd; ++sdx) {
        const int n = sparse ? (sdx == 0 ? 0 : i - 2 + sdx) : sdx;
        LAS unsigned char* slot = kv + (sdx & 1) * 16384;
        KVRegs nx; if (sdx + 1 < nd) { const int nn = sparse ? (i - 1 + sdx) : sdx + 1; nx = kv_load(Kb, Vb, DINP, nn * 64, w, lane); }
        f32x16 p0, p1; qk_tile(slot, qr, p0, p1, r32, hi);
        const int dist0 = tq - 64 * n;
        if (i - n <= 2) { bias_mask<true>(p0, p1, tbh, dist0, 1, 0, 0x7fffffff, true, hi); softmax_pv(st, p0, p1, slot + 8192, wsf, lane, r32, hi); }
        else softmax_pv_fast(st, p0, p1, C2S, tbh[127], slot + 8192, wsf, lane, r32, hi);
        if (sdx + 1 < nd) kv_store(kv + ((sdx + 1) & 1) * 16384, nx, tid);
        __syncthreads();
    }
    if (sparse) {
        if (hi == 0) mrefs[32 * w + r32] = st.mhat;
#pragma unroll
        for (int r = 0; r < 16; ++r) { park[(16 + r) * 64] = __float_as_uint(st.o0[r]); park[(32 + r) * 64] = __float_as_uint(st.o1[r]); }
        __syncthreads();
        const int NR = off[128];
        KVRegs pf0, pf1, pf2, pf3;
        { const int rr = items[0], n0 = rr & 255, nb = rr >> 8;
          pf0 = kv_load(Kb, Vb, DINP, 64 * n0, w, lane); if (nb > 1) pf1 = kv_load(Kb, Vb, DINP, 64 * (n0 + 1), w, lane);
          if (nb > 2) pf2 = kv_load(Kb, Vb, DINP, 64 * (n0 + 2), w, lane); if (nb > 3) pf3 = kv_load(Kb, Vb, DINP, 64 * (n0 + 3), w, lane); }
        for (int rd = 0; rd < NR; ++rd) {
            const int rr = __builtin_amdgcn_readfirstlane((int)items[rd]); const int n0 = rr & 255, nb = rr >> 8;
            kv_store(F.lds + L_KV, pf0, tid); if (nb > 1) kv_store(F.lds + L_KV + 16384, pf1, tid);
            if (nb > 2) kv_store(F.lds + L_SL2, pf2, tid); if (nb > 3) kv_store(F.lds + L_SL2 + 16384, pf3, tid);
            __syncthreads();
            if (rd + 1 < NR) { const int r2 = __builtin_amdgcn_readfirstlane((int)items[rd + 1]); const int m0 = r2 & 255, mb = r2 >> 8;
                pf0 = kv_load(Kb, Vb, DINP, 64 * m0, w, lane); if (mb > 1) pf1 = kv_load(Kb, Vb, DINP, 64 * (m0 + 1), w, lane);
                if (mb > 2) pf2 = kv_load(Kb, Vb, DINP, 64 * (m0 + 2), w, lane); if (mb > 3) pf3 = kv_load(Kb, Vb, DINP, 64 * (m0 + 3), w, lane); }
            const int t0c = (__builtin_amdgcn_readfirstlane(cnt[n0]) + 7) >> 3;
            const int t1c = nb > 1 ? (__builtin_amdgcn_readfirstlane(cnt[n0 + 1]) + 7) >> 3 : 0;
            const int t2c = nb > 2 ? (__builtin_amdgcn_readfirstlane(cnt[n0 + 2]) + 7) >> 3 : 0;
            const int t3c = nb > 3 ? (__builtin_amdgcn_readfirstlane(cnt[n0 + 3]) + 7) >> 3 : 0;
            const int tot = t0c + t1c + t2c + t3c;
            for (int t = w; t < tot; t += NWAVES) {
                int sidx, k;
                if (t < t0c) { sidx = 0; k = t; } else if (t < t0c + t1c) { sidx = 1; k = t - t0c; } else if (t < t0c + t1c + t2c) { sidx = 2; k = t - t0c - t1c; } else { sidx = 3; k = t - t0c - t1c - t2c; }
                const int n = n0 + sidx; const LAS unsigned char* slot = F.lds + (sidx < 2 ? L_KV + sidx * 16384 : L_SL2 + (sidx - 2) * 16384);
                const int cn = __builtin_amdgcn_readfirstlane(cnt[n]);
                const int sl = 8 * k + (r32 >> 2); const bool rowok = sl < cn;
                const int tokq = tokl[n * 64 + (rowok ? sl : 0)]; const int row = tokq * 4 + (r32 & 3);
                bf16x8 q2[4];
                { const bf16* qp = U + (tok0 + tokq) * DINP + C_QN + (4 * g + (r32 & 3)) * 64 + 8 * hi;
#pragma unroll
                  for (int d0 = 0; d0 < 4; ++d0) q2[d0] = *(const bf16x8*)(qp + 16 * d0); }
                f32x16 p0, p1; qk_tile(slot, q2, p0, p1, r32, hi);
                const float mref = mrefs[row];
                if (n == i - 2) { bias_mask<true>(p0, p1, tbh, 64 * i + tokq - 64 * n, 1, 0, 0x7fffffff, rowok, hi);
#pragma unroll
                    for (int r = 0; r < 16; ++r) { p0[r] = __builtin_amdgcn_exp2f(fminf(p0[r] - mref, 100.f)); p1[r] = __builtin_amdgcn_exp2f(fminf(p1[r] - mref, 100.f)); } }
                else { const float sc = rowok ? C2S : 0.f, nbv = rowok ? tbh[127] - mref : NEGBIG;
#pragma unroll
                    for (int r = 0; r < 16; ++r) { p0[r] = __builtin_amdgcn_exp2f(fminf(__builtin_fmaf(p0[r], sc, nbv), 100.f)); p1[r] = __builtin_amdgcn_exp2f(fminf(__builtin_fmaf(p1[r], sc, nbv), 100.f)); } }
                { float sm = 0.f;
#pragma unroll
                  for (int r = 0; r < 16; ++r) sm += p0[r] + p1[r];
                  float t1; const float t0 = swap_lo(sm, t1);
                  if (hi == 0 && rowok) (void)__hip_atomic_fetch_add(lacc + row, t0 + t1, __ATOMIC_RELAXED, __HIP_MEMORY_SCOPE_WORKGROUP); }
                SmState s2; s2.o0 = (f32x16){}; s2.o1 = (f32x16){};
                pv_tail(s2, p0, p1, slot + 8192, lane);
#pragma unroll
                for (int a = 0; a < 4; ++a) { const int sa = 8 * k + 2 * a + hi;
                    if (sa < cn) { const int ta = tokl[n * 64 + sa];
#pragma unroll
                        for (int e = 0; e < 4; ++e) { LAS float* dst = oacc + (ta * 4 + e) * 64 + r32;
                            (void)__hip_atomic_fetch_add(dst, s2.o0[4 * a + e], __ATOMIC_RELAXED, __HIP_MEMORY_SCOPE_WORKGROUP);
                            (void)__hip_atomic_fetch_add(dst + 32, s2.o1[4 * a + e], __ATOMIC_RELAXED, __HIP_MEMORY_SCOPE_WORKGROUP); } } }
            }
            __syncthreads();
        }
        __syncthreads();
        if (hi == 0) st.lsum += lacc[32 * w + r32];
#pragma unroll
        for (int r = 0; r < 16; ++r) { const LAS float* src = oacc + (32 * w + crow(r, hi)) * 64 + r32;
            st.o0[r] = __uint_as_float(park[(16 + r) * 64]) + src[0]; st.o1[r] = __uint_as_float(park[(32 + r) * 64]) + src[32]; }
    }
    finish_rows(st, wsf, r32, hi, false);
    const bf16* OW = (const bf16*)(F.ws + WS_OW); bf16* MIX = (bf16*)(F.ws + WS_MIX);
    { const bf16* gp = U + (tok0 + tql) * DINP + C_GN + (4 * g + (r32 & 3)) * 3;
      const float g1 = sigmoidf2(bflo((unsigned)gp[1]));
      if (hi == 0) wsf[r32] = g1;
      LDS_WAIT();
#pragma unroll
      for (int r = 0; r < 16; ++r) { const float g1r = wsf[crow(r, hi)]; const unsigned oc = park[r * 64]; st.o0[r] = bflo(oc) + g1r * st.o0[r]; st.o1[r] = bfhi(oc) + g1r * st.o1[r]; } }
    LDS_WAIT();
    LAS bf16* stg = (LAS bf16*)(F.lds + L_IMP) + w * 2048;
    stage_tile(stg, st.o0, st.o1, r32, hi);
    LDS_WAIT();
#pragma unroll
    for (int it = 0; it < 4; ++it) { const int row = it * 8 + (lane >> 3), ch = lane & 7;
        const size_t tk = tok0 + 8 * w + (row >> 2); const int hd = 4 * g + (row & 3), col = hd * 64 + ch * 8;
        const v4u t = *(const LAS v4u*)(stg + row * 64 + ch * 8);
        const v4u ow = *(const v4u*)(OW + tk * 512 + col); const v4u zz = *(const v4u*)(U + tk * DINP + C_ZN + col);
        const float g2 = sigmoidf2(bflo((unsigned)U[tk * DINP + C_GN + hd * 3 + 2]));
        const unsigned tw[4] = {t.x, t.y, t.z, t.w}, oww[4] = {ow.x, ow.y, ow.z, ow.w}, zw[4] = {zz.x, zz.y, zz.z, zz.w}; unsigned ov[4];
#pragma unroll
        for (int e = 0; e < 4; ++e) { const float z0 = bflo(zw[e]), z1 = bfhi(zw[e]);
            const float y0 = (bflo(tw[e]) + g2 * bflo(oww[e])) * z0 * sigmoidf2(z0), y1 = (bfhi(tw[e]) + g2 * bfhi(oww[e])) * z1 * sigmoidf2(z1);
            ov[e] = cvtpk(y0, y1); }
        *(v4u*)(MIX + tk * DM + col) = (v4u){ov[0], ov[1], ov[2], ov[3]}; }
    __syncthreads();
}
template <class AT> __device__ __forceinline__ void p2_phase(Frame& F, const AT& A) {
    const int gw = F.vcu * NWAVES + F.wave, NGW = F.G * NWAVES;
    build_bias_table(F, A.in[I_RELB]);
    __syncthreads();
    for (int u = F.vcu; u < BATCH * NSA_G * 128; u += F.G) window_unit(F, u);
    __syncthreads();
    for (int u = F.vcu; u < 512; u += F.G) compress_unit(F, u);
    __syncthreads();
    LAS unsigned char* wl = F.lds + RING_OFF + F.wave * 16384;
    for (int cid = gw; cid < BATCH * GLA_H * NCHUNK; cid += NGW) gla_pass_a(F, A.in[I_BA], cid, wl);
}
constexpr int CW_Q = 200000;
template <class AT> __device__ __forceinline__ void p3_phase(Frame& F, const AT& A) {
    build_bias_table(F, A.in[I_RELB]);
    const int xq = (F.vcu >> 5) & 7;
    volatile LAS unsigned* bc = F.MISC + 16;
    if (F.tid == 0) bc[0] = __hip_atomic_fetch_add(F.ctl + CW_Q + 64 * xq, 1u, RLX_AGENT);
    __syncthreads();
    { const int item = (int)bc[0];
      if (item < 4) gla_scan_unit(F, A.in[I_GNW], 4 * xq + item, (LAS float*)(F.lds + RING_OFF)); }
    __syncthreads();
    for (;;) {
        if (F.tid == 0) bc[1] = __hip_atomic_fetch_add(F.ctl + CW_Q + 64 * (8 + xq), 1u, RLX_AGENT);
        __syncthreads();
        const int k = (int)bc[1];
        __syncthreads();
        if (k >= 256) break;
        nsa_unit(F, (2 * xq + (k & 1)) * 128 + 127 - (k >> 1));
    }
}
constexpr int N_LAUNCHES = MK_N_LAUNCHES;
constexpr int PER_PHASE = 7;
struct Args { const float* in[22]; float* out; unsigned char* ws; int ph_lo, ph_hi, li, pad; };
__global__ void __launch_bounds__(NWAVES * 64, 2) hymba_fwd(Args args) {
    extern __shared__ __attribute__((aligned(16))) unsigned char lds[];
    Frame F;
    F.lds = (LAS unsigned char*)lds;
    F.MISC = (volatile LAS unsigned*)(F.lds + MISC_OFF);
    F.tid = threadIdx.x; F.lane = F.tid & 63; F.wave = __builtin_amdgcn_readfirstlane(F.tid >> 6);
    F.G = gridDim.x; { const int bx = blockIdx.x; F.vcu = (F.G % 8 == 0) ? (bx % 8) * (F.G / 8) + bx / 8 : bx; }
    unsigned char* ws = args.ws; F.ws = ws; F.out = args.out;
    F.ctl = (gu32*)(ws + WS_CTL);
    for (int u = F.tid; u < (LDS_BYTES - LDSCTL_OFF) / 4; u += NWAVES * 64) ((LAS unsigned*)(F.lds + LDSCTL_OFF))[u] = 0u;
    __syncthreads();
    XcdBarrier bar; bar.bar = (unsigned*)(F.ctl + CW_BAR) + args.li * XCD_BAR_WORDS; bar.x = 0; bar.st = nullptr;
    if (N_LAUNCHES != PER_PHASE) bar = xcd_barrier_post((unsigned*)(F.ctl + CW_BAR) + args.li * XCD_BAR_WORDS, F.MISC + 8);
#define GRID_BAR() do { if (N_LAUNCHES != PER_PHASE) xcd_barrier(bar); } while (0)
    const int lo = args.ph_lo, hi = args.ph_hi;
#define IN(k) (lo <= (k) && (k) < hi)
#define REFRESH() do { int t_ = threadIdx.x; asm volatile("" : "+v"(t_)); F.tid = t_; F.lane = t_ & 63; } while (0)
#define BOTH(k) (IN(k) && IN((k) + 1))

    if (IN(0)) { REFRESH(); p0_prologue(F, args); if (BOTH(0)) GRID_BAR(); }
    if (IN(1)) { REFRESH();
        pg8::Gemm g{(const pg8::bf16_t*)(ws + WS_XN), (const pg8::bf16_t*)(ws + WS_WIN), M, DINP, DM}; pg8::StaticOrder S; S.init(M, DINP, F.G, (int)blockIdx.x);
        pg8::EpiBf16 E{(pg8::bf16_t*)(ws + WS_U), DINP};
        pg8::gemm_phase<pg8::EpiBf16, pg8::StaticOrder, true, true>(F.lds + RING_OFF, g, S, E);
        if (BOTH(1)) GRID_BAR();
    }
    if (IN(2)) { REFRESH();
        p2_phase(F, args);
        if (BOTH(2)) GRID_BAR();
    }
    if (IN(3)) { REFRESH();
        p3_phase(F, args);
        if (BOTH(3)) GRID_BAR();
    }
    if (IN(4)) { REFRESH();
        { pg8::Gemm g{(const pg8::bf16_t*)(ws + WS_MIX), (const pg8::bf16_t*)(ws + WS_WOUT), M, DM, DM}; pg8::StaticOrder S; S.init(M, DM, F.G, (int)blockIdx.x);
          pg8::EpiResid E{args.in[I_X], (const float*)(ws + WS_STATS), args.in[I_LN0G], args.in[I_LN0B], F.out, (pg8::bf16_t*)(ws + WS_RB), ALPHA_};
          pg8::gemm_phase<pg8::EpiResid, pg8::StaticOrder, true, true>(F.lds + RING_OFF, g, S, E); }
        { pg8::Gemm g{(const pg8::bf16_t*)(ws + WS_PB), (const pg8::bf16_t*)(ws + WS_WPE), M, DM, PLE}; pg8::StaticOrder S; S.init(M, DM, F.G, (int)blockIdx.x);
          pg8::EpiBf16 E{(pg8::bf16_t*)(ws + WS_EB), DM};
          pg8::gemm_phase<pg8::EpiBf16, pg8::StaticOrder, true, true>(F.lds + RING_OFF, g, S, E); }
        if (BOTH(4)) GRID_BAR();
    }
    if (IN(5)) { REFRESH();
        pg8::Gemm g{(const pg8::bf16_t*)(ws + WS_RB), (const pg8::bf16_t*)(ws + WS_WPG), M, DM, DM}; pg8::StaticOrder S; S.init(M, DM, F.G, (int)blockIdx.x);
        pg8::EpiGate E{F.out, (const pg8::bf16_t*)(ws + WS_EB), args.in[I_BPG]};
        pg8::gemm_phase<pg8::EpiGate, pg8::StaticOrder, true, true>(F.lds + RING_OFF, g, S, E);
        if (BOTH(5)) GRID_BAR();
    }
    if (IN(6)) { REFRESH(); final_ln(F, args.in[I_LNG], args.in[I_LNB]); }
#undef IN
#undef BOTH
}

extern "C" void kernel_launch(void* const* d_in, const int* in_sizes, int n_in, void* d_out, int out_size, void* d_ws, size_t ws_size, hipStream_t stream) {
    static int grid = 0;
    if (grid == 0) {
        if (n_in != 22 || out_size != M * DM || ws_size < WS_END) { fprintf(stderr, "kernel_launch: unexpected shapes (n_in %d out %d ws %zu)\n", n_in, out_size, ws_size); grid = -1; return; }
        int dev = 0, cus = 0, per_cu = 0;
        if (hipGetDevice(&dev) != hipSuccess || hipDeviceGetAttribute(&cus, hipDeviceAttributeMultiprocessorCount, dev) != hipSuccess) { grid = -1; return; }
        if (hipFuncSetAttribute((const void*)hymba_fwd, hipFuncAttributeMaxDynamicSharedMemorySize, LDS_BYTES) != hipSuccess) { fprintf(stderr, "kernel_launch: hipFuncSetAttribute failed\n"); grid = -1; return; }
        if (hipOccupancyMaxActiveBlocksPerMultiprocessor(&per_cu, (const void*)hymba_fwd, NWAVES * 64, LDS_BYTES) != hipSuccess || per_cu < 1)
            fprintf(stderr, "kernel_launch: occupancy query reports %d workgroups per CU\n", per_cu);
        (void)hipGetLastError();
        grid = cus;
    }
    if (grid < 0) return;
    (void)hipMemsetAsync((char*)d_ws + WS_CTL, 0, CTL_ZERO_BYTES, stream);
    Args a{};
    for (int i = 0; i < 22; ++i) a.in[i] = (const float*)d_in[i];
    a.out = (float*)d_out; a.ws = (unsigned char*)d_ws;
#ifdef PROBE_SEQ
    { const int seq[][2] = PROBE_SEQ; const int nseq = (int)(sizeof(seq) / sizeof(seq[0]));
      for (int li = 0; li < nseq; ++li) { a.ph_lo = seq[li][0]; a.ph_hi = seq[li][1]; a.li = li; hipLaunchKernelGGL(hymba_fwd, dim3(grid), dim3(NWAVES * 64), LDS_BYTES, stream, a); } }
#else
    if (N_LAUNCHES == 1) { a.ph_lo = 0; a.ph_hi = PER_PHASE; a.li = 0; hipLaunchKernelGGL(hymba_fwd, dim3(grid), dim3(NWAVES * 64), LDS_BYTES, stream, a); }
    else for (int li = 0; li < PER_PHASE; ++li) { a.ph_lo = li; a.ph_hi = li + 1; a.li = 0; hipLaunchKernelGGL(hymba_fwd, dim3(grid), dim3(NWAVES * 64), LDS_BYTES, stream, a); }
#endif
}
```

```cpp
#include <hip/hip_runtime.h>
#include <hip/hip_bf16.h>
#include <cstdio>
#include <cstdint>
namespace pg8 {
#define PG8_LAS __attribute__((address_space(3)))
typedef unsigned short bf16_t;
typedef short bf16x8 __attribute__((ext_vector_type(8)));
typedef float f32x4 __attribute__((ext_vector_type(4)));
typedef unsigned u32x4 __attribute__((ext_vector_type(4)));
constexpr int BM = 256, BK = 64, HALF = 128, HTB = HALF * BK * 2  , STAGE_BYTES = 8 * HTB, NXCD = 8, WGM = 8;

__host__ __device__ __forceinline__ int lds_byte(int r, int c) { const int st = (r >> 4) * 2 + (c >> 5), rr = r & 15, cc = c & 31, ob = rr * 64 + cc * 2; return st * 1024 + (ob ^ (((ob >> 9) & 1) << 5)); }
__host__ __device__ __forceinline__ void stage_rc(int b, int& R, int& C) { const int st = b / 1024, sb = b % 1024, swz = sb ^ (((sb >> 9) & 1) << 5); R = (st >> 1) * 16 + swz / 64; C = (st & 1) * 32 + (swz % 64) / 2; }
__host__ __device__ __forceinline__ int perm32(int rho) { const int n = rho >> 4, i = rho & 15; return 8 * (i >> 2) + 4 * n + (i & 3); }

struct Unit { int pm, pn; };
struct Gemm { const bf16_t* A; const bf16_t* Bt; int M, N, K; };

struct StaticOrder {
    int nM, nN, nwg, G, c;
    __host__ __device__ void init(int M, int N, int G_, int c_) { nM = M / BM; nN = N / BM; nwg = nM * nN; G = G_; c = c_; }
    __host__ __device__ bool next(int i, Unit& u) const {
        const long L = (long)i * G + c; if (L >= nwg) return false;
        int wgid = (int)L; { const int q = nwg / NXCD, r = nwg % NXCD, xcd = wgid % NXCD, off = wgid / NXCD; wgid = (xcd < r ? xcd * (q + 1) : r * (q + 1) + (xcd - r) * q) + off; }
        const int nig = WGM * nN, gid = wgid / nig, fm = gid * WGM, gsz = (nM - fm) < WGM ? (nM - fm) : WGM;
        u.pm = fm + ((wgid % nig) % gsz); u.pn = (wgid % nig) / gsz; return true;
    }
    __device__ __forceinline__ void a_ready(const Unit&) const {}
    __device__ __forceinline__ void done(const Unit&) const {}
};
__device__ __forceinline__ unsigned cvt_pk_bf16(float lo, float hi) { unsigned r; asm volatile("v_cvt_pk_bf16_f32 %0, %1, %2" : "=v"(r) : "v"(lo), "v"(hi)); return r; }
struct EpiBf16 {
    static constexpr bool PERM = true, AFTER_DRAIN = false;
    bf16_t* O; int ldc;
    __device__ __forceinline__ void operator()(const f32x4 (&acc)[2][2][4][2], const Unit& u, int wr, int wc, int fr, int fq) const {
        const int row0 = u.pm * BM + wr * 64 + fr; const int col0 = u.pn * BM + wc * 32 + 8 * fq;
#pragma unroll
        for (int ai = 0; ai < 2; ++ai)
#pragma unroll
            for (int m = 0; m < 4; ++m) { bf16_t* rowp = O + (size_t)(row0 + ai * HALF + m * 16) * ldc + col0;
#pragma unroll
                for (int bj = 0; bj < 2; ++bj) { const f32x4 v0 = acc[ai][bj][m][0], v1 = acc[ai][bj][m][1];
                    u32x4 w; w.x = cvt_pk_bf16(v0[0], v0[1]); w.y = cvt_pk_bf16(v0[2], v0[3]); w.z = cvt_pk_bf16(v1[0], v1[1]); w.w = cvt_pk_bf16(v1[2], v1[3]);
                    *(u32x4*)(rowp + bj * HALF) = w; } }
    }
};
struct EpiResid {
    static constexpr bool PERM = true, AFTER_DRAIN = false;
    const float* x; const float* stats; const float* g; const float* b; float* out; bf16_t* rb; float alpha;
    __device__ __forceinline__ void operator()(const f32x4 (&acc)[2][2][4][2], const Unit& u, int wr, int wc, int fr, int fq) const {
        const int row0 = u.pm * BM + wr * 64 + fr; const int col0 = u.pn * BM + wc * 32 + 8 * fq;
        f32x4 gv[2][2], bv[2][2];
#pragma unroll
        for (int bj = 0; bj < 2; ++bj)
#pragma unroll
            for (int n = 0; n < 2; ++n) { gv[bj][n] = *(const f32x4*)(g + col0 + bj * HALF + 4 * n) * alpha; bv[bj][n] = *(const f32x4*)(b + col0 + bj * HALF + 4 * n) * alpha; }
#pragma unroll
        for (int ai = 0; ai < 2; ++ai)
#pragma unroll
            for (int m = 0; m < 4; ++m) { const int row = row0 + ai * HALF + m * 16; const size_t off = (size_t)row * 1024 + col0;
                const float mean = stats[2 * row], rstd = stats[2 * row + 1];
#pragma unroll
                for (int bj = 0; bj < 2; ++bj) {
                    const f32x4 x0 = *(const f32x4*)(x + off + bj * HALF), x1 = *(const f32x4*)(x + off + bj * HALF + 4);
                    const f32x4 v0 = ((x0 - mean) * rstd) * gv[bj][0] + bv[bj][0] + acc[ai][bj][m][0];
                    const f32x4 v1 = ((x1 - mean) * rstd) * gv[bj][1] + bv[bj][1] + acc[ai][bj][m][1];
                    *(f32x4*)(out + off + bj * HALF) = v0; *(f32x4*)(out + off + bj * HALF + 4) = v1;
                    u32x4 w; w.x = cvt_pk_bf16(v0[0], v0[1]); w.y = cvt_pk_bf16(v0[2], v0[3]); w.z = cvt_pk_bf16(v1[0], v1[1]); w.w = cvt_pk_bf16(v1[2], v1[3]);
                    *(u32x4*)(rb + off + bj * HALF) = w; } }
    }
};
__device__ __forceinline__ float bf_lo(unsigned w) { return __uint_as_float(w << 16); }
__device__ __forceinline__ float bf_hi(unsigned w) { return __uint_as_float(w & 0xffff0000u); }
__device__ __forceinline__ float sigmoidf_(float v) { return __builtin_amdgcn_rcpf(1.0f + __builtin_amdgcn_exp2f(-1.4426950408889634f * v)); }
struct EpiGate {
    static constexpr bool PERM = true, AFTER_DRAIN = false;
    float* out; const bf16_t* E; const float* bias;
    __device__ __forceinline__ void operator()(const f32x4 (&acc)[2][2][4][2], const Unit& u, int wr, int wc, int fr, int fq) const {
        const int row0 = u.pm * BM + wr * 64 + fr; const int col0 = u.pn * BM + wc * 32 + 8 * fq;
        f32x4 bv[2][2];
#pragma unroll
        for (int bj = 0; bj < 2; ++bj)
#pragma unroll
            for (int n = 0; n < 2; ++n) bv[bj][n] = *(const f32x4*)(bias + col0 + bj * HALF + 4 * n);
#pragma unroll
        for (int ai = 0; ai < 2; ++ai)
#pragma unroll
            for (int m = 0; m < 4; ++m) { const int row = row0 + ai * HALF + m * 16; const size_t off = (size_t)row * 1024 + col0;
#pragma unroll
                for (int bj = 0; bj < 2; ++bj) {
                    const f32x4 r0 = *(const f32x4*)(out + off + bj * HALF), r1 = *(const f32x4*)(out + off + bj * HALF + 4);
                    const u32x4 e = *(const u32x4*)(E + off + bj * HALF);
                    const f32x4 a0 = acc[ai][bj][m][0] + bv[bj][0], a1 = acc[ai][bj][m][1] + bv[bj][1];
                    f32x4 v0, v1;
                    v0[0] = r0[0] + sigmoidf_(a0[0]) * bf_lo(e.x); v0[1] = r0[1] + sigmoidf_(a0[1]) * bf_hi(e.x);
                    v0[2] = r0[2] + sigmoidf_(a0[2]) * bf_lo(e.y); v0[3] = r0[3] + sigmoidf_(a0[3]) * bf_hi(e.y);
                    v1[0] = r1[0] + sigmoidf_(a1[0]) * bf_lo(e.z); v1[1] = r1[1] + sigmoidf_(a1[1]) * bf_hi(e.z);
                    v1[2] = r1[2] + sigmoidf_(a1[2]) * bf_lo(e.w); v1[3] = r1[3] + sigmoidf_(a1[3]) * bf_hi(e.w);
                    *(f32x4*)(out + off + bj * HALF) = v0; *(f32x4*)(out + off + bj * HALF + 4) = v1; } }
    }
};
template <class Epi, class Sched, bool ALIGN_EPI = false, bool SP2 = false>
__device__ __forceinline__ void gemm_phase(PG8_LAS unsigned char* lds, const Gemm g, const Sched& S, const Epi& E) {
    const int tid = threadIdx.x, wid = __builtin_amdgcn_readfirstlane(tid >> 6), lane = tid & 63, wr = wid >> 2, wc = wid & 3, fr = lane & 15, fq = lane >> 4;
    const int K = g.K, nt = K / BK;
    unsigned voffA[2], voffB[2];
#pragma unroll
    for (int i = 0; i < 2; ++i) { int R, C; stage_rc(tid * 16 + i * 8192, R, C); const int Rb = Epi::PERM ? ((R & ~31) + perm32(R & 31)) : R;
        voffA[i] = (unsigned)(R * K + C) * 2u; voffB[i] = (unsigned)(Rb * K + C) * 2u; }
    const size_t kstep = (size_t)(BK * 2);
    const size_t hstep = (size_t)HALF * K * 2;
    const size_t tstep = 2 * hstep;
    const unsigned ldsw = (unsigned)wid * 1024u;
    const int aoff = lds_byte(wr * 64 + fr, fq * 8), boff = lds_byte(wc * 32 + fr, fq * 8);
#define PG8_SA(b, h) (((b) * 2 + (h)) * HTB)
#define PG8_SB(b, h) ((4 + (b) * 2 + (h)) * HTB)
#define PG8_STAGE(bufoff, gbase, voff) do { _Pragma("unroll") for (int _i = 0; _i < 2; ++_i) \
        __builtin_amdgcn_global_load_lds((const unsigned*)((const char*)(gbase) + (voff)[_i]), (PG8_LAS unsigned*)(lds + (bufoff) + ldsw + _i * 8192), 16, 0, 0); } while (0)
#define PG8_LDA(dst, b, h) do { _Pragma("unroll") for (int m = 0; m < 4; ++m) _Pragma("unroll") for (int k = 0; k < 2; ++k) dst[m][k] = *(const PG8_LAS bf16x8*)(lds + PG8_SA(b, h) + aoff + m * 2048 + k * 1024); } while (0)
#define PG8_LDB(dst, b, h) do { _Pragma("unroll") for (int n = 0; n < 2; ++n) _Pragma("unroll") for (int k = 0; k < 2; ++k) dst[n][k] = *(const PG8_LAS bf16x8*)(lds + PG8_SB(b, h) + boff + n * 2048 + k * 1024); } while (0)
#define PG8_MMA(ai, bj, At, Bt) do { __builtin_amdgcn_s_setprio(1); _Pragma("unroll") for (int m = 0; m < 4; ++m) _Pragma("unroll") for (int n = 0; n < 2; ++n) _Pragma("unroll") for (int k = 0; k < 2; ++k) \
        acc[ai][bj][m][n] = __builtin_amdgcn_mfma_f32_16x16x32_bf16(Bt[n][k], At[m][k], acc[ai][bj][m][n], 0, 0, 0); __builtin_amdgcn_s_setprio(0); } while (0)
#define PG8_WAIT_V(n) asm volatile("s_waitcnt vmcnt(" #n ")" ::: "memory")
#define PG8_WAIT_L(n) asm volatile("s_waitcnt lgkmcnt(" #n ")" ::: "memory")
#define PG8_BAR __builtin_amdgcn_s_barrier()
#define PG8_SCHED __builtin_amdgcn_sched_barrier(0)
    Unit cur, nxt; int ui = 0;
    if (!S.next(0, cur)) return;
    f32x4 acc[2][2][4][2];
#pragma unroll
    for (int a = 0; a < 2; ++a)
#pragma unroll
        for (int b = 0; b < 2; ++b)
#pragma unroll
            for (int m = 0; m < 4; ++m)
#pragma unroll
                for (int n = 0; n < 2; ++n) acc[a][b][m][n] = (f32x4){0.f, 0.f, 0.f, 0.f};
    bf16x8 At[4][2], B0[2][2], B1[2][2];
    const char* cA = (const char*)g.A + (size_t)cur.pm * tstep; const char* cB = (const char*)g.Bt + (size_t)cur.pn * tstep;
    S.a_ready(cur);
    if constexpr (SP2) {
        PG8_STAGE(PG8_SB(0, 0), cB, voffB); PG8_STAGE(PG8_SB(0, 1), cB + hstep, voffB); PG8_STAGE(PG8_SA(0, 0), cA, voffA); PG8_STAGE(PG8_SA(0, 1), cA + hstep, voffA);
        if (wr == 1) PG8_BAR;
        PG8_WAIT_V(2); PG8_BAR;
        PG8_STAGE(PG8_SB(1, 0), cB + kstep, voffB); PG8_STAGE(PG8_SA(1, 0), cA + kstep, voffA); PG8_STAGE(PG8_SB(1, 1), cB + hstep + kstep, voffB);
        PG8_WAIT_V(6); PG8_BAR;
    } else {
        PG8_STAGE(PG8_SB(0, 0), cB, voffB); PG8_STAGE(PG8_SA(0, 0), cA, voffA); PG8_STAGE(PG8_SB(0, 1), cB + hstep, voffB); PG8_STAGE(PG8_SA(0, 1), cA + hstep, voffA);
        if (wr == 1) PG8_BAR;
        PG8_WAIT_V(4); PG8_BAR;
        PG8_STAGE(PG8_SB(1, 0), cB + kstep, voffB); PG8_STAGE(PG8_SA(1, 0), cA + kstep, voffA); PG8_STAGE(PG8_SB(1, 1), cB + hstep + kstep, voffB);
        PG8_WAIT_V(6); PG8_BAR;
    }
    for (;;) {
        const bool has_next = S.next(ui + 1, nxt);
        const char* nA = has_next ? (const char*)g.A + (size_t)nxt.pm * tstep : cA; const char* nB = has_next ? (const char*)g.Bt + (size_t)nxt.pn * tstep : cB;
        for (int t = 0; t < nt; t += 2) {
            const bool last = (t == nt - 2);
            const char* a1 = cA + (size_t)(t + 1) * kstep;
            const char* a2 = last ? nA : cA + (size_t)(t + 2) * kstep; const char* b2 = last ? nB : cB + (size_t)(t + 2) * kstep;
            const char* a3 = a2 + kstep; const char* b3 = b2 + kstep;
            if (last && has_next) S.a_ready(nxt);
            if constexpr (SP2) {
            PG8_LDB(B0, 0, 0); PG8_LDB(B1, 0, 1); PG8_SCHED; PG8_LDA(At, 0, 0); PG8_STAGE(PG8_SA(1, 1), a1 + hstep, voffA);
            PG8_WAIT_V(8); PG8_WAIT_L(0); PG8_BAR; PG8_MMA(0, 0, At, B0); PG8_MMA(0, 1, At, B1); PG8_BAR; PG8_SCHED;
            PG8_LDA(At, 0, 1); PG8_STAGE(PG8_SB(0, 0), b2, voffB); PG8_STAGE(PG8_SB(0, 1), b2 + hstep, voffB); PG8_STAGE(PG8_SA(0, 0), a2, voffA);
            PG8_WAIT_V(8); PG8_WAIT_L(0); PG8_BAR; PG8_MMA(1, 0, At, B0); PG8_MMA(1, 1, At, B1); PG8_BAR; PG8_SCHED;
            PG8_LDB(B0, 1, 0); PG8_LDB(B1, 1, 1); PG8_SCHED; PG8_LDA(At, 1, 0); PG8_STAGE(PG8_SA(0, 1), a2 + hstep, voffA);
            PG8_WAIT_V(8); PG8_WAIT_L(0); PG8_BAR; PG8_MMA(0, 0, At, B0); PG8_MMA(0, 1, At, B1); PG8_BAR; PG8_SCHED;
            PG8_LDA(At, 1, 1); PG8_STAGE(PG8_SB(1, 0), b3, voffB); PG8_STAGE(PG8_SB(1, 1), b3 + hstep, voffB); PG8_STAGE(PG8_SA(1, 0), a3, voffA);
            PG8_WAIT_V(8); PG8_WAIT_L(0); PG8_BAR; PG8_MMA(1, 0, At, B0); PG8_MMA(1, 1, At, B1); PG8_BAR; PG8_SCHED;
            } else {
            PG8_LDB(B0, 0, 0); PG8_SCHED; PG8_LDA(At, 0, 0); PG8_STAGE(PG8_SA(1, 1), a1 + hstep, voffA);
            PG8_WAIT_L(8); PG8_BAR; PG8_WAIT_L(0); PG8_MMA(0, 0, At, B0); PG8_BAR; PG8_SCHED;
            PG8_LDB(B1, 0, 1); PG8_STAGE(PG8_SB(0, 0), b2, voffB);
            PG8_BAR; PG8_WAIT_L(0); PG8_MMA(0, 1, At, B1); PG8_BAR;
            PG8_LDA(At, 0, 1); PG8_STAGE(PG8_SA(0, 0), a2, voffA);
            PG8_BAR; PG8_WAIT_L(0); PG8_MMA(1, 0, At, B0); PG8_BAR; PG8_SCHED;
            PG8_STAGE(PG8_SB(0, 1), b2 + hstep, voffB);
            PG8_WAIT_V(6); PG8_BAR; PG8_MMA(1, 1, At, B1); PG8_BAR;
            PG8_LDB(B0, 1, 0); PG8_SCHED; PG8_LDA(At, 1, 0); PG8_STAGE(PG8_SA(0, 1), a2 + hstep, voffA);
            PG8_WAIT_L(8); PG8_BAR; PG8_WAIT_L(0); PG8_MMA(0, 0, At, B0); PG8_BAR; PG8_SCHED;
            PG8_LDB(B1, 1, 1); PG8_STAGE(PG8_SB(1, 0), b3, voffB);
            PG8_BAR; PG8_WAIT_L(0); PG8_MMA(0, 1, At, B1); PG8_BAR;
            PG8_LDA(At, 1, 1); PG8_STAGE(PG8_SA(1, 0), a3, voffA);
            PG8_BAR; PG8_WAIT_L(0); PG8_MMA(1, 0, At, B0); PG8_BAR; PG8_SCHED;
            PG8_STAGE(PG8_SB(1, 1), b3 + hstep, voffB);
            PG8_WAIT_V(6); PG8_BAR; PG8_MMA(1, 1, At, B1); PG8_BAR;
            }
        }
        if constexpr (ALIGN_EPI) { if (wr == 0) PG8_BAR; }
        if constexpr (!Epi::AFTER_DRAIN) { E(acc, cur, wr, wc, fr, fq); S.done(cur); }
        if (!has_next) break;
#pragma unroll
        for (int a = 0; a < 2; ++a)
#pragma unroll
            for (int b = 0; b < 2; ++b)
#pragma unroll
                for (int m = 0; m < 4; ++m)
#pragma unroll
                    for (int n = 0; n < 2; ++n) acc[a][b][m][n] = (f32x4){0.f, 0.f, 0.f, 0.f};
        cur = nxt; cA = nA; cB = nB; ++ui;
        if constexpr (ALIGN_EPI) { if (wr == 1) PG8_BAR; }
    }
    PG8_WAIT_V(0);
    if constexpr (!ALIGN_EPI) { if (wr == 0) PG8_BAR; }
    PG8_BAR;
    if constexpr (Epi::AFTER_DRAIN) { E.fused(acc, cur, wr, wc, fr, fq, lds, wid, lane); S.done(cur); }
#undef PG8_SA
#undef PG8_SB
#undef PG8_STAGE
#undef PG8_LDA
#undef PG8_LDB
#undef PG8_MMA
#undef PG8_WAIT_V
#undef PG8_WAIT_L
#undef PG8_BAR
#undef PG8_SCHED
}
}
constexpr int NWAVES = 8;
#ifndef MK_N_LAUNCHES
#define MK_N_LAUNCHES 1
#endif
constexpr int BATCH = 8, SEQ = 8192, DM = 1024, M = BATCH * SEQ;
constexpr int PLE = 256, DIN = 3368, DINP = 3584;
constexpr int NSA_H = 8, NSA_G = 2, NSA_R = 4, DH = 64, NC = 511, NCP = 512;
constexpr int CMPH = 256, CMPK = 2048;
constexpr int GLA_H = 4, GDK = 64, GDV = 128, GRANK = 16, GCH = 64, NCHUNK = SEQ / GCH;
constexpr int C_QN = 0, C_KC = 512, C_VC = 640, C_KS = 768, C_VS = 896, C_KW = 1024, C_VW = 1152, C_GN = 1280, C_ZN = 1304,
              C_QG = 1816, C_KG = 2072, C_VG = 2328, C_AL = 2840, C_ZG = 2856;
constexpr float LN_EPS = 1e-5f;
constexpr float ALPHA_ = 1.189207115002721f;
constexpr float LOG2E = 1.4426950408889634f;

constexpr size_t MiB = 1u << 20;
constexpr size_t WS_CTL = 0, CTL_ZERO_BYTES = 1 * MiB;
constexpr size_t WS_WIN = 1 * MiB;
constexpr size_t WS_WOUT = 8 * MiB, WS_WPG = 10 * MiB;
constexpr size_t WS_WPE = 12 * MiB;
constexpr size_t WS_WCK1 = 13 * MiB, WS_WCV1 = 14 * MiB;
constexpr size_t WS_SMALL = 15 * MiB;
constexpr size_t SM_WCK2 = 0, SM_WCV2 = 32768, SM_WA2 = 65536, SM_CB1K = 73728, SM_CB1V = 74752;
constexpr size_t WS_STATS = 16 * MiB;
constexpr size_t WS_KC = 17 * MiB, WS_VC = 18 * MiB;
constexpr size_t WS_DEC = 19 * MiB;
constexpr size_t WS_XN = 20 * MiB;
constexpr size_t WS_MIX = WS_XN;
constexpr size_t WS_PB = 148 * MiB;
constexpr size_t WS_U = 180 * MiB;
constexpr size_t WS_EB = WS_U;
constexpr size_t WS_OW = 629 * MiB;
constexpr size_t WS_QE = 693 * MiB;
constexpr size_t WS_KV = 725 * MiB;
constexpr size_t WS_RB = WS_KV;
constexpr size_t WS_OI = 853 * MiB;
constexpr size_t WS_VST = 917 * MiB;
constexpr size_t WS_PARK = 933 * MiB;
constexpr size_t WS_END = 965 * MiB;
constexpr int CW_BAR = 4096;

constexpr int RING_OFF = 0, RING_BYTES = 155648;
constexpr int LDSCTL_OFF = RING_BYTES, MISC_OFF = LDSCTL_OFF + 320;
constexpr int LDS_BYTES = 163840;

#define GAS __attribute__((address_space(1)))
#define LAS __attribute__((address_space(3)))
typedef unsigned short bf16;
typedef unsigned v4u __attribute__((ext_vector_type(4)));
typedef unsigned v2u __attribute__((ext_vector_type(2)));
typedef float f32x4 __attribute__((ext_vector_type(4)));
typedef float f32x16 __attribute__((ext_vector_type(16)));
typedef short bf16x8 __attribute__((ext_vector_type(8)));
typedef GAS unsigned gu32;
#define RLX_AGENT __ATOMIC_RELAXED, __HIP_MEMORY_SCOPE_AGENT
#define LDS_WAIT() asm volatile("s_waitcnt lgkmcnt(0)" ::: "memory")
#define VM_WAIT() asm volatile("s_waitcnt vmcnt(0)" ::: "memory")
__device__ __forceinline__ unsigned f2bf(float f) { unsigned u = __builtin_bit_cast(unsigned, f); return (u + 0x7fffu + ((u >> 16) & 1u)) >> 16; }
__device__ __forceinline__ unsigned pk2(float lo, float hi) { return f2bf(lo) | (f2bf(hi) << 16); }
__device__ __forceinline__ float bflo(unsigned w) { return __uint_as_float(w << 16); }
__device__ __forceinline__ float bfhi(unsigned w) { return __uint_as_float(w & 0xffff0000u); }
__device__ __forceinline__ float sigmoidf2(float v) { return __builtin_amdgcn_rcpf(1.0f + __builtin_amdgcn_exp2f(-1.4426950408889634f * v)); }
#define XB_TMO      128
#define XB_XCNT(j)  (256  + 64 * (j))
#define XB_XSUB(j)  (1280 + 64 * (j))
#define XB_XGEN(j)  (2304 + 64 * (j))
#define XB_TOP      3328
#define XB_TOPGEN   3392
#define XCD_BAR_WORDS 3456
#define XB_SPIN_CAP (1u << 18)

__device__ __forceinline__ unsigned xb_ld(unsigned* p)              { return __hip_atomic_load(p, __ATOMIC_RELAXED, __HIP_MEMORY_SCOPE_AGENT); }
__device__ __forceinline__ unsigned xb_add(unsigned* p, unsigned v) { return __hip_atomic_fetch_add(p, v, __ATOMIC_RELAXED, __HIP_MEMORY_SCOPE_AGENT); }
__device__ __forceinline__ unsigned xb_xcc_id() { return (unsigned)__builtin_amdgcn_s_getreg((3 << 11) | 20) & 0xFu; }
#define XB_SPIN(cond, bar) do { unsigned _sp = 0; while (cond) { __builtin_amdgcn_s_sleep(1); \
    if ((++_sp & 255u) == 0u) { if (xb_ld(&(bar)[XB_TMO])) break; if (_sp > XB_SPIN_CAP) { atomicAdd(&(bar)[XB_TMO], 1u); break; } } } } while (0)

struct XcdBarrier {
    unsigned* bar; unsigned x;
    volatile LAS unsigned* st;
};

__device__ __forceinline__ XcdBarrier xcd_barrier_post(unsigned* bar, volatile LAS unsigned* st) {
    XcdBarrier b; b.bar = bar; b.x = xb_xcc_id(); b.st = st;
    if (threadIdx.x == 0) (void)xb_add(&bar[XB_XCNT(b.x)], 1u);
    return b;
}
__device__ __forceinline__ void xcd_barrier_complete(unsigned* bar, unsigned x, unsigned& nloc, unsigned& nx) {
    const unsigned G = gridDim.x * gridDim.y * gridDim.z;
    unsigned sum, cnt, mine, sp = 0u;
    for (;;) {
        sum = 0u; cnt = 0u; mine = 0u;
#pragma unroll
        for (unsigned j = 0; j < 16; ++j) { const unsigned c = xb_ld(&bar[XB_XCNT(j)]); sum += c; cnt += (c > 0u) ? 1u : 0u; mine = (j == x) ? c : mine; }
        if (sum == G) break;
        __builtin_amdgcn_s_sleep(1);
        if ((++sp & 255u) == 0u) { if (xb_ld(&bar[XB_TMO])) break; if (sp > XB_SPIN_CAP) { atomicAdd(&bar[XB_TMO], 1u); break; } }
    }
    nloc = mine > 0u ? mine : 1u; nx = cnt > 0u ? cnt : 1u;
}

__device__ __forceinline__ void xcd_barrier(const XcdBarrier& b) {
    asm volatile("s_waitcnt vmcnt(0)" ::: "memory");
    __syncthreads();
    if (threadIdx.x == 0) {
        unsigned* bar = b.bar;
        __builtin_amdgcn_s_waitcnt(0);
        unsigned nloc = b.st[0], nx = b.st[1];
        if (nloc == 0u) { xcd_barrier_complete(bar, b.x, nloc, nx); b.st[0] = nloc; b.st[1] = nx; }
        const unsigned old = xb_add(&bar[XB_XSUB(b.x)], 1u);
        const unsigned gen = old / nloc;
        if (old + 1u == (gen + 1u) * nloc) {
            __builtin_amdgcn_fence(__ATOMIC_RELEASE, "agent");
            asm volatile("s_waitcnt vmcnt(0)" ::: "memory");
            const unsigned og = xb_add(&bar[XB_TOP], 1u);
            const unsigned tg = og / nx;
            if (og + 1u == (tg + 1u) * nx) xb_add(&bar[XB_TOPGEN], 1u);
            else XB_SPIN(xb_ld(&bar[XB_TOPGEN]) == tg, bar);
            __builtin_amdgcn_fence(__ATOMIC_ACQUIRE, "agent");
            xb_add(&bar[XB_XGEN(b.x)], 1u);
            asm volatile("s_waitcnt vmcnt(0)" ::: "memory");
        } else {
            XB_SPIN(xb_ld(&bar[XB_XGEN(b.x)]) == gen, bar);
            __builtin_amdgcn_fence(__ATOMIC_ACQUIRE, "agent");
            asm volatile("s_waitcnt vmcnt(0)" ::: "memory");
        }
    }
    __syncthreads();
}
struct Frame {
    LAS unsigned char* lds;
    volatile LAS unsigned* MISC;
    gu32* ctl;
    int tid, lane, wave;
    int vcu, G;
    float* out; unsigned char* ws;
};
enum { I_X = 0, I_P, I_LN0G, I_LN0B, I_RELB, I_WIN, I_WA2, I_BA, I_GNW, I_POS, I_WCK1, I_BCK1, I_WCK2, I_WCV1, I_BCV1, I_WCV2, I_WOUT, I_WPE, I_WPG, I_BPG, I_LNG, I_LNB };

__device__ __forceinline__ float wave_sum(float v) {
#pragma unroll
    for (int o = 1; o < 64; o <<= 1) v += __shfl_xor(v, o);
    return v;
}
__device__ __forceinline__ void p0_transpose_item(const float* W, int K, int N, int nblk, bf16* WT, LAS float* scr, int item, int lane) {
    const int kb = item / nblk, nb = item % nblk, k0 = 64 * kb, n0 = 32 * nb;
    const int nn = n0 + (lane & 31);
#pragma unroll 8
    for (int i = 0; i < 32; ++i) { const int kk = 2 * i + (lane >> 5); scr[kk * 33 + (lane & 31)] = (nn < N) ? W[(size_t)(k0 + kk) * N + nn] : 0.f; }
    LDS_WAIT(); asm volatile("" ::: "memory");
    const int c = lane & 7;
#pragma unroll
    for (int j = 0; j < 4; ++j) { const int n = (lane >> 3) + 8 * j; const LAS float* s = scr + (8 * c) * 33 + n;
        v4u o; o.x = pk2(s[0 * 33], s[1 * 33]); o.y = pk2(s[2 * 33], s[3 * 33]); o.z = pk2(s[4 * 33], s[5 * 33]); o.w = pk2(s[6 * 33], s[7 * 33]);
        *(v4u*)(WT + (size_t)(n0 + n) * K + k0 + 8 * c) = o; }
    LDS_WAIT(); asm volatile("" ::: "memory");
}
__device__ __forceinline__ void ln0_row(const float* xrow, const float* g, const float* b, bf16* orow, float* st, int lane) {
    const f32x4* xr = (const f32x4*)xrow + lane;
    f32x4 v[4]; float s = 0.f;
#pragma unroll
    for (int j = 0; j < 4; ++j) { v[j] = xr[64 * j]; s += (v[j].x + v[j].y) + (v[j].z + v[j].w); }
    const float mean = wave_sum(s) * (1.f / DM); float s2 = 0.f;
#pragma unroll
    for (int j = 0; j < 4; ++j) { v[j] = v[j] - mean; s2 += (v[j].x * v[j].x + v[j].y * v[j].y) + (v[j].z * v[j].z + v[j].w * v[j].w); }
    const float rstd = 1.f / sqrtf(wave_sum(s2) * (1.f / DM) + LN_EPS);
    if (lane == 0) { st[0] = mean; st[1] = rstd; }
    unsigned long long* o8 = (unsigned long long*)orow + lane;
#pragma unroll
    for (int j = 0; j < 4; ++j) { const f32x4 gg = ((const f32x4*)g)[lane + 64 * j], bb = ((const f32x4*)b)[lane + 64 * j]; const f32x4 y = v[j] * rstd * gg + bb;
        o8[64 * j] = (unsigned long long)pk2(y.x, y.y) | ((unsigned long long)pk2(y.z, y.w) << 32); }
}
template <class AT> __device__ __forceinline__ void p0_prologue(Frame& F, const AT& A) {
    LAS float* scr = (LAS float*)(F.lds + RING_OFF + F.wave * 16384);
    const int gw = F.vcu * NWAVES + F.wave, NGW = F.G * NWAVES;
    unsigned char* ws = F.ws;
    constexpr int I_IN = (DM / 64) * (DINP / 32), I_SQ = (DM / 64) * (DM / 32), I_PE = (PLE / 64) * (DM / 32), I_C1 = (CMPK / 64) * (CMPH / 32), I_C2 = (CMPH / 64) * (DH / 32);
    constexpr int NITEMS = I_IN + 2 * I_SQ + I_PE + 2 * I_C1 + 2 * I_C2;
    for (int it = gw; it < NITEMS; it += NGW) {
        int r = it;
        if (r < I_IN) { p0_transpose_item(A.in[I_WIN], DM, DIN, DINP / 32, (bf16*)(ws + WS_WIN), scr, r, F.lane); continue; } r -= I_IN;
        if (r < I_SQ) { p0_transpose_item(A.in[I_WOUT], DM, DM, DM / 32, (bf16*)(ws + WS_WOUT), scr, r, F.lane); continue; } r -= I_SQ;
        if (r < I_SQ) { p0_transpose_item(A.in[I_WPG], DM, DM, DM / 32, (bf16*)(ws + WS_WPG), scr, r, F.lane); continue; } r -= I_SQ;
        if (r < I_PE) { p0_transpose_item(A.in[I_WPE], PLE, DM, DM / 32, (bf16*)(ws + WS_WPE), scr, r, F.lane); continue; } r -= I_PE;
        if (r < I_C1) { p0_transpose_item(A.in[I_WCK1], CMPK, CMPH, CMPH / 32, (bf16*)(ws + WS_WCK1), scr, r, F.lane); continue; } r -= I_C1;
        if (r < I_C1) { p0_transpose_item(A.in[I_WCV1], CMPK, CMPH, CMPH / 32, (bf16*)(ws + WS_WCV1), scr, r, F.lane); continue; } r -= I_C1;
        if (r < I_C2) { p0_transpose_item(A.in[I_WCK2], CMPH, DH, DH / 32, (bf16*)(ws + WS_SMALL + SM_WCK2), scr, r, F.lane); continue; } r -= I_C2;
        p0_transpose_item(A.in[I_WCV2], CMPH, DH, DH / 32, (bf16*)(ws + WS_SMALL + SM_WCV2), scr, r, F.lane);
    }
    { const int gt = gw * 64 + F.lane; if (gt < 256 * 16) { const int n = gt >> 4, k = gt & 15; ((bf16*)(ws + WS_SMALL + SM_WA2))[gt] = (bf16)f2bf(A.in[I_WA2][k * 256 + n]); } }
    { const int w2 = NGW - 1 - gw; if (w2 >= 0 && w2 < 512) { const int which = w2 >> 8, hcol = w2 & 255; const float* W1 = A.in[which ? I_WCV1 : I_WCK1]; const float* pos = A.in[I_POS];
        float s = 0.f;
        for (int k = F.lane; k < CMPK; k += 64) s += pos[k] * W1[(size_t)k * CMPH + hcol];
        s = wave_sum(s);
        if (F.lane == 0) ((float*)(ws + WS_SMALL + (which ? SM_CB1V : SM_CB1K)))[hcol] = s + A.in[which ? I_BCV1 : I_BCK1][hcol]; } }
    for (int m = gw; m < M; m += NGW) ln0_row(A.in[I_X] + (size_t)m * DM, A.in[I_LN0G], A.in[I_LN0B], (bf16*)(ws + WS_XN) + (size_t)m * DM, (float*)(ws + WS_STATS) + 2 * m, F.lane);
    { const f32x4* ps = (const f32x4*)A.in[I_P]; v2u* pd = (v2u*)(ws + WS_PB); const size_t n4 = (size_t)M * PLE / 4;
      for (size_t i = (size_t)gw * 64 + F.lane; i < n4; i += (size_t)NGW * 64) { const f32x4 v = ps[i]; v2u o; o.x = pk2(v.x, v.y); o.y = pk2(v.z, v.w); pd[i] = o; } }
}
__device__ __forceinline__ void final_ln(Frame& F, const float* g, const float* b) {
    const int gw = F.vcu * NWAVES + F.wave, NGW = F.G * NWAVES; const int lane = F.lane;
    for (int m = gw; m < M; m += NGW) {
        f32x4* xr = (f32x4*)(F.out + (size_t)m * DM) + lane;
        f32x4 v[4]; float s = 0.f;
#pragma unroll
        for (int j = 0; j < 4; ++j) { v[j] = xr[64 * j]; s += (v[j].x + v[j].y) + (v[j].z + v[j].w); }
        const float mean = wave_sum(s) * (1.f / DM); float s2 = 0.f;
#pragma unroll
        for (int j = 0; j < 4; ++j) { v[j] = v[j] - mean; s2 += (v[j].x * v[j].x + v[j].y * v[j].y) + (v[j].z * v[j].z + v[j].w * v[j].w); }
        const float rstd = 1.f / sqrtf(wave_sum(s2) * (1.f / DM) + LN_EPS);
#pragma unroll
        for (int j = 0; j < 4; ++j) { const f32x4 gg = ((const f32x4*)g)[lane + 64 * j], bb = ((const f32x4*)b)[lane + 64 * j]; xr[64 * j] = v[j] * rstd * gg + bb; }
    }
}
typedef short v4i16_t __attribute__((ext_vector_type(4)));
#define MFMA32(a, b, c) __builtin_amdgcn_mfma_f32_32x32x16_bf16(a, b, c, 0, 0, 0)
__device__ __forceinline__ int crow(int r, int hi) { return (r & 3) + 8 * (r >> 2) + 4 * hi; }
__device__ __forceinline__ unsigned cvtpk(float lo, float hi) { typedef float f2_t __attribute__((ext_vector_type(2))); typedef __bf16 b2_t __attribute__((ext_vector_type(2)));
    f2_t v = {lo, hi}; b2_t b = __builtin_convertvector(v, b2_t); return __builtin_bit_cast(unsigned, b); }
__device__ __forceinline__ bf16x8 pack8(float a0, float a1, float a2, float a3, float a4, float a5, float a6, float a7) {
    v4u w; w.x = cvtpk(a0, a1); w.y = cvtpk(a2, a3); w.z = cvtpk(a4, a5); w.w = cvtpk(a6, a7); return __builtin_bit_cast(bf16x8, w); }
__device__ __forceinline__ bf16x8 pack8r(const f32x16& p, int base) { return pack8(p[base], p[base + 1], p[base + 2], p[base + 3], p[base + 4], p[base + 5], p[base + 6], p[base + 7]); }
__device__ __forceinline__ v4i16_t vtr(const LAS unsigned char* p) { return __builtin_amdgcn_ds_read_tr16_b64_v4i16((LAS v4i16_t*)p); }
__device__ __forceinline__ float swap_lo(float v, float& hiv) { auto rr = __builtin_amdgcn_permlane32_swap(__float_as_uint(v), __float_as_uint(v), false, false); hiv = __uint_as_float(rr[1]); return __uint_as_float(rr[0]); }
__device__ __forceinline__ float fexp(float v) { return __builtin_amdgcn_exp2f(v * LOG2E); }
__device__ __forceinline__ void stage_tr_image(const bf16* src, int pitch, LAS unsigned char* img, int lane_in) {
    int lane = lane_in; asm volatile("" : "+v"(lane));
    const bf16* sp = src + (size_t)(lane >> 3) * pitch + (lane & 7) * 8;
    LAS unsigned char* dp = img + ((lane & 7) >> 2) * 4096 + (lane >> 3) * 64 + (lane & 3) * 16;
    v4u val[8];
#pragma unroll
    for (int i = 0; i < 8; ++i) { val[i] = *(const v4u*)sp; sp += (size_t)8 * pitch; }
#pragma unroll
    for (int i = 0; i < 8; ++i) *(LAS v4u*)(dp + i * 512) = val[i];
}
__device__ __forceinline__ bf16x8 tr_frag(const LAS unsigned char* img, int ch32, int ks, int lane) {
    const int hi = lane >> 5;
    const LAS unsigned char* p = img + ch32 * 4096 + ks * 1024 + ((lane >> 4) & 1) * 32 + (lane & 3) * 8 + (4 * hi + ((lane & 15) >> 2)) * 64;
    const v4i16_t lo = vtr(p), hv = vtr(p + 512);
    return (bf16x8){lo[0], lo[1], lo[2], lo[3], hv[0], hv[1], hv[2], hv[3]};
}
__device__ __forceinline__ void gla_pass_a(Frame& F, const float* b_a, int cid, LAS unsigned char* wl) {
    int lane_ = F.lane; asm volatile("" : "+v"(lane_));
    const int lane = lane_, r32 = lane & 31, hi = lane >> 5;
    const int bh = cid >> 7, n = cid & 127, b = bh >> 2, h = bh & 3;
    const size_t T0 = (size_t)b * SEQ + (size_t)n * GCH;
    const bf16* U = (const bf16*)(F.ws + WS_U);
    const bf16* wa2t = (const bf16*)(F.ws + WS_SMALL + SM_WA2);
    LAS unsigned char* kimg = wl; LAS unsigned char* vimg = wl + 8192;
    stage_tr_image(U + T0 * DINP + C_KG + h * 64, DINP, kimg, lane);
    asm volatile("" ::: "memory");
    f32x16 bC[2][2];
    {
        bf16x8 af[2], wf[2];
#pragma unroll
        for (int ct = 0; ct < 2; ++ct) af[ct] = *(const bf16x8*)(U + (T0 + 32 * ct + r32) * DINP + C_AL + 8 * hi);
#pragma unroll
        for (int dt = 0; dt < 2; ++dt) wf[dt] = *(const bf16x8*)(wa2t + (h * 64 + 32 * dt + r32) * 16 + 8 * hi);
        const f32x16 z16 = {};
#pragma unroll
        for (int ct = 0; ct < 2; ++ct)
#pragma unroll
            for (int dt = 0; dt < 2; ++dt) bC[ct][dt] = MFMA32(af[ct], wf[dt], z16);
#pragma unroll
        for (int dt = 0; dt < 2; ++dt) { const float ba = b_a[h * 64 + 32 * dt + r32];
#pragma unroll
            for (int ct = 0; ct < 2; ++ct)
#pragma unroll
                for (int r = 0; r < 16; ++r) { const float xv = bC[ct][dt][r] + ba;
                    const float ls = fminf(xv, 0.f) - __logf(1.0f + fexp(-fabsf(xv)));
                    bC[ct][dt][r] = ls * (1.0f / 16.0f); } }
    }
    asm volatile("" ::: "memory");
    f32x16 bT[2][2];
    {
#pragma unroll
        for (int ct = 0; ct < 2; ++ct) {
            f32x16 acc0 = {}, acc1 = {};
#pragma unroll
            for (int ks = 0; ks < 4; ++ks) { if (ct == 0 && ks >= 2) continue;
                v4u tw;
                { unsigned e[8];
#pragma unroll
                  for (int j = 0; j < 8; ++j) { const int cp = 16 * ks + 8 * (j >> 2) + 4 * hi + (j & 3); e[j] = (cp <= 32 * ct + r32) ? 0x3F80u : 0u; }
                  tw.x = e[0] | (e[1] << 16); tw.y = e[2] | (e[3] << 16); tw.z = e[4] | (e[5] << 16); tw.w = e[6] | (e[7] << 16); }
                const bf16x8 LT = __builtin_bit_cast(bf16x8, tw);
#pragma unroll
                for (int dt = 0; dt < 2; ++dt) { const f32x16& x = bC[ks >> 1][dt]; const int base = 8 * (ks & 1);
                    float hv[8], lv[8];
#pragma unroll
                    for (int j = 0; j < 8; ++j) { hv[j] = __uint_as_float(f2bf(x[base + j]) << 16); lv[j] = x[base + j] - hv[j]; }
                    const bf16x8 ah = pack8(hv[0], hv[1], hv[2], hv[3], hv[4], hv[5], hv[6], hv[7]);
                    const bf16x8 al = pack8(lv[0], lv[1], lv[2], lv[3], lv[4], lv[5], lv[6], lv[7]);
                    if (dt == 0) { acc0 = MFMA32(ah, LT, acc0); acc0 = MFMA32(al, LT, acc0); } else { acc1 = MFMA32(ah, LT, acc1); acc1 = MFMA32(al, LT, acc1); } }
            }
            bT[0][ct] = acc0; bT[1][ct] = acc1;
        }
    }
    asm volatile("" ::: "memory");
    float blast[2];
#pragma unroll
    for (int dt = 0; dt < 2; ++dt) { float run = 0.f;
#pragma unroll
        for (int ct = 0; ct < 2; ++ct)
#pragma unroll
            for (int a = 0; a < 4; ++a) { f32x16& x = bC[ct][dt];
                const float g0 = x[4 * a], g1 = g0 + x[4 * a + 1], g2 = g1 + x[4 * a + 2], g3 = g2 + x[4 * a + 3];
                float t1; const float t0 = swap_lo(g3, t1);
                const float off = run + (hi ? t0 : 0.f);
                x[4 * a] = off + g0; x[4 * a + 1] = off + g1; x[4 * a + 2] = off + g2; x[4 * a + 3] = off + g3;
                run += t0 + t1; }
        blast[dt] = run; }
    asm volatile("" ::: "memory");
    bf16x8 kl[2][4];
#pragma unroll
    for (int dt = 0; dt < 2; ++dt)
#pragma unroll
        for (int ks = 0; ks < 4; ++ks) { const bf16x8 kf = tr_frag(kimg, dt, ks, lane); float o8[8];
#pragma unroll
            for (int j = 0; j < 8; ++j) o8[j] = __uint_as_float(((unsigned)(unsigned short)kf[j]) << 16) * fexp(blast[dt] - bC[ks >> 1][dt][8 * (ks & 1) + j]);
            kl[dt][ks] = pack8(o8[0], o8[1], o8[2], o8[3], o8[4], o8[5], o8[6], o8[7]); }
    if (hi == 0) { float* dec = (float*)(F.ws + WS_DEC) + (size_t)cid * 64; dec[r32] = fexp(blast[0]); dec[32 + r32] = fexp(blast[1]); }
    asm volatile("" ::: "memory");
    bf16x8 qe[2][4], ke[2][4];
    bf16* QE = (bf16*)(F.ws + WS_QE) + (size_t)cid * 4096;
#pragma unroll
    for (int ct = 0; ct < 2; ++ct) { const bf16* rowp = U + (T0 + 32 * ct + r32) * DINP;
#pragma unroll
        for (int ds = 0; ds < 4; ++ds) {
            const v2u q0 = *(const v2u*)(rowp + C_QG + h * 64 + 16 * ds + 4 * hi), q1 = *(const v2u*)(rowp + C_QG + h * 64 + 16 * ds + 8 + 4 * hi);
            const v2u k0 = *(const v2u*)(rowp + C_KG + h * 64 + 16 * ds + 4 * hi), k1 = *(const v2u*)(rowp + C_KG + h * 64 + 16 * ds + 8 + 4 * hi);
            const float qv[8] = {bflo(q0.x), bfhi(q0.x), bflo(q0.y), bfhi(q0.y), bflo(q1.x), bfhi(q1.x), bflo(q1.y), bfhi(q1.y)};
            const float kv_[8] = {bflo(k0.x), bfhi(k0.x), bflo(k0.y), bfhi(k0.y), bflo(k1.x), bfhi(k1.x), bflo(k1.y), bfhi(k1.y)};
            float qo[8], ko[8];
#pragma unroll
            for (int j = 0; j < 8; ++j) { const float e = bT[ds >> 1][ct][8 * (ds & 1) + j]; qo[j] = qv[j] * 0.125f * fexp(e); ko[j] = kv_[j] * fexp(-e); }
            qe[ct][ds] = pack8(qo[0], qo[1], qo[2], qo[3], qo[4], qo[5], qo[6], qo[7]);
            ke[ct][ds] = pack8(ko[0], ko[1], ko[2], ko[3], ko[4], ko[5], ko[6], ko[7]);
            *(bf16x8*)(QE + ((ct * 4 + ds) * 64 + lane) * 8) = qe[ct][ds];
            if (ds & 1) asm volatile("" ::: "memory");
        } }
    asm volatile("" ::: "memory");
    bf16x8 at0[2], at1[4];
    {
        f32x16 a00 = {}, a01 = {}, a11 = {};
#pragma unroll
        for (int ds = 0; ds < 4; ++ds) { a00 = MFMA32(ke[0][ds], qe[0][ds], a00); a01 = MFMA32(ke[0][ds], qe[1][ds], a01); a11 = MFMA32(ke[1][ds], qe[1][ds], a11); }
#pragma unroll
        for (int r = 0; r < 16; ++r) { const bool keep = crow(r, hi) <= r32; a00[r] = keep ? a00[r] : 0.f; a11[r] = keep ? a11[r] : 0.f; }
        at0[0] = pack8r(a00, 0); at0[1] = pack8r(a00, 8);
        at1[0] = pack8r(a01, 0); at1[1] = pack8r(a01, 8); at1[2] = pack8r(a11, 0); at1[3] = pack8r(a11, 8);
    }
    asm volatile("" ::: "memory");
    bf16* KVF = (bf16*)(F.ws + WS_KV) + (size_t)cid * 8192;
    bf16* OI = (bf16*)(F.ws + WS_OI) + (size_t)cid * 8192;
#pragma unroll
    for (int vh = 0; vh < 2; ++vh) {
        stage_tr_image(U + T0 * DINP + C_VG + h * 128 + vh * 64, DINP, vimg, lane);
#pragma unroll
        for (int v2 = 0; v2 < 2; ++v2) { const int vt = 2 * vh + v2;
            bf16x8 vf[4];
#pragma unroll
            for (int ks = 0; ks < 4; ++ks) vf[ks] = tr_frag(vimg, v2, ks, lane);
            f32x16 o0 = {}, o1 = {};
#pragma unroll
            for (int ks = 0; ks < 4; ++ks) { if (ks < 2) o0 = MFMA32(vf[ks], at0[ks], o0); o1 = MFMA32(vf[ks], at1[ks], o1); }
            { v4u w0, w1;
              w0.x = cvtpk(o0[0], o0[1]); w0.y = cvtpk(o0[2], o0[3]); w0.z = cvtpk(o0[4], o0[5]); w0.w = cvtpk(o0[6], o0[7]);
              w1.x = cvtpk(o0[8], o0[9]); w1.y = cvtpk(o0[10], o0[11]); w1.z = cvtpk(o0[12], o0[13]); w1.w = cvtpk(o0[14], o0[15]);
              v4u* d0 = (v4u*)(OI + ((vt * 2 + 0) * 64 + lane) * 16); d0[0] = w0; d0[1] = w1;
              w0.x = cvtpk(o1[0], o1[1]); w0.y = cvtpk(o1[2], o1[3]); w0.z = cvtpk(o1[4], o1[5]); w0.w = cvtpk(o1[6], o1[7]);
              w1.x = cvtpk(o1[8], o1[9]); w1.y = cvtpk(o1[10], o1[11]); w1.z = cvtpk(o1[12], o1[13]); w1.w = cvtpk(o1[14], o1[15]);
              v4u* d1 = (v4u*)(OI + ((vt * 2 + 1) * 64 + lane) * 16); d1[0] = w0; d1[1] = w1; }
            f32x16 kv0 = {}, kv1 = {};
#pragma unroll
            for (int ks = 0; ks < 4; ++ks) { kv0 = MFMA32(kl[0][ks], vf[ks], kv0); kv1 = MFMA32(kl[1][ks], vf[ks], kv1); }
            { v4u w0, w1;
              w0.x = cvtpk(kv0[0], kv0[1]); w0.y = cvtpk(kv0[2], kv0[3]); w0.z = cvtpk(kv0[4], kv0[5]); w0.w = cvtpk(kv0[6], kv0[7]);
              w1.x = cvtpk(kv0[8], kv0[9]); w1.y = cvtpk(kv0[10], kv0[11]); w1.z = cvtpk(kv0[12], kv0[13]); w1.w = cvtpk(kv0[14], kv0[15]);
              v4u* d0 = (v4u*)(KVF + ((vt * 2 + 0) * 64 + lane) * 16); d0[0] = w0; d0[1] = w1;
              w0.x = cvtpk(kv1[0], kv1[1]); w0.y = cvtpk(kv1[2], kv1[3]); w0.z = cvtpk(kv1[4], kv1[5]); w0.w = cvtpk(kv1[6], kv1[7]);
              w1.x = cvtpk(kv1[8], kv1[9]); w1.y = cvtpk(kv1[10], kv1[11]); w1.z = cvtpk(kv1[12], kv1[13]); w1.w = cvtpk(kv1[14], kv1[15]);
              v4u* d1 = (v4u*)(KVF + ((vt * 2 + 1) * 64 + lane) * 16); d1[0] = w0; d1[1] = w1; }
        }
    }
}
struct ScanLoads { bf16x8 qf[4]; v4u k0a, k0b, k1a, k1b; v4u oi0, oi1; v2u zz[4]; };
__device__ __forceinline__ void scan_load(ScanLoads& L, const unsigned char* ws, int cid, size_t tok, int h, int ct, int vt, int lane, int hi) {
    const bf16* QE = (const bf16*)(ws + WS_QE) + (size_t)cid * 4096;
    const bf16* KVF = (const bf16*)(ws + WS_KV) + (size_t)cid * 8192;
    const bf16* OI = (const bf16*)(ws + WS_OI) + (size_t)cid * 8192;
    const bf16* U = (const bf16*)(ws + WS_U);
#pragma unroll
    for (int ds = 0; ds < 4; ++ds) L.qf[ds] = *(const bf16x8*)(QE + ((ct * 4 + ds) * 64 + lane) * 8);
    { const v4u* p0 = (const v4u*)(KVF + ((vt * 2 + 0) * 64 + lane) * 16); const v4u* p1 = (const v4u*)(KVF + ((vt * 2 + 1) * 64 + lane) * 16);
      L.k0a = p0[0]; L.k0b = p0[1]; L.k1a = p1[0]; L.k1b = p1[1]; }
    L.oi0 = *(const v4u*)(OI + ((vt * 2 + ct) * 64 + lane) * 16); L.oi1 = *(const v4u*)(OI + ((vt * 2 + ct) * 64 + lane) * 16 + 8);
#pragma unroll
    for (int a = 0; a < 4; ++a) L.zz[a] = *(const v2u*)(U + tok * DINP + C_ZG + h * 128 + 32 * vt + 8 * a + 4 * hi);
}
__device__ __forceinline__ void scan_step(const ScanLoads& L, f32x16& S0, f32x16& S1, const LAS float* gnl, LAS float* part, const LAS float* decb, bf16* MIX, size_t tok, int n, int h, int ct, int vt, int r32, int hi) {
    f32x16 o = {};
    o = MFMA32(pack8r(S0, 0), L.qf[0], o); o = MFMA32(pack8r(S0, 8), L.qf[1], o); o = MFMA32(pack8r(S1, 0), L.qf[2], o); o = MFMA32(pack8r(S1, 8), L.qf[3], o);
    const unsigned oiw[8] = {L.oi0.x, L.oi0.y, L.oi0.z, L.oi0.w, L.oi1.x, L.oi1.y, L.oi1.z, L.oi1.w};
    float ss = 0.f;
#pragma unroll
    for (int r = 0; r < 16; ++r) { const float add = (r & 1) ? bfhi(oiw[r >> 1]) : bflo(oiw[r >> 1]); o[r] += add; ss += o[r] * o[r]; }
    { const unsigned k0w[8] = {L.k0a.x, L.k0a.y, L.k0a.z, L.k0a.w, L.k0b.x, L.k0b.y, L.k0b.z, L.k0b.w}, k1w[8] = {L.k1a.x, L.k1a.y, L.k1a.z, L.k1a.w, L.k1b.x, L.k1b.y, L.k1b.z, L.k1b.w};
#pragma unroll
      for (int a = 0; a < 4; ++a) { const f32x4 x0 = *(const LAS f32x4*)(decb + 8 * a + 4 * hi), x1 = *(const LAS f32x4*)(decb + 32 + 8 * a + 4 * hi);
        S0[4 * a] = x0.x * S0[4 * a] + bflo(k0w[2 * a]); S0[4 * a + 1] = x0.y * S0[4 * a + 1] + bfhi(k0w[2 * a]); S0[4 * a + 2] = x0.z * S0[4 * a + 2] + bflo(k0w[2 * a + 1]); S0[4 * a + 3] = x0.w * S0[4 * a + 3] + bfhi(k0w[2 * a + 1]);
        S1[4 * a] = x1.x * S1[4 * a] + bflo(k1w[2 * a]); S1[4 * a + 1] = x1.y * S1[4 * a + 1] + bfhi(k1w[2 * a]); S1[4 * a + 2] = x1.z * S1[4 * a + 2] + bflo(k1w[2 * a + 1]); S1[4 * a + 3] = x1.w * S1[4 * a + 3] + bfhi(k1w[2 * a + 1]); } }
    { float t1; const float t0 = swap_lo(ss, t1); ss = t0 + t1; }
    LAS float* pb = part + (n & 1) * 256;
    if (hi == 0) pb[vt * 64 + 32 * ct + r32] = ss;
    __syncthreads();
    const float tot = (pb[32 * ct + r32] + pb[64 + 32 * ct + r32]) + (pb[128 + 32 * ct + r32] + pb[192 + 32 * ct + r32]);
    const float rstd = 1.0f / sqrtf(tot * (1.0f / GDV) + LN_EPS);
#pragma unroll
    for (int a = 0; a < 4; ++a) { const float z0 = bflo(L.zz[a].x), z1 = bfhi(L.zz[a].x), z2 = bflo(L.zz[a].y), z3 = bfhi(L.zz[a].y); const f32x4 gna = *(const LAS f32x4*)(gnl + 32 * vt + 8 * a + 4 * hi);
        const float y0 = o[4 * a] * rstd * gna.x * z0 * sigmoidf2(z0), y1 = o[4 * a + 1] * rstd * gna.y * z1 * sigmoidf2(z1);
        const float y2 = o[4 * a + 2] * rstd * gna.z * z2 * sigmoidf2(z2), y3 = o[4 * a + 3] * rstd * gna.w * z3 * sigmoidf2(z3);
        v2u ov; ov.x = cvtpk(y0, y1); ov.y = cvtpk(y2, y3);
        *(v2u*)(MIX + tok * DM + 512 + h * 128 + 32 * vt + 8 * a + 4 * hi) = ov; }
}
__device__ __forceinline__ void gla_scan_unit(Frame& F, const float* gnw, int bh, LAS float* part) {
    const int lane = F.lane, r32 = lane & 31, hi = lane >> 5, w = F.wave, ct = w & 1, vt = w >> 1;
    const int b = bh >> 2, h = bh & 3;
    bf16* MIX = (bf16*)(F.ws + WS_MIX);
    LAS float* decb = part + 512;
    const float* DEC = (const float*)(F.ws + WS_DEC) + (size_t)bh * NCHUNK * 64;
    f32x16 S0 = {}, S1 = {};
    LAS float* gnl = part + 640;
    if (w == 1) { gnl[lane] = gnw[lane]; gnl[64 + lane] = gnw[64 + lane]; }
    const size_t tokb = (size_t)b * SEQ + 32 * ct + r32;
    ScanLoads LA, LB;
    scan_load(LA, F.ws, bh * NCHUNK, tokb, h, ct, vt, lane, hi);
    if (w == 0) decb[lane] = DEC[lane];
    __syncthreads();
    for (int n = 0; n < NCHUNK; n += 2) {
        scan_load(LB, F.ws, bh * NCHUNK + n + 1, tokb + (size_t)(n + 1) * GCH, h, ct, vt, lane, hi);
        if (w == 0) decb[64 + lane] = DEC[(n + 1) * 64 + lane];
        scan_step(LA, S0, S1, gnl, part, decb, MIX, tokb + (size_t)n * GCH, n, h, ct, vt, r32, hi);
        if (n + 2 < NCHUNK) { scan_load(LA, F.ws, bh * NCHUNK + n + 2, tokb + (size_t)(n + 2) * GCH, h, ct, vt, lane, hi); if (w == 0) decb[lane] = DEC[(n + 2) * 64 + lane]; }
        scan_step(LB, S0, S1, gnl, part, decb + 64, MIX, tokb + (size_t)(n + 1) * GCH, n + 1, h, ct, vt, r32, hi);
    }
    __syncthreads();
}
constexpr int L_KV = 0;
constexpr int L_TB = 32768;
constexpr int L_WSF = 36864;
constexpr int L_SELM = 38912;
constexpr int L_MREF = 39936;
constexpr int L_LACC = 40960;
constexpr int L_CNT = 41984;
constexpr int L_ITEMS = 43520;
constexpr int L_TOKL = 44032;
constexpr int L_SL2 = 52224;
constexpr int L_OACC = 84992;
constexpr int L_IMP = L_OACC;
constexpr int L_MAIL = L_OACC;
constexpr int L_MAILL = L_MAIL + 32768;
constexpr int L_WHERE = L_MAILL + 1024;
constexpr int IMP_LD = 129;
constexpr float NEGBIG = -1e30f;
constexpr float C2S = 0.125f * LOG2E;
constexpr float THR_RESC = 8.0f;

__device__ __forceinline__ int t5_bucket(int n) {
    if (n < 16) return n;
    const int th[15] = {19, 21, 24, 27, 31, 35, 40, 46, 52, 59, 67, 77, 87, 99, 113};
    int b = 16;
#pragma unroll
    for (int i = 0; i < 15; ++i) b += (n >= th[i]) ? 1 : 0;
    return b;
}
__device__ __forceinline__ void build_bias_table(Frame& F, const float* rel_bias) {
    LAS float* tb = (LAS float*)(F.lds + L_TB);
    for (int i = F.tid; i < 8 * 128; i += NWAVES * 64) { const int hd = i >> 7, n = i & 127; tb[i] = rel_bias[t5_bucket(n) * 8 + hd] * LOG2E; }
}
struct KVRegs { v4u k, v; };
__device__ __forceinline__ KVRegs kv_load(const bf16* Kb, const bf16* Vb, size_t pitch, int row0, int w, int lane) {
    KVRegs r;
    r.k = *(const v4u*)(Kb + (size_t)(row0 + lane) * pitch + w * 8);
    r.v = *(const v4u*)(Vb + (size_t)(row0 + 16 * (w & 3) + (lane >> 2)) * pitch + (w >> 2) * 32 + (lane & 3) * 8);
    return r;
}
__device__ __forceinline__ void kv_store(LAS unsigned char* slot, const KVRegs& r, int tid) {
    *(LAS v4u*)(slot + tid * 16) = r.k; *(LAS v4u*)(slot + 8192 + tid * 16) = r.v;
}
struct SmState { float mhat, lsum; f32x16 o0, o1; };
__device__ __forceinline__ void qk_tile(const LAS unsigned char* kslot, const bf16x8 (&qr)[4], f32x16& p0, f32x16& p1, int r32, int hi) {
    const LAS unsigned char* kp = kslot + hi * 1024 + r32 * 16;
    p0 = (f32x16){}; p1 = (f32x16){};
#pragma unroll
    for (int d0 = 0; d0 < 4; ++d0) { const bf16x8 k0 = *(const LAS bf16x8*)(kp + d0 * 2048), k1 = *(const LAS bf16x8*)(kp + d0 * 2048 + 512);
        p0 = MFMA32(k0, qr[d0], p0); p1 = MFMA32(k1, qr[d0], p1); }
}
__device__ __forceinline__ float rowmax32(const f32x16& p0, const f32x16& p1) {
    float a = fmaxf(p0[0], p1[0]);
#pragma unroll
    for (int r = 1; r < 16; ++r) a = fmaxf(a, fmaxf(p0[r], p1[r]));
    float t1; const float t0 = swap_lo(a, t1); return fmaxf(t0, t1);
}
__device__ __forceinline__ void pv_tail(SmState& st, const f32x16& p0, const f32x16& p1, const LAS unsigned char* vslot, int lane) {
    const bf16x8 pa0 = pack8r(p0, 0), pa1 = pack8r(p0, 8), pa2 = pack8r(p1, 0), pa3 = pack8r(p1, 8);
#pragma unroll
    for (int d0 = 0; d0 < 2; ++d0) {
        const bf16x8 v0 = tr_frag(vslot, d0, 0, lane), v1 = tr_frag(vslot, d0, 1, lane), v2 = tr_frag(vslot, d0, 2, lane), v3 = tr_frag(vslot, d0, 3, lane);
        f32x16 o = d0 ? st.o1 : st.o0;
        o = MFMA32(pa0, v0, o); o = MFMA32(pa1, v1, o); o = MFMA32(pa2, v2, o); o = MFMA32(pa3, v3, o);
        if (d0) st.o1 = o; else st.o0 = o;
    }
}
__device__ __forceinline__ void softmax_pv(SmState& st, f32x16& p0, f32x16& p1, const LAS unsigned char* vslot, LAS float* wsf, int lane, int r32, int hi) {
    const float rm = rowmax32(p0, p1);
    if (__any(rm > st.mhat + THR_RESC)) {
        const float mnew = fmaxf(st.mhat, rm); const float f = __builtin_amdgcn_exp2f(st.mhat - mnew);
        st.lsum *= f; st.mhat = mnew;
        if (hi == 0) wsf[r32] = f;
        LDS_WAIT();
#pragma unroll
        for (int r = 0; r < 16; ++r) { const float fr = wsf[crow(r, hi)]; st.o0[r] *= fr; st.o1[r] *= fr; }
    }
    float s = 0.f;
#pragma unroll
    for (int r = 0; r < 16; ++r) { p0[r] = __builtin_amdgcn_exp2f(p0[r] - st.mhat); p1[r] = __builtin_amdgcn_exp2f(p1[r] - st.mhat); s += p0[r] + p1[r]; }
    st.lsum += s;
    pv_tail(st, p0, p1, vslot, lane);
}
__device__ __forceinline__ void softmax_pv_fast(SmState& st, f32x16& p0, f32x16& p1, float sc, float bias, const LAS unsigned char* vslot, LAS float* wsf, int lane, int r32, int hi) {
    const float rm = __builtin_fmaf(rowmax32(p0, p1), sc, bias);
    if (__any(rm > st.mhat + THR_RESC)) {
        const float mnew = fmaxf(st.mhat, rm); const float f = __builtin_amdgcn_exp2f(st.mhat - mnew);
        st.lsum *= f; st.mhat = mnew;
        if (hi == 0) wsf[r32] = f;
        LDS_WAIT();
#pragma unroll
        for (int r = 0; r < 16; ++r) { const float fr = wsf[crow(r, hi)]; st.o0[r] *= fr; st.o1[r] *= fr; }
    }
    const float nb = bias - st.mhat; float s = 0.f;
#pragma unroll
    for (int r = 0; r < 16; ++r) { p0[r] = __builtin_amdgcn_exp2f(__builtin_fmaf(p0[r], sc, nb)); p1[r] = __builtin_amdgcn_exp2f(__builtin_fmaf(p1[r], sc, nb)); s += p0[r] + p1[r]; }
    st.lsum += s;
    pv_tail(st, p0, p1, vslot, lane);
}
__device__ __forceinline__ void stage_tile(LAS bf16* stg, const f32x16& a0, const f32x16& a1, int r32, int hi) {
#pragma unroll
    for (int r = 0; r < 16; ++r) { stg[crow(r, hi) * 64 + r32] = (bf16)f2bf(a0[r]); stg[crow(r, hi) * 64 + 32 + r32] = (bf16)f2bf(a1[r]); }
}
__device__ __forceinline__ void finish_rows(SmState& st, LAS float* wsf, int r32, int hi, bool zero_row) {
    float t1; const float t0 = swap_lo(st.lsum, t1); const float l = t0 + t1;
    if (hi == 0) wsf[32 + r32] = zero_row ? 0.f : __builtin_amdgcn_rcpf(l);
    LDS_WAIT();
#pragma unroll
    for (int r = 0; r < 16; ++r) { const float il = wsf[32 + crow(r, hi)]; st.o0[r] *= il; st.o1[r] *= il; }
}
__device__ __forceinline__ void load_q(bf16x8 (&qr)[4], const bf16* U, size_t tok0, int g, int w, int r32, int hi) {
    const bf16* qp = U + (tok0 + 8 * w + (r32 >> 2)) * DINP + C_QN + (4 * g + (r32 & 3)) * 64 + 8 * hi;
#pragma unroll
    for (int d0 = 0; d0 < 4; ++d0) qr[d0] = *(const bf16x8*)(qp + 16 * d0);
}
template <bool NEAR>
__device__ __forceinline__ void bias_mask(f32x16& p0, f32x16& p1, const LAS float* tbh, int dist0, int kstep, int loD, int hiD, bool rowok, int hi) {
    const float cfar = tbh[127];
#pragma unroll
    for (int r = 0; r < 16; ++r) {
        const int k0 = crow(r, hi), k1 = k0 + 32;
        const int dA = dist0 - kstep * k0, dB = dist0 - kstep * k1;
        float bA, bB;
        if (NEAR) { bA = tbh[min(max(dA, 0), 127)]; bB = tbh[min(max(dB, 0), 127)]; } else { bA = cfar; bB = cfar; }
        const bool vA = rowok && dA >= loD && dA < hiD, vB = rowok && dB >= loD && dB < hiD;
        p0[r] = vA ? __builtin_fmaf(p0[r], C2S, bA) : NEGBIG;
        p1[r] = vB ? __builtin_fmaf(p1[r], C2S, bB) : NEGBIG;
    }
}
__device__ __forceinline__ void window_unit(Frame& F, int unit) {
    int tid_ = F.tid; asm volatile("" : "+v"(tid_));
    const int tid = tid_, lane = tid & 63, r32 = lane & 31, hi = lane >> 5, w = F.wave;
    const int bg = unit >> 7, i = unit & 127, b = bg >> 1, g = bg & 1;
    const bf16* U = (const bf16*)(F.ws + WS_U);
    const size_t tok0 = (size_t)b * SEQ + (size_t)i * 64;
    const bf16* Kb = U + (size_t)b * SEQ * DINP + C_KW + g * 64; const bf16* Vb = U + (size_t)b * SEQ * DINP + C_VW + g * 64;
    LAS unsigned char* kv = F.lds + L_KV; LAS float* wsf = (LAS float*)(F.lds + L_WSF) + w * 64;
    const LAS float* tbh = (const LAS float*)(F.lds + L_TB) + (4 * g + (r32 & 3)) * 128;
    bf16x8 qr[4]; load_q(qr, U, tok0, g, w, r32, hi);
    SmState st; st.mhat = NEGBIG; st.lsum = 0.f; st.o0 = (f32x16){}; st.o1 = (f32x16){};
    const int tql = 8 * w + (r32 >> 2);
    const int nb = (i < 8 ? i : 8) + 1;
    { const KVRegs r0 = kv_load(Kb, Vb, DINP, i * 64, w, lane); kv_store(kv, r0, tid); }
    __syncthreads();
    for (int s = 0; s < nb; ++s) {
        const int blk = i - s; LAS unsigned char* slot = kv + (s & 1) * 16384;
        KVRegs nx; if (s + 1 < nb) nx = kv_load(Kb, Vb, DINP, (blk - 1) * 64, w, lane);
        f32x16 p0, p1; qk_tile(slot, qr, p0, p1, r32, hi);
        const int dist0 = 64 * s + tql;
        if (s <= 2) { bias_mask<true>(p0, p1, tbh, dist0, 1, 0, 512, true, hi); softmax_pv(st, p0, p1, slot + 8192, wsf, lane, r32, hi); }
        else if (s == 8) { bias_mask<false>(p0, p1, tbh, dist0, 1, 0, 512, true, hi); softmax_pv(st, p0, p1, slot + 8192, wsf, lane, r32, hi); }
        else softmax_pv_fast(st, p0, p1, C2S, tbh[127], slot + 8192, wsf, lane, r32, hi);
        if (s + 1 < nb) kv_store(kv + ((s + 1) & 1) * 16384, nx, tid);
        __syncthreads();
    }
    finish_rows(st, wsf, r32, hi, false);
    bf16* OW = (bf16*)(F.ws + WS_OW);
    LAS bf16* stg = (LAS bf16*)(F.lds + L_IMP) + w * 2048;
    stage_tile(stg, st.o0, st.o1, r32, hi);
    LDS_WAIT();
#pragma unroll
    for (int it = 0; it < 4; ++it) { const int row = it * 8 + (lane >> 3), ch = lane & 7;
        const v4u t = *(const LAS v4u*)(stg + row * 64 + ch * 8);
        *(v4u*)(OW + (tok0 + 8 * w + (row >> 2)) * 512 + (4 * g + (row & 3)) * 64 + ch * 8) = t; }
    LDS_WAIT();
}
constexpr int CA_ROWS = 528, L_CH = 69632, CH_LD = 264;
__device__ __forceinline__ float gelu_tanh(float x) { const float u = 0.7978845608028654f * (x + 0.044715f * x * x * x); const float e = __builtin_amdgcn_exp2f(2.0f * LOG2E * u); return x * (1.0f - __builtin_amdgcn_rcpf(e + 1.0f)); }
__device__ __forceinline__ void compress_unit(Frame& F, int unit) {
    int tid_ = F.tid; asm volatile("" : "+v"(tid_));
    const int tid = tid_, lane = tid & 63, r32 = lane & 31, hi = lane >> 5, w = F.wave;
    const int which = unit >> 8, bg = (unit >> 4) & 15, jb = unit & 15, b = bg >> 1, g = bg & 1;
    const bf16* U = (const bf16*)(F.ws + WS_U);
    const bf16* src = U + ((size_t)b * SEQ + 512 * jb) * DINP + (which ? C_VC : C_KC) + g * 64;
    const bf16* W1t = (const bf16*)(F.ws + (which ? WS_WCV1 : WS_WCK1));
    const bf16* W2t = (const bf16*)(F.ws + WS_SMALL + (which ? SM_WCV2 : SM_WCK2));
    const float* cb1 = (const float*)(F.ws + WS_SMALL + (which ? SM_CB1V : SM_CB1K));
    bf16* dst = (bf16*)(F.ws + (which ? WS_VC : WS_KC)) + ((size_t)bg * NCP + 32 * jb) * 64;
    LAS unsigned char* A = F.lds; LAS bf16* H = (LAS bf16*)(F.lds + L_CH);
    for (int p = tid; p < CA_ROWS * 8; p += NWAVES * 64) { const int t = p >> 3, ch = p & 7;
        const v4u val = *(const v4u*)(src + (size_t)t * DINP + ch * 8);
        *(LAS v4u*)(A + t * 128 + ((ch ^ ((t >> 4) & 7)) << 4)) = val; }
    __syncthreads();
    f32x16 acc = {};
    const bf16* wp = W1t + (size_t)(32 * w + r32) * CMPK + 8 * hi;
#pragma unroll 4
    for (int kk = 0; kk < 128; ++kk) { const int tok = kk >> 2, t = 16 * r32 + tok, ch = 2 * (kk & 3) + hi;
        const bf16x8 a = *(const LAS bf16x8*)(A + t * 128 + ((ch ^ ((t >> 4) & 7)) << 4));
        const bf16x8 bw = *(const bf16x8*)(wp + 16 * kk);
        acc = MFMA32(a, bw, acc); }
    { const float cb = cb1[32 * w + r32];
#pragma unroll
      for (int r = 0; r < 16; ++r) H[crow(r, hi) * CH_LD + 32 * w + r32] = (bf16)f2bf(gelu_tanh(acc[r] + cb)); }
    __syncthreads();
    if (w < 2) {
        f32x16 o = {};
        const bf16* w2p = W2t + (size_t)(32 * w + r32) * CMPH + 8 * hi;
#pragma unroll
        for (int kk = 0; kk < 16; ++kk) { const bf16x8 a = *(const LAS bf16x8*)(H + r32 * CH_LD + 16 * kk + 8 * hi); const bf16x8 bw = *(const bf16x8*)(w2p + 16 * kk); o = MFMA32(a, bw, o); }
#pragma unroll
        for (int r = 0; r < 16; ++r) dst[crow(r, hi) * 64 + 32 * w + r32] = (bf16)f2bf(o[r]);
    }
    __syncthreads();
}
#ifdef PROBE_SEC
#define TSTAMP(sec) do { if (unit == 127 && threadIdx.x == 0) { const unsigned long long t_ = __builtin_amdgcn_s_memtime(); atomicAdd((unsigned long long*)((unsigned*)F.ctl + 210000) + (sec), t_ - tprev_); tprev_ = t_; } } while (0)
#define TSTART() unsigned long long tprev_ = __builtin_amdgcn_s_memtime()
#else
#define TSTAMP(sec) do {} while (0)
#define TSTART() do {} while (0)
#endif
__device__ __forceinline__ void nsa_unit(Frame& F, int unit) {
    int tid_ = F.tid; asm volatile("" : "+v"(tid_));
    const int tid = tid_, lane = tid & 63, r32 = lane & 31, hi = lane >> 5, w = F.wave;
    const int bg = unit >> 7, i = unit & 127, b = bg >> 1, g = bg & 1;
    const bf16* U = (const bf16*)(F.ws + WS_U);
    const size_t tok0 = (size_t)b * SEQ + (size_t)i * 64;
    LAS unsigned char* kv = F.lds + L_KV; LAS float* wsf = (LAS float*)(F.lds + L_WSF) + w * 64;
    const LAS float* tbh = (const LAS float*)(F.lds + L_TB) + (4 * g + (r32 & 3)) * 128;
    LAS float* imp = (LAS float*)(F.lds + L_IMP); LAS unsigned* selm = (LAS unsigned*)(F.lds + L_SELM);
    TSTART();
    bf16x8 qr[4]; load_q(qr, U, tok0, g, w, r32, hi);
    const int tql = 8 * w + (r32 >> 2), tq = i * 64 + tql;
    const bf16* KCb = (const bf16*)(F.ws + WS_KC) + (size_t)bg * NCP * 64; const bf16* VCb = (const bf16*)(F.ws + WS_VC) + (size_t)bg * NCP * 64;
    const int ncv = 4 * i + 3, nct = (ncv + 63) >> 6;
    SmState st; st.mhat = NEGBIG; st.lsum = 0.f; st.o0 = (f32x16){}; st.o1 = (f32x16){};
    { const KVRegs r0 = kv_load(KCb, VCb, 64, 0, w, lane); kv_store(kv, r0, tid); }
    __syncthreads();
    for (int s = 0; s < nct; ++s) {
        LAS unsigned char* slot = kv + (s & 1) * 16384;
        KVRegs nx; if (s + 1 < nct) nx = kv_load(KCb, VCb, 64, (s + 1) * 64, w, lane);
        f32x16 p0, p1; qk_tile(slot, qr, p0, p1, r32, hi);
        const int dist0 = tq - 31 - 1024 * s;
        if (64 * i - 31 - 1024 * s - 16 * 63 < 113) { bias_mask<true>(p0, p1, tbh, dist0, 16, 0, 0x7fffffff, true, hi); softmax_pv(st, p0, p1, slot + 8192, wsf, lane, r32, hi); }
        else softmax_pv_fast(st, p0, p1, C2S, tbh[127], slot + 8192, wsf, lane, r32, hi);
        if (s + 1 < nct) kv_store(kv + ((s + 1) & 1) * 16384, nx, tid);
        __syncthreads();
    }
    const bool norow = tq < 31;
    float lc; { float t1; const float t0 = swap_lo(st.lsum, t1); lc = t0 + t1; }
    const float mfin = st.mhat, ilc = norow ? 0.f : __builtin_amdgcn_rcpf(lc);
    finish_rows(st, wsf, r32, hi, norow);
    unsigned ocw[16];
    { const bf16* gp = U + (tok0 + tql) * DINP + C_GN + (4 * g + (r32 & 3)) * 3;
      const float g0 = sigmoidf2(bflo((unsigned)gp[0]));
      if (hi == 0) wsf[r32] = g0;
      LDS_WAIT();
#pragma unroll
      for (int r = 0; r < 16; ++r) { const float gg = wsf[crow(r, hi)]; ocw[r] = cvtpk(st.o0[r] * gg, st.o1[r] * gg); } }
    unsigned* park = (unsigned*)(F.ws + WS_PARK) + ((size_t)blockIdx.x * NWAVES + w) * 4096 + lane;
#pragma unroll
    for (int r = 0; r < 16; ++r) park[r * 64] = ocw[r];
    __syncthreads();
    TSTAMP(0);
    { const KVRegs r0 = kv_load(KCb, VCb, 64, 0, w, lane); kv_store(kv, r0, tid); }
    __syncthreads();
    for (int s = 0; s < nct; ++s) {
        LAS unsigned char* slot = kv + (s & 1) * 16384;
        KVRegs nx; if (s + 1 < nct) nx = kv_load(KCb, VCb, 64, (s + 1) * 64, w, lane);
        f32x16 p0, p1; qk_tile(slot, qr, p0, p1, r32, hi);
        const int dist0 = tq - 31 - 1024 * s;
        if (64 * i - 31 - 1024 * s - 16 * 63 < 113) { bias_mask<true>(p0, p1, tbh, dist0, 16, 0, 0x7fffffff, true, hi);
#pragma unroll
            for (int r = 0; r < 16; ++r) { p0[r] = __builtin_amdgcn_exp2f(p0[r] - mfin) * ilc; p1[r] = __builtin_amdgcn_exp2f(p1[r] - mfin) * ilc; } }
        else { const float nb = tbh[127] - mfin;
#pragma unroll
            for (int r = 0; r < 16; ++r) { p0[r] = __builtin_amdgcn_exp2f(__builtin_fmaf(p0[r], C2S, nb)) * ilc; p1[r] = __builtin_amdgcn_exp2f(__builtin_fmaf(p1[r], C2S, nb)) * ilc; } }
        LAS float* irow = imp + tql * IMP_LD + 16 * s + hi;
#pragma unroll
        for (int A = 0; A < 8; ++A) { const f32x16& p = (A < 4) ? p0 : p1; const int a = A & 3;
            float own = p[4 * a] + p[4 * a + 1] + p[4 * a + 2] + 0.5f * p[4 * a + 3], car = 0.5f * p[4 * a + 3];
            own += __shfl_xor(own, 1); own += __shfl_xor(own, 2); car += __shfl_xor(car, 1); car += __shfl_xor(car, 2);
            if ((r32 & 3) == 0) { irow[2 * A] = own; irow[64 * IMP_LD + 2 * A + 1] = car; } }
        if (s + 1 < nct) kv_store(kv + ((s + 1) & 1) * 16384, nx, tid);
        __syncthreads();
    }
    TSTAMP(1);
    {
        const int tl = 8 * w + (lane >> 3), slot8 = lane & 7; const int cur = i;
        unsigned m0 = 0u, m1 = 0u, m2 = 0u, m3 = 0u;
        if (cur < 16) { m0 = (cur == 31) ? 0xffffffffu : ((1u << (cur + 1)) - 1u); }
        else {
            unsigned key[16];
#pragma unroll
            for (int k = 0; k < 16; ++k) { const int n = slot8 + 8 * k; const float v = (n >= 1 && n <= cur - 2) ? imp[tl * IMP_LD + n] + imp[64 * IMP_LD + tl * IMP_LD + n] : 0.f;
                key[k] = (n >= 1 && n <= cur - 2) ? ((__float_as_uint(v) & ~127u) | (unsigned)(127 - n)) : 0u; }
            for (int it = 0; it < 13; ++it) {
                unsigned mx = key[0];
#pragma unroll
                for (int k = 1; k < 16; ++k) mx = max(mx, key[k]);
                mx = max(mx, (unsigned)__shfl_xor((int)mx, 1)); mx = max(mx, (unsigned)__shfl_xor((int)mx, 2)); mx = max(mx, (unsigned)__shfl_xor((int)mx, 4));
                const int nsel = 127 - (int)(mx & 127u);
#pragma unroll
                for (int k = 0; k < 16; ++k) key[k] = (key[k] == mx) ? 0u : key[k];
                const unsigned bit = 1u << (nsel & 31); const int wd = nsel >> 5;
                m0 |= (wd == 0) ? bit : 0u; m1 |= (wd == 1) ? bit : 0u; m2 |= (wd == 2) ? bit : 0u; m3 |= (wd == 3) ? bit : 0u;
            }
            m0 |= 1u;
            { const int n1 = cur - 1, n2 = cur; const unsigned b1 = 1u << (n1 & 31), b2 = 1u << (n2 & 31);
              m0 |= ((n1 >> 5) == 0 ? b1 : 0u) | ((n2 >> 5) == 0 ? b2 : 0u); m1 |= ((n1 >> 5) == 1 ? b1 : 0u) | ((n2 >> 5) == 1 ? b2 : 0u);
              m2 |= ((n1 >> 5) == 2 ? b1 : 0u) | ((n2 >> 5) == 2 ? b2 : 0u); m3 |= ((n1 >> 5) == 3 ? b1 : 0u) | ((n2 >> 5) == 3 ? b2 : 0u); }
        }
        if (slot8 == 0) { selm[tl * 4 + 0] = m0; selm[tl * 4 + 1] = m1; selm[tl * 4 + 2] = m2; selm[tl * 4 + 3] = m3; }
    }
    LDS_WAIT();
    __syncthreads();
    TSTAMP(2);
    const bool sparse = i >= 16;
    LAS float* mrefs = (LAS float*)(F.lds + L_MREF); LAS bf16* mail = (LAS bf16*)(F.lds + L_MAIL); LAS float* maill = (LAS float*)(F.lds + L_MAILL); LAS unsigned short* wher = (LAS unsigned short*)(F.lds + L_WHERE);
    LAS int* cnt = (LAS int*)(F.lds + L_CNT); LAS int* off = cnt + 128; LAS unsigned short* items = (LAS unsigned short*)(F.lds + L_ITEMS);
    LAS unsigned char* tokl = F.lds + L_TOKL;
    if (sparse) {
        if (tid < 128) { const int n = tid; int c = 0;
            if (n >= 1 && n <= i - 2) { const int wd = n >> 5, bt = n & 31;
                for (int t = 0; t < 64; ++t) if ((selm[t * 4 + wd] >> bt) & 1u) { tokl[n * 64 + c] = (unsigned char)t; ++c; } }
            cnt[n] = c; }
        if (tid < 256) wher[tid] = 0xffffu;
        __syncthreads();
        if (tid == 0) {
            int nr = 0, n = 1;
            while (n <= i - 2) { int nb = 0, tl = 0; const int n0 = n;
                while (n <= i - 2 && nb < 4) { const int tn = (cnt[n] + 7) >> 3; if (nb > 0 && tl + tn > 8) break; tl += tn; ++nb; ++n; }
                items[nr++] = (unsigned short)(n0 | (nb << 8)); }
            off[128] = nr; }
    }
    TSTAMP(3);
    const bf16* Kb = U + (size_t)b * SEQ * DINP + C_KS + g * 64; const bf16* Vb = U + (size_t)b * SEQ * DINP + C_VS + g * 64;
    st.mhat = NEGBIG; st.lsum = 0.f; st.o0 = (f32x16){}; st.o1 = (f32x16){};
    const int nd = sparse ? 3 : i + 1;
    load_q(qr, U, tok0, g, w, r32, hi);
    { const KVRegs r0 = kv_load(Kb, Vb, DINP, 0, w, lane); kv_store(kv, r0, tid); }
    __syncthreads();
    for (int sdx = 0; sdx < nd; ++sdx) {
        const int n = sparse ? (sdx == 0 ? 0 : i - 2 + sdx) : sdx;
        LAS unsigned char* slot = kv + (sdx & 1) * 16384;
        KVRegs nx; if (sdx + 1 < nd) { const int nn = sparse ? (i - 1 + sdx) : sdx + 1; nx = kv_load(Kb, Vb, DINP, nn * 64, w, lane); }
        f32x16 p0, p1; qk_tile(slot, qr, p0, p1, r32, hi);
        const int dist0 = tq - 64 * n;
        if (i - n <= 2) { bias_mask<true>(p0, p1, tbh, dist0, 1, 0, 0x7fffffff, true, hi); softmax_pv(st, p0, p1, slot + 8192, wsf, lane, r32, hi); }
        else softmax_pv_fast(st, p0, p1, C2S, tbh[127], slot + 8192, wsf, lane, r32, hi);
        if (sdx + 1 < nd) kv_store(kv + ((sdx + 1) & 1) * 16384, nx, tid);
        __syncthreads();
    }
    TSTAMP(4);
    if (sparse) {
        if (hi == 0) mrefs[32 * w + r32] = st.mhat;
        __syncthreads();
        const int NR = off[128];
#ifdef PROBE_SEC
        if (unit == 127 && tid == 0) { unsigned long long* tp = (unsigned long long*)((unsigned*)F.ctl + 210000); tp[10] = NR; unsigned long long sc = 0; for (int n = 0; n < 128; ++n) sc += cnt[n]; tp[12] = sc; }
#endif
        KVRegs pf0, pf1, pf2, pf3;
        { const int rr = items[0], n0 = rr & 255, nb = rr >> 8;
          pf0 = kv_load(Kb, Vb, DINP, 64 * n0, w, lane); if (nb > 1) pf1 = kv_load(Kb, Vb, DINP, 64 * (n0 + 1), w, lane);
          if (nb > 2) pf2 = kv_load(Kb, Vb, DINP, 64 * (n0 + 2), w, lane); if (nb > 3) pf3 = kv_load(Kb, Vb, DINP, 64 * (n0 + 3), w, lane); }
        for (int rd = 0; rd < NR; ++rd) {
            const int rr = __builtin_amdgcn_readfirstlane((int)items[rd]); const int n0 = rr & 255, nb = rr >> 8;
            kv_store(F.lds + L_KV, pf0, tid); if (nb > 1) kv_store(F.lds + L_KV + 16384, pf1, tid);
            if (nb > 2) kv_store(F.lds + L_SL2, pf2, tid); if (nb > 3) kv_store(F.lds + L_SL2 + 16384, pf3, tid);
            __syncthreads();
            if (rd + 1 < NR) { const int r2 = __builtin_amdgcn_readfirstlane((int)items[rd + 1]); const int m0 = r2 & 255, mb = r2 >> 8;
                pf0 = kv_load(Kb, Vb, DINP, 64 * m0, w, lane); if (mb > 1) pf1 = kv_load(Kb, Vb, DINP, 64 * (m0 + 1), w, lane);
                if (mb > 2) pf2 = kv_load(Kb, Vb, DINP, 64 * (m0 + 2), w, lane); if (mb > 3) pf3 = kv_load(Kb, Vb, DINP, 64 * (m0 + 3), w, lane); }
            const int t0c = (__builtin_amdgcn_readfirstlane(cnt[n0]) + 7) >> 3;
            const int t1c = nb > 1 ? (__builtin_amdgcn_readfirstlane(cnt[n0 + 1]) + 7) >> 3 : 0;
            const int t2c = nb > 2 ? (__builtin_amdgcn_readfirstlane(cnt[n0 + 2]) + 7) >> 3 : 0;
            const int t3c = nb > 3 ? (__builtin_amdgcn_readfirstlane(cnt[n0 + 3]) + 7) >> 3 : 0;
            const int tot = t0c + t1c + t2c + t3c;
            if (w < tot) { const int t = w;
                int sidx, k;
                if (t < t0c) { sidx = 0; k = t; } else if (t < t0c + t1c) { sidx = 1; k = t - t0c; } else if (t < t0c + t1c + t2c) { sidx = 2; k = t - t0c - t1c; } else { sidx = 3; k = t - t0c - t1c - t2c; }
                const int n = n0 + sidx; const LAS unsigned char* slot = F.lds + (sidx < 2 ? L_KV + sidx * 16384 : L_SL2 + (sidx - 2) * 16384);
                const int cn = __builtin_amdgcn_readfirstlane(cnt[n]);
                const int sl = 8 * k + (r32 >> 2); const bool rowok = sl < cn;
                const int tokq = tokl[n * 64 + (rowok ? sl : 0)]; const int row = tokq * 4 + (r32 & 3);
                bf16x8 q2[4];
                { const bf16* qp = U + (tok0 + tokq) * DINP + C_QN + (4 * g + (r32 & 3)) * 64 + 8 * hi;
#pragma unroll
                  for (int d0 = 0; d0 < 4; ++d0) q2[d0] = *(const bf16x8*)(qp + 16 * d0); }
                f32x16 p0, p1; qk_tile(slot, q2, p0, p1, r32, hi);
                const float mref = mrefs[row];
                if (n == i - 2) { bias_mask<true>(p0, p1, tbh, 64 * i + tokq - 64 * n, 1, 0, 0x7fffffff, rowok, hi);
#pragma unroll
                    for (int r = 0; r < 16; ++r) { p0[r] = __builtin_amdgcn_exp2f(fminf(p0[r] - mref, 100.f)); p1[r] = __builtin_amdgcn_exp2f(fminf(p1[r] - mref, 100.f)); } }
                else { const float sc = rowok ? C2S : 0.f, nbv = rowok ? tbh[127] - mref : NEGBIG;
#pragma unroll
                    for (int r = 0; r < 16; ++r) { p0[r] = __builtin_amdgcn_exp2f(fminf(__builtin_fmaf(p0[r], sc, nbv), 100.f)); p1[r] = __builtin_amdgcn_exp2f(fminf(__builtin_fmaf(p1[r], sc, nbv), 100.f)); } }
                { float sm = 0.f;
#pragma unroll
                  for (int r = 0; r < 16; ++r) sm += p0[r] + p1[r];
                  float t1; const float t0 = swap_lo(sm, t1);
                  if (hi == 0) { maill[32 * w + r32] = t0 + t1; if (rowok && (r32 & 3) == 0) wher[tokq * 4 + sidx] = (unsigned short)((w << 3) | (r32 >> 2)); } }
                SmState s2; s2.o0 = (f32x16){}; s2.o1 = (f32x16){};
                pv_tail(s2, p0, p1, slot + 8192, lane);
                stage_tile(mail + w * 2048, s2.o0, s2.o1, r32, hi);
            }
            __syncthreads();
#pragma unroll
            for (int a = 0; a < 4; ++a) { const int tk = 8 * w + 2 * a + hi;
#pragma unroll
                for (int jj = 0; jj < 4; ++jj) { const unsigned v = wher[tk * 4 + jj];
                    if (v != 0xffffu) { const LAS bf16* mp = mail + (v >> 3) * 2048 + (v & 7) * 256 + r32;
#pragma unroll
                        for (int e = 0; e < 4; ++e) { st.o0[4 * a + e] += bflo((unsigned)mp[e * 64]); st.o1[4 * a + e] += bflo((unsigned)mp[e * 64 + 32]); } } } }
            { const int tk = 8 * w + (r32 >> 2);
#pragma unroll
              for (int jj = 0; jj < 4; ++jj) { const unsigned v = wher[tk * 4 + jj]; if (v != 0xffffu && hi == 0) st.lsum += maill[(v >> 3) * 32 + (v & 7) * 4 + (r32 & 3)]; } }
            LDS_WAIT();
            if (lane < 32) wher[32 * w + lane] = 0xffffu;
        }
    }
    TSTAMP(5);
    finish_rows(st, wsf, r32, hi, false);
    const bf16* OW = (const bf16*)(F.ws + WS_OW); bf16* MIX = (bf16*)(F.ws + WS_MIX);
    { const bf16* gp = U + (tok0 + tql) * DINP + C_GN + (4 * g + (r32 & 3)) * 3;
      const float g1 = sigmoidf2(bflo((unsigned)gp[1]));
      if (hi == 0) wsf[r32] = g1;
      LDS_WAIT();
#pragma unroll
      for (int r = 0; r < 16; ++r) { const float g1r = wsf[crow(r, hi)]; const unsigned oc = park[r * 64]; st.o0[r] = bflo(oc) + g1r * st.o0[r]; st.o1[r] = bfhi(oc) + g1r * st.o1[r]; } }
    LDS_WAIT();
    LAS bf16* stg = (LAS bf16*)(F.lds + L_IMP) + w * 2048;
    stage_tile(stg, st.o0, st.o1, r32, hi);
    LDS_WAIT();
#pragma unroll
    for (int it = 0; it < 4; ++it) { const int row = it * 8 + (lane >> 3), ch = lane & 7;
        const size_t tk = tok0 + 8 * w + (row >> 2); const int hd = 4 * g + (row & 3), col = hd * 64 + ch * 8;
        const v4u t = *(const LAS v4u*)(stg + row * 64 + ch * 8);
        const v4u ow = *(const v4u*)(OW + tk * 512 + col); const v4u zz = *(const v4u*)(U + tk * DINP + C_ZN + col);
        const float g2 = sigmoidf2(bflo((unsigned)U[tk * DINP + C_GN + hd * 3 + 2]));
        const unsigned tw[4] = {t.x, t.y, t.z, t.w}, oww[4] = {ow.x, ow.y, ow.z, ow.w}, zw[4] = {zz.x, zz.y, zz.z, zz.w}; unsigned ov[4];
#pragma unroll
        for (int e = 0; e < 4; ++e) { const float z0 = bflo(zw[e]), z1 = bfhi(zw[e]);
            const float y0 = (bflo(tw[e]) + g2 * bflo(oww[e])) * z0 * sigmoidf2(z0), y1 = (bfhi(tw[e]) + g2 * bfhi(oww[e])) * z1 * sigmoidf2(z1);
            ov[e] = cvtpk(y0, y1); }
        *(v4u*)(MIX + tk * DM + col) = (v4u){ov[0], ov[1], ov[2], ov[3]}; }
    __syncthreads();
    TSTAMP(6);
}
template <class AT> __device__ __forceinline__ void p2_phase(Frame& F, const AT& A) {
    const int gw = F.vcu * NWAVES + F.wave, NGW = F.G * NWAVES;
    build_bias_table(F, A.in[I_RELB]);
    __syncthreads();
    for (int u = F.vcu; u < BATCH * NSA_G * 128; u += F.G) window_unit(F, u);
    __syncthreads();
    for (int u = F.vcu; u < 512; u += F.G) compress_unit(F, u);
    __syncthreads();
    LAS unsigned char* wl = F.lds + RING_OFF + F.wave * 16384;
    for (int cid = gw; cid < BATCH * GLA_H * NCHUNK; cid += NGW) gla_pass_a(F, A.in[I_BA], cid, wl);
}
constexpr int CW_Q = 200000;
template <class AT> __device__ __forceinline__ void p3_phase(Frame& F, const AT& A) {
    build_bias_table(F, A.in[I_RELB]);
    const int xq = (F.vcu >> 5) & 7;
    volatile LAS unsigned* bc = F.MISC + 16;
    if (F.tid == 0) bc[0] = __hip_atomic_fetch_add(F.ctl + CW_Q + 64 * xq, 1u, RLX_AGENT);
    __syncthreads();
    { const int item = (int)bc[0];
      if (item < 4) gla_scan_unit(F, A.in[I_GNW], 4 * xq + item, (LAS float*)(F.lds + RING_OFF)); }
    __syncthreads();
    for (;;) {
        if (F.tid == 0) bc[1] = __hip_atomic_fetch_add(F.ctl + CW_Q + 64 * (8 + xq), 1u, RLX_AGENT);
        __syncthreads();
        const int k = (int)bc[1];
        __syncthreads();
        if (k >= 256) break;
        nsa_unit(F, (2 * xq + (k & 1)) * 128 + 127 - (k >> 1));
    }
}
constexpr int N_LAUNCHES = MK_N_LAUNCHES;
constexpr int PER_PHASE = 7;
struct Args { const float* in[22]; float* out; unsigned char* ws; int ph_lo, ph_hi, li, pad; };
__global__ void __launch_bounds__(NWAVES * 64, 2) hymba_fwd(Args args) {
    extern __shared__ __attribute__((aligned(16))) unsigned char lds[];
    Frame F;
    F.lds = (LAS unsigned char*)lds;
    F.MISC = (volatile LAS unsigned*)(F.lds + MISC_OFF);
    F.tid = threadIdx.x; F.lane = F.tid & 63; F.wave = __builtin_amdgcn_readfirstlane(F.tid >> 6);
    F.G = gridDim.x; { const int bx = blockIdx.x; F.vcu = (F.G % 8 == 0) ? (bx % 8) * (F.G / 8) + bx / 8 : bx; }
    unsigned char* ws = args.ws; F.ws = ws; F.out = args.out;
    F.ctl = (gu32*)(ws + WS_CTL);
    for (int u = F.tid; u < (LDS_BYTES - LDSCTL_OFF) / 4; u += NWAVES * 64) ((LAS unsigned*)(F.lds + LDSCTL_OFF))[u] = 0u;
    __syncthreads();
    XcdBarrier bar; bar.bar = (unsigned*)(F.ctl + CW_BAR) + args.li * XCD_BAR_WORDS; bar.x = 0; bar.st = nullptr;
    if (N_LAUNCHES != PER_PHASE) bar = xcd_barrier_post((unsigned*)(F.ctl + CW_BAR) + args.li * XCD_BAR_WORDS, F.MISC + 8);
#define GRID_BAR() do { if (N_LAUNCHES != PER_PHASE) xcd_barrier(bar); } while (0)
    const int lo = args.ph_lo, hi = args.ph_hi;
#define IN(k) (lo <= (k) && (k) < hi)
#define REFRESH() do { int t_ = threadIdx.x; asm volatile("" : "+v"(t_)); F.tid = t_; F.lane = t_ & 63; } while (0)
#define BOTH(k) (IN(k) && IN((k) + 1))

    if (IN(0)) { REFRESH(); p0_prologue(F, args); if (BOTH(0)) GRID_BAR(); }
    if (IN(1)) { REFRESH();
        pg8::Gemm g{(const pg8::bf16_t*)(ws + WS_XN), (const pg8::bf16_t*)(ws + WS_WIN), M, DINP, DM}; pg8::StaticOrder S; S.init(M, DINP, F.G, (int)blockIdx.x);
        pg8::EpiBf16 E{(pg8::bf16_t*)(ws + WS_U), DINP};
        pg8::gemm_phase<pg8::EpiBf16, pg8::StaticOrder, true, true>(F.lds + RING_OFF, g, S, E);
        if (BOTH(1)) GRID_BAR();
    }
    if (IN(2)) { REFRESH();
        p2_phase(F, args);
        if (BOTH(2)) GRID_BAR();
    }
    if (IN(3)) { REFRESH();
        p3_phase(F, args);
        if (BOTH(3)) GRID_BAR();
    }
    if (IN(4)) { REFRESH();
        { pg8::Gemm g{(const pg8::bf16_t*)(ws + WS_MIX), (const pg8::bf16_t*)(ws + WS_WOUT), M, DM, DM}; pg8::StaticOrder S; S.init(M, DM, F.G, (int)blockIdx.x);
          pg8::EpiResid E{args.in[I_X], (const float*)(ws + WS_STATS), args.in[I_LN0G], args.in[I_LN0B], F.out, (pg8::bf16_t*)(ws + WS_RB), ALPHA_};
          pg8::gemm_phase<pg8::EpiResid, pg8::StaticOrder, true, true>(F.lds + RING_OFF, g, S, E); }
        { pg8::Gemm g{(const pg8::bf16_t*)(ws + WS_PB), (const pg8::bf16_t*)(ws + WS_WPE), M, DM, PLE}; pg8::StaticOrder S; S.init(M, DM, F.G, (int)blockIdx.x);
          pg8::EpiBf16 E{(pg8::bf16_t*)(ws + WS_EB), DM};
          pg8::gemm_phase<pg8::EpiBf16, pg8::StaticOrder, true, true>(F.lds + RING_OFF, g, S, E); }
        if (BOTH(4)) GRID_BAR();
    }
    if (IN(5)) { REFRESH();
        pg8::Gemm g{(const pg8::bf16_t*)(ws + WS_RB), (const pg8::bf16_t*)(ws + WS_WPG), M, DM, DM}; pg8::StaticOrder S; S.init(M, DM, F.G, (int)blockIdx.x);
        pg8::EpiGate E{F.out, (const pg8::bf16_t*)(ws + WS_EB), args.in[I_BPG]};
        pg8::gemm_phase<pg8::EpiGate, pg8::StaticOrder, true, true>(F.lds + RING_OFF, g, S, E);
        if (BOTH(5)) GRID_BAR();
    }
    if (IN(6)) { REFRESH(); final_ln(F, args.in[I_LNG], args.in[I_LNB]); }
#ifdef PROBE_SEC
    if (blockIdx.x == 0 && threadIdx.x == 0) { __threadfence(); const unsigned long long* tp = (const unsigned long long*)((unsigned*)F.ctl + 210000); { float xv = (float)(PROBE_SEC >= 10 ? tp[PROBE_SEC] : tp[PROBE_SEC] / 1000ull); if (PROBE_SEC < 10) xv = exp2f(rintf(2.0f * log2f(xv + 1.0f)) * 0.5f); F.out[0] = xv; } }
#endif
#undef IN
#undef BOTH
}

extern "C" void kernel_launch(void* const* d_in, const int* in_sizes, int n_in, void* d_out, int out_size, void* d_ws, size_t ws_size, hipStream_t stream) {
    static int grid = 0;
    if (grid == 0) {
        if (n_in != 22 || out_size != M * DM || ws_size < WS_END) { fprintf(stderr, "kernel_launch: unexpected shapes (n_in %d out %d ws %zu)\n", n_in, out_size, ws_size); grid = -1; return; }
        int dev = 0, cus = 0, per_cu = 0;
        if (hipGetDevice(&dev) != hipSuccess || hipDeviceGetAttribute(&cus, hipDeviceAttributeMultiprocessorCount, dev) != hipSuccess) { grid = -1; return; }
        if (hipFuncSetAttribute((const void*)hymba_fwd, hipFuncAttributeMaxDynamicSharedMemorySize, LDS_BYTES) != hipSuccess) { fprintf(stderr, "kernel_launch: hipFuncSetAttribute failed\n"); grid = -1; return; }
        if (hipOccupancyMaxActiveBlocksPerMultiprocessor(&per_cu, (const void*)hymba_fwd, NWAVES * 64, LDS_BYTES) != hipSuccess || per_cu < 1)
            fprintf(stderr, "kernel_launch: occupancy query reports %d workgroups per CU\n", per_cu);
        (void)hipGetLastError();
        grid = cus;
    }
    if (grid < 0) return;
    (void)hipMemsetAsync((char*)d_ws + WS_CTL, 0, CTL_ZERO_BYTES, stream);
    Args a{};
    for (int i = 0; i < 22; ++i) a.in[i] = (const float*)d_in[i];
    a.out = (float*)d_out; a.ws = (unsigned char*)d_ws;
#ifdef PROBE_SEQ
    { const int seq[][2] = PROBE_SEQ; const int nseq = (int)(sizeof(seq) / sizeof(seq[0]));
      for (int li = 0; li < nseq; ++li) { a.ph_lo = seq[li][0]; a.ph_hi = seq[li][1]; a.li = li; hipLaunchKernelGGL(hymba_fwd, dim3(grid), dim3(NWAVES * 64), LDS_BYTES, stream, a); } }
#else
    if (N_LAUNCHES == 1) { a.ph_lo = 0; a.ph_hi = PER_PHASE; a.li = 0; hipLaunchKernelGGL(hymba_fwd, dim3(grid), dim3(NWAVES * 64), LDS_BYTES, stream, a); }
    else for (int li = 0; li < PER_PHASE; ++li) { a.ph_lo = li; a.ph_hi = li + 1; a.li = 0; hipLaunchKernelGGL(hymba_fwd, dim3(grid), dim3(NWAVES * 64), LDS_BYTES, stream, a); }
#endif
}
```

```cpp
#include <hip/hip_runtime.h>
#include <hip/hip_bf16.h>
#include <cstdio>
#include <cstdint>
namespace pg8 {
#define PG8_LAS __attribute__((address_space(3)))
typedef unsigned short bf16_t;
typedef short bf16x8 __attribute__((ext_vector_type(8)));
typedef float f32x4 __attribute__((ext_vector_type(4)));
typedef unsigned u32x4 __attribute__((ext_vector_type(4)));
constexpr int BM = 256, BK = 64, HALF = 128, HTB = HALF * BK * 2  , STAGE_BYTES = 8 * HTB, NXCD = 8, WGM = 8;

__host__ __device__ __forceinline__ int lds_byte(int r, int c) { const int st = (r >> 4) * 2 + (c >> 5), rr = r & 15, cc = c & 31, ob = rr * 64 + cc * 2; return st * 1024 + (ob ^ (((ob >> 9) & 1) << 5)); }
__host__ __device__ __forceinline__ void stage_rc(int b, int& R, int& C) { const int st = b / 1024, sb = b % 1024, swz = sb ^ (((sb >> 9) & 1) << 5); R = (st >> 1) * 16 + swz / 64; C = (st & 1) * 32 + (swz % 64) / 2; }
__host__ __device__ __forceinline__ int perm32(int rho) { const int n = rho >> 4, i = rho & 15; return 8 * (i >> 2) + 4 * n + (i & 3); }

struct Unit { int pm, pn; };
struct Gemm { const bf16_t* A; const bf16_t* Bt; int M, N, K; };

struct StaticOrder {
    int nM, nN, nwg, G, c;
    __host__ __device__ void init(int M, int N, int G_, int c_) { nM = M / BM; nN = N / BM; nwg = nM * nN; G = G_; c = c_; }
    __host__ __device__ bool next(int i, Unit& u) const {
        const long L = (long)i * G + c; if (L >= nwg) return false;
        int wgid = (int)L; { const int q = nwg / NXCD, r = nwg % NXCD, xcd = wgid % NXCD, off = wgid / NXCD; wgid = (xcd < r ? xcd * (q + 1) : r * (q + 1) + (xcd - r) * q) + off; }
        const int nig = WGM * nN, gid = wgid / nig, fm = gid * WGM, gsz = (nM - fm) < WGM ? (nM - fm) : WGM;
        u.pm = fm + ((wgid % nig) % gsz); u.pn = (wgid % nig) / gsz; return true;
    }
    __device__ __forceinline__ void a_ready(const Unit&) const {}
    __device__ __forceinline__ void done(const Unit&) const {}
};
__device__ __forceinline__ unsigned cvt_pk_bf16(float lo, float hi) { unsigned r; asm volatile("v_cvt_pk_bf16_f32 %0, %1, %2" : "=v"(r) : "v"(lo), "v"(hi)); return r; }
struct EpiBf16 {
    static constexpr bool PERM = true, AFTER_DRAIN = false;
    bf16_t* O; int ldc;
    __device__ __forceinline__ void operator()(const f32x4 (&acc)[2][2][4][2], const Unit& u, int wr, int wc, int fr, int fq) const {
        const int row0 = u.pm * BM + wr * 64 + fr; const int col0 = u.pn * BM + wc * 32 + 8 * fq;
#pragma unroll
        for (int ai = 0; ai < 2; ++ai)
#pragma unroll
            for (int m = 0; m < 4; ++m) { bf16_t* rowp = O + (size_t)(row0 + ai * HALF + m * 16) * ldc + col0;
#pragma unroll
                for (int bj = 0; bj < 2; ++bj) { const f32x4 v0 = acc[ai][bj][m][0], v1 = acc[ai][bj][m][1];
                    u32x4 w; w.x = cvt_pk_bf16(v0[0], v0[1]); w.y = cvt_pk_bf16(v0[2], v0[3]); w.z = cvt_pk_bf16(v1[0], v1[1]); w.w = cvt_pk_bf16(v1[2], v1[3]);
                    *(u32x4*)(rowp + bj * HALF) = w; } }
    }
};
struct EpiResid {
    static constexpr bool PERM = true, AFTER_DRAIN = false;
    const float* x; const float* stats; const float* g; const float* b; float* out; bf16_t* rb; float alpha;
    __device__ __forceinline__ void operator()(const f32x4 (&acc)[2][2][4][2], const Unit& u, int wr, int wc, int fr, int fq) const {
        const int row0 = u.pm * BM + wr * 64 + fr; const int col0 = u.pn * BM + wc * 32 + 8 * fq;
        f32x4 gv[2][2], bv[2][2];
#pragma unroll
        for (int bj = 0; bj < 2; ++bj)
#pragma unroll
            for (int n = 0; n < 2; ++n) { gv[bj][n] = *(const f32x4*)(g + col0 + bj * HALF + 4 * n) * alpha; bv[bj][n] = *(const f32x4*)(b + col0 + bj * HALF + 4 * n) * alpha; }
#pragma unroll
        for (int ai = 0; ai < 2; ++ai)
#pragma unroll
            for (int m = 0; m < 4; ++m) { const int row = row0 + ai * HALF + m * 16; const size_t off = (size_t)row * 1024 + col0;
                const float mean = stats[2 * row], rstd = stats[2 * row + 1];
#pragma unroll
                for (int bj = 0; bj < 2; ++bj) {
                    const f32x4 x0 = *(const f32x4*)(x + off + bj * HALF), x1 = *(const f32x4*)(x + off + bj * HALF + 4);
                    const f32x4 v0 = ((x0 - mean) * rstd) * gv[bj][0] + bv[bj][0] + acc[ai][bj][m][0];
                    const f32x4 v1 = ((x1 - mean) * rstd) * gv[bj][1] + bv[bj][1] + acc[ai][bj][m][1];
                    *(f32x4*)(out + off + bj * HALF) = v0; *(f32x4*)(out + off + bj * HALF + 4) = v1;
                    u32x4 w; w.x = cvt_pk_bf16(v0[0], v0[1]); w.y = cvt_pk_bf16(v0[2], v0[3]); w.z = cvt_pk_bf16(v1[0], v1[1]); w.w = cvt_pk_bf16(v1[2], v1[3]);
                    *(u32x4*)(rb + off + bj * HALF) = w; } }
    }
};
__device__ __forceinline__ float bf_lo(unsigned w) { return __uint_as_float(w << 16); }
__device__ __forceinline__ float bf_hi(unsigned w) { return __uint_as_float(w & 0xffff0000u); }
__device__ __forceinline__ float sigmoidf_(float v) { return __builtin_amdgcn_rcpf(1.0f + __builtin_amdgcn_exp2f(-1.4426950408889634f * v)); }
struct EpiGate {
    static constexpr bool PERM = true, AFTER_DRAIN = false;
    float* out; const bf16_t* E; const float* bias;
    __device__ __forceinline__ void operator()(const f32x4 (&acc)[2][2][4][2], const Unit& u, int wr, int wc, int fr, int fq) const {
        const int row0 = u.pm * BM + wr * 64 + fr; const int col0 = u.pn * BM + wc * 32 + 8 * fq;
        f32x4 bv[2][2];
#pragma unroll
        for (int bj = 0; bj < 2; ++bj)
#pragma unroll
            for (int n = 0; n < 2; ++n) bv[bj][n] = *(const f32x4*)(bias + col0 + bj * HALF + 4 * n);
#pragma unroll
        for (int ai = 0; ai < 2; ++ai)
#pragma unroll
            for (int m = 0; m < 4; ++m) { const int row = row0 + ai * HALF + m * 16; const size_t off = (size_t)row * 1024 + col0;
#pragma unroll
                for (int bj = 0; bj < 2; ++bj) {
                    const f32x4 r0 = *(const f32x4*)(out + off + bj * HALF), r1 = *(const f32x4*)(out + off + bj * HALF + 4);
                    const u32x4 e = *(const u32x4*)(E + off + bj * HALF);
                    const f32x4 a0 = acc[ai][bj][m][0] + bv[bj][0], a1 = acc[ai][bj][m][1] + bv[bj][1];
                    f32x4 v0, v1;
                    v0[0] = r0[0] + sigmoidf_(a0[0]) * bf_lo(e.x); v0[1] = r0[1] + sigmoidf_(a0[1]) * bf_hi(e.x);
                    v0[2] = r0[2] + sigmoidf_(a0[2]) * bf_lo(e.y); v0[3] = r0[3] + sigmoidf_(a0[3]) * bf_hi(e.y);
                    v1[0] = r1[0] + sigmoidf_(a1[0]) * bf_lo(e.z); v1[1] = r1[1] + sigmoidf_(a1[1]) * bf_hi(e.z);
                    v1[2] = r1[2] + sigmoidf_(a1[2]) * bf_lo(e.w); v1[3] = r1[3] + sigmoidf_(a1[3]) * bf_hi(e.w);
                    *(f32x4*)(out + off + bj * HALF) = v0; *(f32x4*)(out + off + bj * HALF + 4) = v1; } }
    }
};
template <class Epi, class Sched, bool ALIGN_EPI = false, bool SP2 = false>
__device__ __forceinline__ void gemm_phase(PG8_LAS unsigned char* lds, const Gemm g, const Sched& S, const Epi& E) {
    const int tid = threadIdx.x, wid = __builtin_amdgcn_readfirstlane(tid >> 6), lane = tid & 63, wr = wid >> 2, wc = wid & 3, fr = lane & 15, fq = lane >> 4;
    const int K = g.K, nt = K / BK;
    unsigned voffA[2], voffB[2];
#pragma unroll
    for (int i = 0; i < 2; ++i) { int R, C; stage_rc(tid * 16 + i * 8192, R, C); const int Rb = Epi::PERM ? ((R & ~31) + perm32(R & 31)) : R;
        voffA[i] = (unsigned)(R * K + C) * 2u; voffB[i] = (unsigned)(Rb * K + C) * 2u; }
    const size_t kstep = (size_t)(BK * 2);
    const size_t hstep = (size_t)HALF * K * 2;
    const size_t tstep = 2 * hstep;
    const unsigned ldsw = (unsigned)wid * 1024u;
    const int aoff = lds_byte(wr * 64 + fr, fq * 8), boff = lds_byte(wc * 32 + fr, fq * 8);
#define PG8_SA(b, h) (((b) * 2 + (h)) * HTB)
#define PG8_SB(b, h) ((4 + (b) * 2 + (h)) * HTB)
#define PG8_STAGE(bufoff, gbase, voff) do { _Pragma("unroll") for (int _i = 0; _i < 2; ++_i) \
        __builtin_amdgcn_global_load_lds((const unsigned*)((const char*)(gbase) + (voff)[_i]), (PG8_LAS unsigned*)(lds + (bufoff) + ldsw + _i * 8192), 16, 0, 0); } while (0)
#define PG8_LDA(dst, b, h) do { _Pragma("unroll") for (int m = 0; m < 4; ++m) _Pragma("unroll") for (int k = 0; k < 2; ++k) dst[m][k] = *(const PG8_LAS bf16x8*)(lds + PG8_SA(b, h) + aoff + m * 2048 + k * 1024); } while (0)
#define PG8_LDB(dst, b, h) do { _Pragma("unroll") for (int n = 0; n < 2; ++n) _Pragma("unroll") for (int k = 0; k < 2; ++k) dst[n][k] = *(const PG8_LAS bf16x8*)(lds + PG8_SB(b, h) + boff + n * 2048 + k * 1024); } while (0)
#define PG8_MMA(ai, bj, At, Bt) do { __builtin_amdgcn_s_setprio(1); _Pragma("unroll") for (int m = 0; m < 4; ++m) _Pragma("unroll") for (int n = 0; n < 2; ++n) _Pragma("unroll") for (int k = 0; k < 2; ++k) \
        acc[ai][bj][m][n] = __builtin_amdgcn_mfma_f32_16x16x32_bf16(Bt[n][k], At[m][k], acc[ai][bj][m][n], 0, 0, 0); __builtin_amdgcn_s_setprio(0); } while (0)
#define PG8_WAIT_V(n) asm volatile("s_waitcnt vmcnt(" #n ")" ::: "memory")
#define PG8_WAIT_L(n) asm volatile("s_waitcnt lgkmcnt(" #n ")" ::: "memory")
#define PG8_BAR __builtin_amdgcn_s_barrier()
#define PG8_SCHED __builtin_amdgcn_sched_barrier(0)
    Unit cur, nxt; int ui = 0;
    if (!S.next(0, cur)) return;
    f32x4 acc[2][2][4][2];
#pragma unroll
    for (int a = 0; a < 2; ++a)
#pragma unroll
        for (int b = 0; b < 2; ++b)
#pragma unroll
            for (int m = 0; m < 4; ++m)
#pragma unroll
                for (int n = 0; n < 2; ++n) acc[a][b][m][n] = (f32x4){0.f, 0.f, 0.f, 0.f};
    bf16x8 At[4][2], B0[2][2], B1[2][2];
    const char* cA = (const char*)g.A + (size_t)cur.pm * tstep; const char* cB = (const char*)g.Bt + (size_t)cur.pn * tstep;
    S.a_ready(cur);
    if constexpr (SP2) {
        PG8_STAGE(PG8_SB(0, 0), cB, voffB); PG8_STAGE(PG8_SB(0, 1), cB + hstep, voffB); PG8_STAGE(PG8_SA(0, 0), cA, voffA); PG8_STAGE(PG8_SA(0, 1), cA + hstep, voffA);
        if (wr == 1) PG8_BAR;
        PG8_WAIT_V(2); PG8_BAR;
        PG8_STAGE(PG8_SB(1, 0), cB + kstep, voffB); PG8_STAGE(PG8_SA(1, 0), cA + kstep, voffA); PG8_STAGE(PG8_SB(1, 1), cB + hstep + kstep, voffB);
        PG8_WAIT_V(6); PG8_BAR;
    } else {
        PG8_STAGE(PG8_SB(0, 0), cB, voffB); PG8_STAGE(PG8_SA(0, 0), cA, voffA); PG8_STAGE(PG8_SB(0, 1), cB + hstep, voffB); PG8_STAGE(PG8_SA(0, 1), cA + hstep, voffA);
        if (wr == 1) PG8_BAR;
        PG8_WAIT_V(4); PG8_BAR;
        PG8_STAGE(PG8_SB(1, 0), cB + kstep, voffB); PG8_STAGE(PG8_SA(1, 0), cA + kstep, voffA); PG8_STAGE(PG8_SB(1, 1), cB + hstep + kstep, voffB);
        PG8_WAIT_V(6); PG8_BAR;
    }
    for (;;) {
        const bool has_next = S.next(ui + 1, nxt);
        const char* nA = has_next ? (const char*)g.A + (size_t)nxt.pm * tstep : cA; const char* nB = has_next ? (const char*)g.Bt + (size_t)nxt.pn * tstep : cB;
        for (int t = 0; t < nt; t += 2) {
            const bool last = (t == nt - 2);
            const char* a1 = cA + (size_t)(t + 1) * kstep;
            const char* a2 = last ? nA : cA + (size_t)(t + 2) * kstep; const char* b2 = last ? nB : cB + (size_t)(t + 2) * kstep;
            const char* a3 = a2 + kstep; const char* b3 = b2 + kstep;
            if (last && has_next) S.a_ready(nxt);
            if constexpr (SP2) {
            PG8_LDB(B0, 0, 0); PG8_LDB(B1, 0, 1); PG8_SCHED; PG8_LDA(At, 0, 0); PG8_STAGE(PG8_SA(1, 1), a1 + hstep, voffA);
            PG8_WAIT_V(8); PG8_WAIT_L(0); PG8_BAR; PG8_MMA(0, 0, At, B0); PG8_MMA(0, 1, At, B1); PG8_BAR; PG8_SCHED;
            PG8_LDA(At, 0, 1); PG8_STAGE(PG8_SB(0, 0), b2, voffB); PG8_STAGE(PG8_SB(0, 1), b2 + hstep, voffB); PG8_STAGE(PG8_SA(0, 0), a2, voffA);
            PG8_WAIT_V(8); PG8_WAIT_L(0); PG8_BAR; PG8_MMA(1, 0, At, B0); PG8_MMA(1, 1, At, B1); PG8_BAR; PG8_SCHED;
            PG8_LDB(B0, 1, 0); PG8_LDB(B1, 1, 1); PG8_SCHED; PG8_LDA(At, 1, 0); PG8_STAGE(PG8_SA(0, 1), a2 + hstep, voffA);
            PG8_WAIT_V(8); PG8_WAIT_L(0); PG8_BAR; PG8_MMA(0, 0, At, B0); PG8_MMA(0, 1, At, B1); PG8_BAR; PG8_SCHED;
            PG8_LDA(At, 1, 1); PG8_STAGE(PG8_SB(1, 0), b3, voffB); PG8_STAGE(PG8_SB(1, 1), b3 + hstep, voffB); PG8_STAGE(PG8_SA(1, 0), a3, voffA);
            PG8_WAIT_V(8); PG8_WAIT_L(0); PG8_BAR; PG8_MMA(1, 0, At, B0); PG8_MMA(1, 1, At, B1); PG8_BAR; PG8_SCHED;
            } else {
            PG8_LDB(B0, 0, 0); PG8_SCHED; PG8_LDA(At, 0, 0); PG8_STAGE(PG8_SA(1, 1), a1 + hstep, voffA);
            PG8_WAIT_L(8); PG8_BAR; PG8_WAIT_L(0); PG8_MMA(0, 0, At, B0); PG8_BAR; PG8_SCHED;
            PG8_LDB(B1, 0, 1); PG8_STAGE(PG8_SB(0, 0), b2, voffB);
            PG8_BAR; PG8_WAIT_L(0); PG8_MMA(0, 1, At, B1); PG8_BAR;
            PG8_LDA(At, 0, 1); PG8_STAGE(PG8_SA(0, 0), a2, voffA);
            PG8_BAR; PG8_WAIT_L(0); PG8_MMA(1, 0, At, B0); PG8_BAR; PG8_SCHED;
            PG8_STAGE(PG8_SB(0, 1), b2 + hstep, voffB);
            PG8_WAIT_V(6); PG8_BAR; PG8_MMA(1, 1, At, B1); PG8_BAR;
            PG8_LDB(B0, 1, 0); PG8_SCHED; PG8_LDA(At, 1, 0); PG8_STAGE(PG8_SA(0, 1), a2 + hstep, voffA);
            PG8_WAIT_L(8); PG8_BAR; PG8_WAIT_L(0); PG8_MMA(0, 0, At, B0); PG8_BAR; PG8_SCHED;
            PG8_LDB(B1, 1, 1); PG8_STAGE(PG8_SB(1, 0), b3, voffB);
            PG8_BAR; PG8_WAIT_L(0); PG8_MMA(0, 1, At, B1); PG8_BAR;
            PG8_LDA(At, 1, 1); PG8_STAGE(PG8_SA(1, 0), a3, voffA);
            PG8_BAR; PG8_WAIT_L(0); PG8_MMA(1, 0, At, B0); PG8_BAR; PG8_SCHED;
            PG8_STAGE(PG8_SB(1, 1), b3 + hstep, voffB);
            PG8_WAIT_V(6); PG8_BAR; PG8_MMA(1, 1, At, B1); PG8_BAR;
            }
        }
        if constexpr (ALIGN_EPI) { if (wr == 0) PG8_BAR; }
        if constexpr (!Epi::AFTER_DRAIN) { E(acc, cur, wr, wc, fr, fq); S.done(cur); }
        if (!has_next) break;
#pragma unroll
        for (int a = 0; a < 2; ++a)
#pragma unroll
            for (int b = 0; b < 2; ++b)
#pragma unroll
                for (int m = 0; m < 4; ++m)
#pragma unroll
                    for (int n = 0; n < 2; ++n) acc[a][b][m][n] = (f32x4){0.f, 0.f, 0.f, 0.f};
        cur = nxt; cA = nA; cB = nB; ++ui;
        if constexpr (ALIGN_EPI) { if (wr == 1) PG8_BAR; }
    }
    PG8_WAIT_V(0);
    if constexpr (!ALIGN_EPI) { if (wr == 0) PG8_BAR; }
    PG8_BAR;
    if constexpr (Epi::AFTER_DRAIN) { E.fused(acc, cur, wr, wc, fr, fq, lds, wid, lane); S.done(cur); }
#undef PG8_SA
#undef PG8_SB
#undef PG8_STAGE
#undef PG8_LDA
#undef PG8_LDB
#undef PG8_MMA
#undef PG8_WAIT_V
#undef PG8_WAIT_L
#undef PG8_BAR
#undef PG8_SCHED
}
}
constexpr int NWAVES = 8;
#ifndef MK_N_LAUNCHES
#define MK_N_LAUNCHES 1
#endif
constexpr int BATCH = 8, SEQ = 8192, DM = 1024, M = BATCH * SEQ;
constexpr int PLE = 256, DIN = 3368, DINP = 3584;
constexpr int NSA_H = 8, NSA_G = 2, NSA_R = 4, DH = 64, NC = 511, NCP = 512;
constexpr int CMPH = 256, CMPK = 2048;
constexpr int GLA_H = 4, GDK = 64, GDV = 128, GRANK = 16, GCH = 64, NCHUNK = SEQ / GCH;
constexpr int C_QN = 0, C_KC = 512, C_VC = 640, C_KS = 768, C_VS = 896, C_KW = 1024, C_VW = 1152, C_GN = 1280, C_ZN = 1304,
              C_QG = 1816, C_KG = 2072, C_VG = 2328, C_AL = 2840, C_ZG = 2856;
constexpr float LN_EPS = 1e-5f;
constexpr float ALPHA_ = 1.189207115002721f;
constexpr float LOG2E = 1.4426950408889634f;

constexpr size_t MiB = 1u << 20;
constexpr size_t WS_CTL = 0, CTL_ZERO_BYTES = 1 * MiB;
constexpr size_t WS_WIN = 1 * MiB;
constexpr size_t WS_WOUT = 8 * MiB, WS_WPG = 10 * MiB;
constexpr size_t WS_WPE = 12 * MiB;
constexpr size_t WS_WCK1 = 13 * MiB, WS_WCV1 = 14 * MiB;
constexpr size_t WS_SMALL = 15 * MiB;
constexpr size_t SM_WCK2 = 0, SM_WCV2 = 32768, SM_WA2 = 65536, SM_CB1K = 73728, SM_CB1V = 74752;
constexpr size_t WS_STATS = 16 * MiB;
constexpr size_t WS_KC = 17 * MiB, WS_VC = 18 * MiB;
constexpr size_t WS_DEC = 19 * MiB;
constexpr size_t WS_XN = 20 * MiB;
constexpr size_t WS_MIX = WS_XN;
constexpr size_t WS_PB = 148 * MiB;
constexpr size_t WS_U = 180 * MiB;
constexpr size_t WS_EB = WS_U;
constexpr size_t WS_OW = 629 * MiB;
constexpr size_t WS_QE = 693 * MiB;
constexpr size_t WS_KV = 725 * MiB;
constexpr size_t WS_RB = WS_KV;
constexpr size_t WS_OI = 853 * MiB;
constexpr size_t WS_VST = 917 * MiB;
constexpr size_t WS_PARK = 933 * MiB;
constexpr size_t WS_END = 965 * MiB;
constexpr int CW_BAR = 4096;

constexpr int RING_OFF = 0, RING_BYTES = 155648;
constexpr int LDSCTL_OFF = RING_BYTES, MISC_OFF = LDSCTL_OFF + 320;
constexpr int LDS_BYTES = 163840;

#define GAS __attribute__((address_space(1)))
#define LAS __attribute__((address_space(3)))
typedef unsigned short bf16;
typedef unsigned v4u __attribute__((ext_vector_type(4)));
typedef unsigned v2u __attribute__((ext_vector_type(2)));
typedef float f32x4 __attribute__((ext_vector_type(4)));
typedef float f32x16 __attribute__((ext_vector_type(16)));
typedef short bf16x8 __attribute__((ext_vector_type(8)));
typedef GAS unsigned gu32;
#define RLX_AGENT __ATOMIC_RELAXED, __HIP_MEMORY_SCOPE_AGENT
#define LDS_WAIT() asm volatile("s_waitcnt lgkmcnt(0)" ::: "memory")
#define VM_WAIT() asm volatile("s_waitcnt vmcnt(0)" ::: "memory")
__device__ __forceinline__ unsigned f2bf(float f) { unsigned u = __builtin_bit_cast(unsigned, f); return (u + 0x7fffu + ((u >> 16) & 1u)) >> 16; }
__device__ __forceinline__ unsigned pk2(float lo, float hi) { return f2bf(lo) | (f2bf(hi) << 16); }
__device__ __forceinline__ float bflo(unsigned w) { return __uint_as_float(w << 16); }
__device__ __forceinline__ float bfhi(unsigned w) { return __uint_as_float(w & 0xffff0000u); }
__device__ __forceinline__ float sigmoidf2(float v) { return __builtin_amdgcn_rcpf(1.0f + __builtin_amdgcn_exp2f(-1.4426950408889634f * v)); }
#define XB_TMO      128
#define XB_XCNT(j)  (256  + 64 * (j))
#define XB_XSUB(j)  (1280 + 64 * (j))
#define XB_XGEN(j)  (2304 + 64 * (j))
#define XB_TOP      3328
#define XB_TOPGEN   3392
#define XCD_BAR_WORDS 3456
#define XB_SPIN_CAP (1u << 18)

__device__ __forceinline__ unsigned xb_ld(unsigned* p)              { return __hip_atomic_load(p, __ATOMIC_RELAXED, __HIP_MEMORY_SCOPE_AGENT); }
__device__ __forceinline__ unsigned xb_add(unsigned* p, unsigned v) { return __hip_atomic_fetch_add(p, v, __ATOMIC_RELAXED, __HIP_MEMORY_SCOPE_AGENT); }
__device__ __forceinline__ unsigned xb_xcc_id() { return (unsigned)__builtin_amdgcn_s_getreg((3 << 11) | 20) & 0xFu; }
#define XB_SPIN(cond, bar) do { unsigned _sp = 0; while (cond) { __builtin_amdgcn_s_sleep(1); \
    if ((++_sp & 255u) == 0u) { if (xb_ld(&(bar)[XB_TMO])) break; if (_sp > XB_SPIN_CAP) { atomicAdd(&(bar)[XB_TMO], 1u); break; } } } } while (0)

struct XcdBarrier {
    unsigned* bar; unsigned x;
    volatile LAS unsigned* st;
};

__device__ __forceinline__ XcdBarrier xcd_barrier_post(unsigned* bar, volatile LAS unsigned* st) {
    XcdBarrier b; b.bar = bar; b.x = xb_xcc_id(); b.st = st;
    if (threadIdx.x == 0) (void)xb_add(&bar[XB_XCNT(b.x)], 1u);
    return b;
}
__device__ __forceinline__ void xcd_barrier_complete(unsigned* bar, unsigned x, unsigned& nloc, unsigned& nx) {
    const unsigned G = gridDim.x * gridDim.y * gridDim.z;
    unsigned sum, cnt, mine, sp = 0u;
    for (;;) {
        sum = 0u; cnt = 0u; mine = 0u;
#pragma unroll
        for (unsigned j = 0; j < 16; ++j) { const unsigned c = xb_ld(&bar[XB_XCNT(j)]); sum += c; cnt += (c > 0u) ? 1u : 0u; mine = (j == x) ? c : mine; }
        if (sum == G) break;
        __builtin_amdgcn_s_sleep(1);
        if ((++sp & 255u) == 0u) { if (xb_ld(&bar[XB_TMO])) break; if (sp > XB_SPIN_CAP) { atomicAdd(&bar[XB_TMO], 1u); break; } }
    }
    nloc = mine > 0u ? mine : 1u; nx = cnt > 0u ? cnt : 1u;
}

__device__ __forceinline__ void xcd_barrier(const XcdBarrier& b) {
    asm volatile("s_waitcnt vmcnt(0)" ::: "memory");
    __syncthreads();
    if (threadIdx.x == 0) {
        unsigned* bar = b.bar;
        __builtin_amdgcn_s_waitcnt(0);
        unsigned nloc = b.st[0], nx = b.st[1];
        if (nloc == 0u) { xcd_barrier_complete(bar, b.x, nloc, nx); b.st[0] = nloc; b.st[1] = nx; }
        const unsigned old = xb_add(&bar[XB_XSUB(b.x)], 1u);
        const unsigned gen = old / nloc;
        if (old + 1u == (gen + 1u) * nloc) {
            __builtin_amdgcn_fence(__ATOMIC_RELEASE, "agent");
            asm volatile("s_waitcnt vmcnt(0)" ::: "memory");
            const unsigned og = xb_add(&bar[XB_TOP], 1u);
            const unsigned tg = og / nx;
            if (og + 1u == (tg + 1u) * nx) xb_add(&bar[XB_TOPGEN], 1u);
            else XB_SPIN(xb_ld(&bar[XB_TOPGEN]) == tg, bar);
            __builtin_amdgcn_fence(__ATOMIC_ACQUIRE, "agent");
            xb_add(&bar[XB_XGEN(b.x)], 1u);
            asm volatile("s_waitcnt vmcnt(0)" ::: "memory");
        } else {
            XB_SPIN(xb_ld(&bar[XB_XGEN(b.x)]) == gen, bar);
            __builtin_amdgcn_fence(__ATOMIC_ACQUIRE, "agent");
            asm volatile("s_waitcnt vmcnt(0)" ::: "memory");
        }
    }
    __syncthreads();
}
struct Frame {
    LAS unsigned char* lds;
    volatile LAS unsigned* MISC;
    gu32* ctl;
    int tid, lane, wave;
    int vcu, G;
    float* out; unsigned char* ws;
};
enum { I_X = 0, I_P, I_LN0G, I_LN0B, I_RELB, I_WIN, I_WA2, I_BA, I_GNW, I_POS, I_WCK1, I_BCK1, I_WCK2, I_WCV1, I_BCV1, I_WCV2, I_WOUT, I_WPE, I_WPG, I_BPG, I_LNG, I_LNB };

__device__ __forceinline__ float wave_sum(float v) {
#pragma unroll
    for (int o = 1; o < 64; o <<= 1) v += __shfl_xor(v, o);
    return v;
}
__device__ __forceinline__ void p0_transpose_item(const float* W, int K, int N, int nblk, bf16* WT, LAS float* scr, int item, int lane) {
    const int kb = item / nblk, nb = item % nblk, k0 = 64 * kb, n0 = 32 * nb;
    const int nn = n0 + (lane & 31);
#pragma unroll 8
    for (int i = 0; i < 32; ++i) { const int kk = 2 * i + (lane >> 5); scr[kk * 33 + (lane & 31)] = (nn < N) ? W[(size_t)(k0 + kk) * N + nn] : 0.f; }
    LDS_WAIT(); asm volatile("" ::: "memory");
    const int c = lane & 7;
#pragma unroll
    for (int j = 0; j < 4; ++j) { const int n = (lane >> 3) + 8 * j; const LAS float* s = scr + (8 * c) * 33 + n;
        v4u o; o.x = pk2(s[0 * 33], s[1 * 33]); o.y = pk2(s[2 * 33], s[3 * 33]); o.z = pk2(s[4 * 33], s[5 * 33]); o.w = pk2(s[6 * 33], s[7 * 33]);
        *(v4u*)(WT + (size_t)(n0 + n) * K + k0 + 8 * c) = o; }
    LDS_WAIT(); asm volatile("" ::: "memory");
}
__device__ __forceinline__ void ln0_row(const float* xrow, const float* g, const float* b, bf16* orow, float* st, int lane) {
    const f32x4* xr = (const f32x4*)xrow + lane;
    f32x4 v[4]; float s = 0.f;
#pragma unroll
    for (int j = 0; j < 4; ++j) { v[j] = xr[64 * j]; s += (v[j].x + v[j].y) + (v[j].z + v[j].w); }
    const float mean = wave_sum(s) * (1.f / DM); float s2 = 0.f;
#pragma unroll
    for (int j = 0; j < 4; ++j) { v[j] = v[j] - mean; s2 += (v[j].x * v[j].x + v[j].y * v[j].y) + (v[j].z * v[j].z + v[j].w * v[j].w); }
    const float rstd = 1.f / sqrtf(wave_sum(s2) * (1.f / DM) + LN_EPS);
    if (lane == 0) { st[0] = mean; st[1] = rstd; }
    unsigned long long* o8 = (unsigned long long*)orow + lane;
#pragma unroll
    for (int j = 0; j < 4; ++j) { const f32x4 gg = ((const f32x4*)g)[lane + 64 * j], bb = ((const f32x4*)b)[lane + 64 * j]; const f32x4 y = v[j] * rstd * gg + bb;
        o8[64 * j] = (unsigned long long)pk2(y.x, y.y) | ((unsigned long long)pk2(y.z, y.w) << 32); }
}
template <class AT> __device__ __forceinline__ void p0_prologue(Frame& F, const AT& A) {
    LAS float* scr = (LAS float*)(F.lds + RING_OFF + F.wave * 16384);
    const int gw = F.vcu * NWAVES + F.wave, NGW = F.G * NWAVES;
    unsigned char* ws = F.ws;
    constexpr int I_IN = (DM / 64) * (DINP / 32), I_SQ = (DM / 64) * (DM / 32), I_PE = (PLE / 64) * (DM / 32), I_C1 = (CMPK / 64) * (CMPH / 32), I_C2 = (CMPH / 64) * (DH / 32);
    constexpr int NITEMS = I_IN + 2 * I_SQ + I_PE + 2 * I_C1 + 2 * I_C2;
    for (int it = gw; it < NITEMS; it += NGW) {
        int r = it;
        if (r < I_IN) { p0_transpose_item(A.in[I_WIN], DM, DIN, DINP / 32, (bf16*)(ws + WS_WIN), scr, r, F.lane); continue; } r -= I_IN;
        if (r < I_SQ) { p0_transpose_item(A.in[I_WOUT], DM, DM, DM / 32, (bf16*)(ws + WS_WOUT), scr, r, F.lane); continue; } r -= I_SQ;
        if (r < I_SQ) { p0_transpose_item(A.in[I_WPG], DM, DM, DM / 32, (bf16*)(ws + WS_WPG), scr, r, F.lane); continue; } r -= I_SQ;
        if (r < I_PE) { p0_transpose_item(A.in[I_WPE], PLE, DM, DM / 32, (bf16*)(ws + WS_WPE), scr, r, F.lane); continue; } r -= I_PE;
        if (r < I_C1) { p0_transpose_item(A.in[I_WCK1], CMPK, CMPH, CMPH / 32, (bf16*)(ws + WS_WCK1), scr, r, F.lane); continue; } r -= I_C1;
        if (r < I_C1) { p0_transpose_item(A.in[I_WCV1], CMPK, CMPH, CMPH / 32, (bf16*)(ws + WS_WCV1), scr, r, F.lane); continue; } r -= I_C1;
        if (r < I_C2) { p0_transpose_item(A.in[I_WCK2], CMPH, DH, DH / 32, (bf16*)(ws + WS_SMALL + SM_WCK2), scr, r, F.lane); continue; } r -= I_C2;
        p0_transpose_item(A.in[I_WCV2], CMPH, DH, DH / 32, (bf16*)(ws + WS_SMALL + SM_WCV2), scr, r, F.lane);
    }
    { const int gt = gw * 64 + F.lane; if (gt < 256 * 16) { const int n = gt >> 4, k = gt & 15; ((bf16*)(ws + WS_SMALL + SM_WA2))[gt] = (bf16)f2bf(A.in[I_WA2][k * 256 + n]); } }
    { const int w2 = NGW - 1 - gw; if (w2 >= 0 && w2 < 512) { const int which = w2 >> 8, hcol = w2 & 255; const float* W1 = A.in[which ? I_WCV1 : I_WCK1]; const float* pos = A.in[I_POS];
        float s = 0.f;
        for (int k = F.lane; k < CMPK; k += 64) s += pos[k] * W1[(size_t)k * CMPH + hcol];
        s = wave_sum(s);
        if (F.lane == 0) ((float*)(ws + WS_SMALL + (which ? SM_CB1V : SM_CB1K)))[hcol] = s + A.in[which ? I_BCV1 : I_BCK1][hcol]; } }
    for (int m = gw; m < M; m += NGW) ln0_row(A.in[I_X] + (size_t)m * DM, A.in[I_LN0G], A.in[I_LN0B], (bf16*)(ws + WS_XN) + (size_t)m * DM, (float*)(ws + WS_STATS) + 2 * m, F.lane);
    { const f32x4* ps = (const f32x4*)A.in[I_P]; v2u* pd = (v2u*)(ws + WS_PB); const size_t n4 = (size_t)M * PLE / 4;
      for (size_t i = (size_t)gw * 64 + F.lane; i < n4; i += (size_t)NGW * 64) { const f32x4 v = ps[i]; v2u o; o.x = pk2(v.x, v.y); o.y = pk2(v.z, v.w); pd[i] = o; } }
}
__device__ __forceinline__ void final_ln(Frame& F, const float* g, const float* b) {
    const int gw = F.vcu * NWAVES + F.wave, NGW = F.G * NWAVES; const int lane = F.lane;
    for (int m = gw; m < M; m += NGW) {
        f32x4* xr = (f32x4*)(F.out + (size_t)m * DM) + lane;
        f32x4 v[4]; float s = 0.f;
#pragma unroll
        for (int j = 0; j < 4; ++j) { v[j] = xr[64 * j]; s += (v[j].x + v[j].y) + (v[j].z + v[j].w); }
        const float mean = wave_sum(s) * (1.f / DM); float s2 = 0.f;
#pragma unroll
        for (int j = 0; j < 4; ++j) { v[j] = v[j] - mean; s2 += (v[j].x * v[j].x + v[j].y * v[j].y) + (v[j].z * v[j].z + v[j].w * v[j].w); }
        const float rstd = 1.f / sqrtf(wave_sum(s2) * (1.f / DM) + LN_EPS);
#pragma unroll
        for (int j = 0; j < 4; ++j) { const f32x4 gg = ((const f32x4*)g)[lane + 64 * j], bb = ((const f32x4*)b)[lane + 64 * j]; xr[64 * j] = v[j] * rstd * gg + bb; }
    }
}
typedef short v4i16_t __attribute__((ext_vector_type(4)));
#define MFMA32(a, b, c) __builtin_amdgcn_mfma_f32_32x32x16_bf16(a, b, c, 0, 0, 0)
__device__ __forceinline__ int crow(int r, int hi) { return (r & 3) + 8 * (r >> 2) + 4 * hi; }
__device__ __forceinline__ unsigned cvtpk(float lo, float hi) { typedef float f2_t __attribute__((ext_vector_type(2))); typedef __bf16 b2_t __attribute__((ext_vector_type(2)));
    f2_t v = {lo, hi}; b2_t b = __builtin_convertvector(v, b2_t); return __builtin_bit_cast(unsigned, b); }
__device__ __forceinline__ bf16x8 pack8(float a0, float a1, float a2, float a3, float a4, float a5, float a6, float a7) {
    v4u w; w.x = cvtpk(a0, a1); w.y = cvtpk(a2, a3); w.z = cvtpk(a4, a5); w.w = cvtpk(a6, a7); return __builtin_bit_cast(bf16x8, w); }
__device__ __forceinline__ bf16x8 pack8r(const f32x16& p, int base) { return pack8(p[base], p[base + 1], p[base + 2], p[base + 3], p[base + 4], p[base + 5], p[base + 6], p[base + 7]); }
__device__ __forceinline__ v4i16_t vtr(const LAS unsigned char* p) { return __builtin_amdgcn_ds_read_tr16_b64_v4i16((LAS v4i16_t*)p); }
__device__ __forceinline__ float swap_lo(float v, float& hiv) { auto rr = __builtin_amdgcn_permlane32_swap(__float_as_uint(v), __float_as_uint(v), false, false); hiv = __uint_as_float(rr[1]); return __uint_as_float(rr[0]); }
__device__ __forceinline__ float fexp(float v) { return __builtin_amdgcn_exp2f(v * LOG2E); }
__device__ __forceinline__ void stage_tr_image(const bf16* src, int pitch, LAS unsigned char* img, int lane_in) {
    int lane = lane_in; asm volatile("" : "+v"(lane));
    const bf16* sp = src + (size_t)(lane >> 3) * pitch + (lane & 7) * 8;
    LAS unsigned char* dp = img + ((lane & 7) >> 2) * 4096 + (lane >> 3) * 64 + (lane & 3) * 16;
    v4u val[8];
#pragma unroll
    for (int i = 0; i < 8; ++i) { val[i] = *(const v4u*)sp; sp += (size_t)8 * pitch; }
#pragma unroll
    for (int i = 0; i < 8; ++i) *(LAS v4u*)(dp + i * 512) = val[i];
}
__device__ __forceinline__ bf16x8 tr_frag(const LAS unsigned char* img, int ch32, int ks, int lane) {
    const int hi = lane >> 5;
    const LAS unsigned char* p = img + ch32 * 4096 + ks * 1024 + ((lane >> 4) & 1) * 32 + (lane & 3) * 8 + (4 * hi + ((lane & 15) >> 2)) * 64;
    const v4i16_t lo = vtr(p), hv = vtr(p + 512);
    return (bf16x8){lo[0], lo[1], lo[2], lo[3], hv[0], hv[1], hv[2], hv[3]};
}
__device__ __forceinline__ void gla_pass_a(Frame& F, const float* b_a, int cid, LAS unsigned char* wl) {
    int lane_ = F.lane; asm volatile("" : "+v"(lane_));
    const int lane = lane_, r32 = lane & 31, hi = lane >> 5;
    const int bh = cid >> 7, n = cid & 127, b = bh >> 2, h = bh & 3;
    const size_t T0 = (size_t)b * SEQ + (size_t)n * GCH;
    const bf16* U = (const bf16*)(F.ws + WS_U);
    const bf16* wa2t = (const bf16*)(F.ws + WS_SMALL + SM_WA2);
    LAS unsigned char* kimg = wl; LAS unsigned char* vimg = wl + 8192;
    stage_tr_image(U + T0 * DINP + C_KG + h * 64, DINP, kimg, lane);
    asm volatile("" ::: "memory");
    f32x16 bC[2][2];
    {
        bf16x8 af[2], wf[2];
#pragma unroll
        for (int ct = 0; ct < 2; ++ct) af[ct] = *(const bf16x8*)(U + (T0 + 32 * ct + r32) * DINP + C_AL + 8 * hi);
#pragma unroll
        for (int dt = 0; dt < 2; ++dt) wf[dt] = *(const bf16x8*)(wa2t + (h * 64 + 32 * dt + r32) * 16 + 8 * hi);
        const f32x16 z16 = {};
#pragma unroll
        for (int ct = 0; ct < 2; ++ct)
#pragma unroll
            for (int dt = 0; dt < 2; ++dt) bC[ct][dt] = MFMA32(af[ct], wf[dt], z16);
#pragma unroll
        for (int dt = 0; dt < 2; ++dt) { const float ba = b_a[h * 64 + 32 * dt + r32];
#pragma unroll
            for (int ct = 0; ct < 2; ++ct)
#pragma unroll
                for (int r = 0; r < 16; ++r) { const float xv = bC[ct][dt][r] + ba;
                    const float ls = fminf(xv, 0.f) - __logf(1.0f + fexp(-fabsf(xv)));
                    bC[ct][dt][r] = ls * (1.0f / 16.0f); } }
    }
    asm volatile("" ::: "memory");
    f32x16 bT[2][2];
    {
#pragma unroll
        for (int ct = 0; ct < 2; ++ct) {
            f32x16 acc0 = {}, acc1 = {};
#pragma unroll
            for (int ks = 0; ks < 4; ++ks) { if (ct == 0 && ks >= 2) continue;
                v4u tw;
                { unsigned e[8];
#pragma unroll
                  for (int j = 0; j < 8; ++j) { const int cp = 16 * ks + 8 * (j >> 2) + 4 * hi + (j & 3); e[j] = (cp <= 32 * ct + r32) ? 0x3F80u : 0u; }
                  tw.x = e[0] | (e[1] << 16); tw.y = e[2] | (e[3] << 16); tw.z = e[4] | (e[5] << 16); tw.w = e[6] | (e[7] << 16); }
                const bf16x8 LT = __builtin_bit_cast(bf16x8, tw);
#pragma unroll
                for (int dt = 0; dt < 2; ++dt) { const f32x16& x = bC[ks >> 1][dt]; const int base = 8 * (ks & 1);
                    float hv[8], lv[8];
#pragma unroll
                    for (int j = 0; j < 8; ++j) { hv[j] = __uint_as_float(f2bf(x[base + j]) << 16); lv[j] = x[base + j] - hv[j]; }
                    const bf16x8 ah = pack8(hv[0], hv[1], hv[2], hv[3], hv[4], hv[5], hv[6], hv[7]);
                    const bf16x8 al = pack8(lv[0], lv[1], lv[2], lv[3], lv[4], lv[5], lv[6], lv[7]);
                    if (dt == 0) { acc0 = MFMA32(ah, LT, acc0); acc0 = MFMA32(al, LT, acc0); } else { acc1 = MFMA32(ah, LT, acc1); acc1 = MFMA32(al, LT, acc1); } }
            }
            bT[0][ct] = acc0; bT[1][ct] = acc1;
        }
    }
    asm volatile("" ::: "memory");
    float blast[2];
#pragma unroll
    for (int dt = 0; dt < 2; ++dt) { float run = 0.f;
#pragma unroll
        for (int ct = 0; ct < 2; ++ct)
#pragma unroll
            for (int a = 0; a < 4; ++a) { f32x16& x = bC[ct][dt];
                const float g0 = x[4 * a], g1 = g0 + x[4 * a + 1], g2 = g1 + x[4 * a + 2], g3 = g2 + x[4 * a + 3];
                float t1; const float t0 = swap_lo(g3, t1);
                const float off = run + (hi ? t0 : 0.f);
                x[4 * a] = off + g0; x[4 * a + 1] = off + g1; x[4 * a + 2] = off + g2; x[4 * a + 3] = off + g3;
                run += t0 + t1; }
        blast[dt] = run; }
    asm volatile("" ::: "memory");
    bf16x8 kl[2][4];
#pragma unroll
    for (int dt = 0; dt < 2; ++dt)
#pragma unroll
        for (int ks = 0; ks < 4; ++ks) { const bf16x8 kf = tr_frag(kimg, dt, ks, lane); float o8[8];
#pragma unroll
            for (int j = 0; j < 8; ++j) o8[j] = __uint_as_float(((unsigned)(unsigned short)kf[j]) << 16) * fexp(blast[dt] - bC[ks >> 1][dt][8 * (ks & 1) + j]);
            kl[dt][ks] = pack8(o8[0], o8[1], o8[2], o8[3], o8[4], o8[5], o8[6], o8[7]); }
    if (hi == 0) { float* dec = (float*)(F.ws + WS_DEC) + (size_t)cid * 64; dec[r32] = fexp(blast[0]); dec[32 + r32] = fexp(blast[1]); }
    asm volatile("" ::: "memory");
    bf16x8 qe[2][4], ke[2][4];
    bf16* QE = (bf16*)(F.ws + WS_QE) + (size_t)cid * 4096;
#pragma unroll
    for (int ct = 0; ct < 2; ++ct) { const bf16* rowp = U + (T0 + 32 * ct + r32) * DINP;
#pragma unroll
        for (int ds = 0; ds < 4; ++ds) {
            const v2u q0 = *(const v2u*)(rowp + C_QG + h * 64 + 16 * ds + 4 * hi), q1 = *(const v2u*)(rowp + C_QG + h * 64 + 16 * ds + 8 + 4 * hi);
            const v2u k0 = *(const v2u*)(rowp + C_KG + h * 64 + 16 * ds + 4 * hi), k1 = *(const v2u*)(rowp + C_KG + h * 64 + 16 * ds + 8 + 4 * hi);
            const float qv[8] = {bflo(q0.x), bfhi(q0.x), bflo(q0.y), bfhi(q0.y), bflo(q1.x), bfhi(q1.x), bflo(q1.y), bfhi(q1.y)};
            const float kv_[8] = {bflo(k0.x), bfhi(k0.x), bflo(k0.y), bfhi(k0.y), bflo(k1.x), bfhi(k1.x), bflo(k1.y), bfhi(k1.y)};
            float qo[8], ko[8];
#pragma unroll
            for (int j = 0; j < 8; ++j) { const float e = bT[ds >> 1][ct][8 * (ds & 1) + j]; qo[j] = qv[j] * 0.125f * fexp(e); ko[j] = kv_[j] * fexp(-e); }
            qe[ct][ds] = pack8(qo[0], qo[1], qo[2], qo[3], qo[4], qo[5], qo[6], qo[7]);
            ke[ct][ds] = pack8(ko[0], ko[1], ko[2], ko[3], ko[4], ko[5], ko[6], ko[7]);
            *(bf16x8*)(QE + ((ct * 4 + ds) * 64 + lane) * 8) = qe[ct][ds];
            if (ds & 1) asm volatile("" ::: "memory");
        } }
    asm volatile("" ::: "memory");
    bf16x8 at0[2], at1[4];
    {
        f32x16 a00 = {}, a01 = {}, a11 = {};
#pragma unroll
        for (int ds = 0; ds < 4; ++ds) { a00 = MFMA32(ke[0][ds], qe[0][ds], a00); a01 = MFMA32(ke[0][ds], qe[1][ds], a01); a11 = MFMA32(ke[1][ds], qe[1][ds], a11); }
#pragma unroll
        for (int r = 0; r < 16; ++r) { const bool keep = crow(r, hi) <= r32; a00[r] = keep ? a00[r] : 0.f; a11[r] = keep ? a11[r] : 0.f; }
        at0[0] = pack8r(a00, 0); at0[1] = pack8r(a00, 8);
        at1[0] = pack8r(a01, 0); at1[1] = pack8r(a01, 8); at1[2] = pack8r(a11, 0); at1[3] = pack8r(a11, 8);
    }
    asm volatile("" ::: "memory");
    bf16* KVF = (bf16*)(F.ws + WS_KV) + (size_t)cid * 8192;
    bf16* OI = (bf16*)(F.ws + WS_OI) + (size_t)cid * 8192;
#pragma unroll
    for (int vh = 0; vh < 2; ++vh) {
        stage_tr_image(U + T0 * DINP + C_VG + h * 128 + vh * 64, DINP, vimg, lane);
#pragma unroll
        for (int v2 = 0; v2 < 2; ++v2) { const int vt = 2 * vh + v2;
            bf16x8 vf[4];
#pragma unroll
            for (int ks = 0; ks < 4; ++ks) vf[ks] = tr_frag(vimg, v2, ks, lane);
            f32x16 o0 = {}, o1 = {};
#pragma unroll
            for (int ks = 0; ks < 4; ++ks) { if (ks < 2) o0 = MFMA32(vf[ks], at0[ks], o0); o1 = MFMA32(vf[ks], at1[ks], o1); }
            { v4u w0, w1;
              w0.x = cvtpk(o0[0], o0[1]); w0.y = cvtpk(o0[2], o0[3]); w0.z = cvtpk(o0[4], o0[5]); w0.w = cvtpk(o0[6], o0[7]);
              w1.x = cvtpk(o0[8], o0[9]); w1.y = cvtpk(o0[10], o0[11]); w1.z = cvtpk(o0[12], o0[13]); w1.w = cvtpk(o0[14], o0[15]);
              v4u* d0 = (v4u*)(OI + ((vt * 2 + 0) * 64 + lane) * 16); d0[0] = w0; d0[1] = w1;
              w0.x = cvtpk(o1[0], o1[1]); w0.y = cvtpk(o1[2], o1[3]); w0.z = cvtpk(o1[4], o1[5]); w0.w = cvtpk(o1[6], o1[7]);
              w1.x = cvtpk(o1[8], o1[9]); w1.y = cvtpk(o1[10], o1[11]); w1.z = cvtpk(o1[12], o1[13]); w1.w = cvtpk(o1[14], o1[15]);
              v4u* d1 = (v4u*)(OI + ((vt * 2 + 1) * 64 + lane) * 16); d1[0] = w0; d1[1] = w1; }
            f32x16 kv0 = {}, kv1 = {};
#pragma unroll
            for (int ks = 0; ks < 4; ++ks) { kv0 = MFMA32(kl[0][ks], vf[ks], kv0); kv1 = MFMA32(kl[1][ks], vf[ks], kv1); }
            { v4u w0, w1;
              w0.x = cvtpk(kv0[0], kv0[1]); w0.y = cvtpk(kv0[2], kv0[3]); w0.z = cvtpk(kv0[4], kv0[5]); w0.w = cvtpk(kv0[6], kv0[7]);
              w1.x = cvtpk(kv0[8], kv0[9]); w1.y = cvtpk(kv0[10], kv0[11]); w1.z = cvtpk(kv0[12], kv0[13]); w1.w = cvtpk(kv0[14], kv0[15]);
              v4u* d0 = (v4u*)(KVF + ((vt * 2 + 0) * 64 + lane) * 16); d0[0] = w0; d0[1] = w1;
              w0.x = cvtpk(kv1[0], kv1[1]); w0.y = cvtpk(kv1[2], kv1[3]); w0.z = cvtpk(kv1[4], kv1[5]); w0.w = cvtpk(kv1[6], kv1[7]);
              w1.x = cvtpk(kv1[8], kv1[9]); w1.y = cvtpk(kv1[10], kv1[11]); w1.z = cvtpk(kv1[12], kv1[13]); w1.w = cvtpk(kv1[14], kv1[15]);
              v4u* d1 = (v4u*)(KVF + ((vt * 2 + 1) * 64 + lane) * 16); d1[0] = w0; d1[1] = w1; }
        }
    }
}
struct ScanLoads { bf16x8 qf[4]; v4u k0a, k0b, k1a, k1b; v4u oi0, oi1; v2u zz[4]; };
__device__ __forceinline__ void scan_load(ScanLoads& L, const unsigned char* ws, int cid, size_t tok, int h, int ct, int vt, int lane, int hi) {
    const bf16* QE = (const bf16*)(ws + WS_QE) + (size_t)cid * 4096;
    const bf16* KVF = (const bf16*)(ws + WS_KV) + (size_t)cid * 8192;
    const bf16* OI = (const bf16*)(ws + WS_OI) + (size_t)cid * 8192;
    const bf16* U = (const bf16*)(ws + WS_U);
#pragma unroll
    for (int ds = 0; ds < 4; ++ds) L.qf[ds] = *(const bf16x8*)(QE + ((ct * 4 + ds) * 64 + lane) * 8);
    { const v4u* p0 = (const v4u*)(KVF + ((vt * 2 + 0) * 64 + lane) * 16); const v4u* p1 = (const v4u*)(KVF + ((vt * 2 + 1) * 64 + lane) * 16);
      L.k0a = p0[0]; L.k0b = p0[1]; L.k1a = p1[0]; L.k1b = p1[1]; }
    L.oi0 = *(const v4u*)(OI + ((vt * 2 + ct) * 64 + lane) * 16); L.oi1 = *(const v4u*)(OI + ((vt * 2 + ct) * 64 + lane) * 16 + 8);
#pragma unroll
    for (int a = 0; a < 4; ++a) L.zz[a] = *(const v2u*)(U + tok * DINP + C_ZG + h * 128 + 32 * vt + 8 * a + 4 * hi);
}
__device__ __forceinline__ void scan_step(const ScanLoads& L, f32x16& S0, f32x16& S1, const LAS float* gnl, LAS float* part, const LAS float* decb, bf16* MIX, size_t tok, int n, int h, int ct, int vt, int r32, int hi) {
    f32x16 o = {};
    o = MFMA32(pack8r(S0, 0), L.qf[0], o); o = MFMA32(pack8r(S0, 8), L.qf[1], o); o = MFMA32(pack8r(S1, 0), L.qf[2], o); o = MFMA32(pack8r(S1, 8), L.qf[3], o);
    const unsigned oiw[8] = {L.oi0.x, L.oi0.y, L.oi0.z, L.oi0.w, L.oi1.x, L.oi1.y, L.oi1.z, L.oi1.w};
    float ss = 0.f;
#pragma unroll
    for (int r = 0; r < 16; ++r) { const float add = (r & 1) ? bfhi(oiw[r >> 1]) : bflo(oiw[r >> 1]); o[r] += add; ss += o[r] * o[r]; }
    { const unsigned k0w[8] = {L.k0a.x, L.k0a.y, L.k0a.z, L.k0a.w, L.k0b.x, L.k0b.y, L.k0b.z, L.k0b.w}, k1w[8] = {L.k1a.x, L.k1a.y, L.k1a.z, L.k1a.w, L.k1b.x, L.k1b.y, L.k1b.z, L.k1b.w};
#pragma unroll
      for (int a = 0; a < 4; ++a) { const f32x4 x0 = *(const LAS f32x4*)(decb + 8 * a + 4 * hi), x1 = *(const LAS f32x4*)(decb + 32 + 8 * a + 4 * hi);
        S0[4 * a] = x0.x * S0[4 * a] + bflo(k0w[2 * a]); S0[4 * a + 1] = x0.y * S0[4 * a + 1] + bfhi(k0w[2 * a]); S0[4 * a + 2] = x0.z * S0[4 * a + 2] + bflo(k0w[2 * a + 1]); S0[4 * a + 3] = x0.w * S0[4 * a + 3] + bfhi(k0w[2 * a + 1]);
        S1[4 * a] = x1.x * S1[4 * a] + bflo(k1w[2 * a]); S1[4 * a + 1] = x1.y * S1[4 * a + 1] + bfhi(k1w[2 * a]); S1[4 * a + 2] = x1.z * S1[4 * a + 2] + bflo(k1w[2 * a + 1]); S1[4 * a + 3] = x1.w * S1[4 * a + 3] + bfhi(k1w[2 * a + 1]); } }
    { float t1; const float t0 = swap_lo(ss, t1); ss = t0 + t1; }
    LAS float* pb = part + (n & 1) * 256;
    if (hi == 0) pb[vt * 64 + 32 * ct + r32] = ss;
    __syncthreads();
    const float tot = (pb[32 * ct + r32] + pb[64 + 32 * ct + r32]) + (pb[128 + 32 * ct + r32] + pb[192 + 32 * ct + r32]);
    const float rstd = 1.0f / sqrtf(tot * (1.0f / GDV) + LN_EPS);
#pragma unroll
    for (int a = 0; a < 4; ++a) { const float z0 = bflo(L.zz[a].x), z1 = bfhi(L.zz[a].x), z2 = bflo(L.zz[a].y), z3 = bfhi(L.zz[a].y); const f32x4 gna = *(const LAS f32x4*)(gnl + 32 * vt + 8 * a + 4 * hi);
        const float y0 = o[4 * a] * rstd * gna.x * z0 * sigmoidf2(z0), y1 = o[4 * a + 1] * rstd * gna.y * z1 * sigmoidf2(z1);
        const float y2 = o[4 * a + 2] * rstd * gna.z * z2 * sigmoidf2(z2), y3 = o[4 * a + 3] * rstd * gna.w * z3 * sigmoidf2(z3);
        v2u ov; ov.x = cvtpk(y0, y1); ov.y = cvtpk(y2, y3);
        *(v2u*)(MIX + tok * DM + 512 + h * 128 + 32 * vt + 8 * a + 4 * hi) = ov; }
}
__device__ __forceinline__ void gla_scan_unit(Frame& F, const float* gnw, int bh, LAS float* part) {
    const int lane = F.lane, r32 = lane & 31, hi = lane >> 5, w = F.wave, ct = w & 1, vt = w >> 1;
    const int b = bh >> 2, h = bh & 3;
    bf16* MIX = (bf16*)(F.ws + WS_MIX);
    LAS float* decb = part + 512;
    const float* DEC = (const float*)(F.ws + WS_DEC) + (size_t)bh * NCHUNK * 64;
    f32x16 S0 = {}, S1 = {};
    LAS float* gnl = part + 640;
    if (w == 1) { gnl[lane] = gnw[lane]; gnl[64 + lane] = gnw[64 + lane]; }
    const size_t tokb = (size_t)b * SEQ + 32 * ct + r32;
    ScanLoads LA, LB;
    scan_load(LA, F.ws, bh * NCHUNK, tokb, h, ct, vt, lane, hi);
    if (w == 0) decb[lane] = DEC[lane];
    __syncthreads();
    for (int n = 0; n < NCHUNK; n += 2) {
        scan_load(LB, F.ws, bh * NCHUNK + n + 1, tokb + (size_t)(n + 1) * GCH, h, ct, vt, lane, hi);
        if (w == 0) decb[64 + lane] = DEC[(n + 1) * 64 + lane];
        scan_step(LA, S0, S1, gnl, part, decb, MIX, tokb + (size_t)n * GCH, n, h, ct, vt, r32, hi);
        if (n + 2 < NCHUNK) { scan_load(LA, F.ws, bh * NCHUNK + n + 2, tokb + (size_t)(n + 2) * GCH, h, ct, vt, lane, hi); if (w == 0) decb[lane] = DEC[(n + 2) * 64 + lane]; }
        scan_step(LB, S0, S1, gnl, part, decb + 64, MIX, tokb + (size_t)(n + 1) * GCH, n + 1, h, ct, vt, r32, hi);
    }
    __syncthreads();
}
constexpr int L_KV = 0;
constexpr int L_TB = 32768;
constexpr int L_WSF = 36864;
constexpr int L_SELM = 38912;
constexpr int L_MREF = 39936;
constexpr int L_LACC = 40960;
constexpr int L_CNT = 41984;
constexpr int L_ITEMS = 43520;
constexpr int L_TOKL = 44032;
constexpr int L_SL2 = 52224;
constexpr int L_OACC = 84992;
constexpr int L_IMP = L_OACC;
constexpr int L_MAIL = L_OACC;
constexpr int L_MAILL = L_MAIL + 32768;
constexpr int L_WHERE = L_MAILL + 1024;
constexpr int IMP_LD = 129;
constexpr float NEGBIG = -1e30f;
constexpr float C2S = 0.125f * LOG2E;
constexpr float THR_RESC = 8.0f;

__device__ __forceinline__ int t5_bucket(int n) {
    if (n < 16) return n;
    const int th[15] = {19, 21, 24, 27, 31, 35, 40, 46, 52, 59, 67, 77, 87, 99, 113};
    int b = 16;
#pragma unroll
    for (int i = 0; i < 15; ++i) b += (n >= th[i]) ? 1 : 0;
    return b;
}
__device__ __forceinline__ void build_bias_table(Frame& F, const float* rel_bias) {
    LAS float* tb = (LAS float*)(F.lds + L_TB);
    for (int i = F.tid; i < 8 * 128; i += NWAVES * 64) { const int hd = i >> 7, n = i & 127; tb[i] = rel_bias[t5_bucket(n) * 8 + hd] * LOG2E; }
}
struct KVRegs { v4u k, v; };
__device__ __forceinline__ KVRegs kv_load(const bf16* Kb, const bf16* Vb, size_t pitch, int row0, int w, int lane) {
    KVRegs r; const size_t off = (size_t)(row0 + 8 * w + (lane >> 3)) * pitch + (lane & 7) * 8;
    r.k = *(const v4u*)(Kb + off); r.v = *(const v4u*)(Vb + off);
    return r;
}
__device__ __forceinline__ void kv_store(LAS unsigned char* slot, const KVRegs& r, int tid) {
    const int row = tid >> 3, c = tid & 7;
    *(LAS v4u*)(slot + row * 128 + ((c ^ (row & 7)) << 4)) = r.k;
    *(LAS v4u*)(slot + 8192 + (c >> 2) * 4096 + row * 64 + (c & 3) * 16) = r.v;
}
struct SmState { float mhat, lsum; f32x16 o0, o1; };
__device__ __forceinline__ void qk_tile(const LAS unsigned char* kslot, const bf16x8 (&qr)[4], f32x16& p0, f32x16& p1, int r32, int hi) {
    const LAS unsigned char* kp = kslot + r32 * 128; const int sw = r32 & 7;
    p0 = (f32x16){}; p1 = (f32x16){};
#pragma unroll
    for (int d0 = 0; d0 < 4; ++d0) { const int co = ((2 * d0 + hi) ^ sw) << 4;
        const bf16x8 k0 = *(const LAS bf16x8*)(kp + co), k1 = *(const LAS bf16x8*)(kp + 4096 + co);
        p0 = MFMA32(k0, qr[d0], p0); p1 = MFMA32(k1, qr[d0], p1); }
}
__device__ __forceinline__ float rowmax32(const f32x16& p0, const f32x16& p1) {
    float a = fmaxf(p0[0], p1[0]);
#pragma unroll
    for (int r = 1; r < 16; ++r) a = fmaxf(a, fmaxf(p0[r], p1[r]));
    float t1; const float t0 = swap_lo(a, t1); return fmaxf(t0, t1);
}
__device__ __forceinline__ void pv_tail(SmState& st, const f32x16& p0, const f32x16& p1, const LAS unsigned char* vslot, int lane) {
    const bf16x8 pa0 = pack8r(p0, 0), pa1 = pack8r(p0, 8), pa2 = pack8r(p1, 0), pa3 = pack8r(p1, 8);
#pragma unroll
    for (int d0 = 0; d0 < 2; ++d0) {
        const bf16x8 v0 = tr_frag(vslot, d0, 0, lane), v1 = tr_frag(vslot, d0, 1, lane), v2 = tr_frag(vslot, d0, 2, lane), v3 = tr_frag(vslot, d0, 3, lane);
        f32x16 o = d0 ? st.o1 : st.o0;
        o = MFMA32(pa0, v0, o); o = MFMA32(pa1, v1, o); o = MFMA32(pa2, v2, o); o = MFMA32(pa3, v3, o);
        if (d0) st.o1 = o; else st.o0 = o;
    }
}
__device__ __forceinline__ void softmax_pv(SmState& st, f32x16& p0, f32x16& p1, const LAS unsigned char* vslot, LAS float* wsf, int lane, int r32, int hi) {
    const float rm = rowmax32(p0, p1);
    if (__any(rm > st.mhat + THR_RESC)) {
        const float mnew = fmaxf(st.mhat, rm); const float f = __builtin_amdgcn_exp2f(st.mhat - mnew);
        st.lsum *= f; st.mhat = mnew;
        if (hi == 0) wsf[r32] = f;
        LDS_WAIT();
#pragma unroll
        for (int r = 0; r < 16; ++r) { const float fr = wsf[crow(r, hi)]; st.o0[r] *= fr; st.o1[r] *= fr; }
    }
    float s = 0.f;
#pragma unroll
    for (int r = 0; r < 16; ++r) { p0[r] = __builtin_amdgcn_exp2f(p0[r] - st.mhat); p1[r] = __builtin_amdgcn_exp2f(p1[r] - st.mhat); s += p0[r] + p1[r]; }
    st.lsum += s;
    pv_tail(st, p0, p1, vslot, lane);
}
__device__ __forceinline__ void softmax_pv_fast(SmState& st, f32x16& p0, f32x16& p1, float sc, float bias, const LAS unsigned char* vslot, LAS float* wsf, int lane, int r32, int hi) {
    const float rm = __builtin_fmaf(rowmax32(p0, p1), sc, bias);
    if (__any(rm > st.mhat + THR_RESC)) {
        const float mnew = fmaxf(st.mhat, rm); const float f = __builtin_amdgcn_exp2f(st.mhat - mnew);
        st.lsum *= f; st.mhat = mnew;
        if (hi == 0) wsf[r32] = f;
        LDS_WAIT();
#pragma unroll
        for (int r = 0; r < 16; ++r) { const float fr = wsf[crow(r, hi)]; st.o0[r] *= fr; st.o1[r] *= fr; }
    }
    const float nb = bias - st.mhat; float s = 0.f;
#pragma unroll
    for (int r = 0; r < 16; ++r) { p0[r] = __builtin_amdgcn_exp2f(__builtin_fmaf(p0[r], sc, nb)); p1[r] = __builtin_amdgcn_exp2f(__builtin_fmaf(p1[r], sc, nb)); s += p0[r] + p1[r]; }
    st.lsum += s;
    pv_tail(st, p0, p1, vslot, lane);
}
__device__ __forceinline__ void stage_tile(LAS bf16* stg, const f32x16& a0, const f32x16& a1, int r32, int hi) {
#pragma unroll
    for (int r = 0; r < 16; ++r) { stg[crow(r, hi) * 64 + r32] = (bf16)f2bf(a0[r]); stg[crow(r, hi) * 64 + 32 + r32] = (bf16)f2bf(a1[r]); }
}
__device__ __forceinline__ void finish_rows(SmState& st, LAS float* wsf, int r32, int hi, bool zero_row) {
    float t1; const float t0 = swap_lo(st.lsum, t1); const float l = t0 + t1;
    if (hi == 0) wsf[32 + r32] = zero_row ? 0.f : __builtin_amdgcn_rcpf(l);
    LDS_WAIT();
#pragma unroll
    for (int r = 0; r < 16; ++r) { const float il = wsf[32 + crow(r, hi)]; st.o0[r] *= il; st.o1[r] *= il; }
}
__device__ __forceinline__ void load_q(bf16x8 (&qr)[4], const bf16* U, size_t tok0, int g, int w, int r32, int hi) {
    const bf16* qp = U + (tok0 + 8 * w + (r32 >> 2)) * DINP + C_QN + (4 * g + (r32 & 3)) * 64 + 8 * hi;
#pragma unroll
    for (int d0 = 0; d0 < 4; ++d0) qr[d0] = *(const bf16x8*)(qp + 16 * d0);
}
template <bool NEAR>
__device__ __forceinline__ void bias_mask(f32x16& p0, f32x16& p1, const LAS float* tbh, int dist0, int kstep, int loD, int hiD, bool rowok, int hi) {
    const float cfar = tbh[127];
#pragma unroll
    for (int r = 0; r < 16; ++r) {
        const int k0 = crow(r, hi), k1 = k0 + 32;
        const int dA = dist0 - kstep * k0, dB = dist0 - kstep * k1;
        float bA, bB;
        if (NEAR) { bA = tbh[min(max(dA, 0), 127)]; bB = tbh[min(max(dB, 0), 127)]; } else { bA = cfar; bB = cfar; }
        const bool vA = rowok && dA >= loD && dA < hiD, vB = rowok && dB >= loD && dB < hiD;
        p0[r] = vA ? __builtin_fmaf(p0[r], C2S, bA) : NEGBIG;
        p1[r] = vB ? __builtin_fmaf(p1[r], C2S, bB) : NEGBIG;
    }
}
__device__ __forceinline__ void window_unit(Frame& F, int unit) {
    int tid_ = F.tid; asm volatile("" : "+v"(tid_));
    const int tid = tid_, lane = tid & 63, r32 = lane & 31, hi = lane >> 5, w = F.wave;
    const int bg = unit >> 7, i = unit & 127, b = bg >> 1, g = bg & 1;
    const bf16* U = (const bf16*)(F.ws + WS_U);
    const size_t tok0 = (size_t)b * SEQ + (size_t)i * 64;
    const bf16* Kb = U + (size_t)b * SEQ * DINP + C_KW + g * 64; const bf16* Vb = U + (size_t)b * SEQ * DINP + C_VW + g * 64;
    LAS unsigned char* kv = F.lds + L_KV; LAS float* wsf = (LAS float*)(F.lds + L_WSF) + w * 64;
    const LAS float* tbh = (const LAS float*)(F.lds + L_TB) + (4 * g + (r32 & 3)) * 128;
    bf16x8 qr[4]; load_q(qr, U, tok0, g, w, r32, hi);
    SmState st; st.mhat = NEGBIG; st.lsum = 0.f; st.o0 = (f32x16){}; st.o1 = (f32x16){};
    const int tql = 8 * w + (r32 >> 2);
    const int nb = (i < 8 ? i : 8) + 1;
    { const KVRegs r0 = kv_load(Kb, Vb, DINP, i * 64, w, lane); kv_store(kv, r0, tid); }
    __syncthreads();
    for (int s = 0; s < nb; ++s) {
        const int blk = i - s; LAS unsigned char* slot = kv + (s & 1) * 16384;
        KVRegs nx; if (s + 1 < nb) nx = kv_load(Kb, Vb, DINP, (blk - 1) * 64, w, lane);
        f32x16 p0, p1; qk_tile(slot, qr, p0, p1, r32, hi);
        const int dist0 = 64 * s + tql;
        if (s <= 2) { bias_mask<true>(p0, p1, tbh, dist0, 1, 0, 512, true, hi); softmax_pv(st, p0, p1, slot + 8192, wsf, lane, r32, hi); }
        else if (s == 8) { bias_mask<false>(p0, p1, tbh, dist0, 1, 0, 512, true, hi); softmax_pv(st, p0, p1, slot + 8192, wsf, lane, r32, hi); }
        else softmax_pv_fast(st, p0, p1, C2S, tbh[127], slot + 8192, wsf, lane, r32, hi);
        if (s + 1 < nb) kv_store(kv + ((s + 1) & 1) * 16384, nx, tid);
        __syncthreads();
    }
    finish_rows(st, wsf, r32, hi, false);
    bf16* OW = (bf16*)(F.ws + WS_OW);
    LAS bf16* stg = (LAS bf16*)(F.lds + L_IMP) + w * 2048;
    stage_tile(stg, st.o0, st.o1, r32, hi);
    LDS_WAIT();
#pragma unroll
    for (int it = 0; it < 4; ++it) { const int row = it * 8 + (lane >> 3), ch = lane & 7;
        const v4u t = *(const LAS v4u*)(stg + row * 64 + ch * 8);
        *(v4u*)(OW + (tok0 + 8 * w + (row >> 2)) * 512 + (4 * g + (row & 3)) * 64 + ch * 8) = t; }
    LDS_WAIT();
}
constexpr int CA_ROWS = 528, L_CH = 69632, CH_LD = 264;
__device__ __forceinline__ float gelu_tanh(float x) { const float u = 0.7978845608028654f * (x + 0.044715f * x * x * x); const float e = __builtin_amdgcn_exp2f(2.0f * LOG2E * u); return x * (1.0f - __builtin_amdgcn_rcpf(e + 1.0f)); }
__device__ __forceinline__ void compress_unit(Frame& F, int unit) {
    int tid_ = F.tid; asm volatile("" : "+v"(tid_));
    const int tid = tid_, lane = tid & 63, r32 = lane & 31, hi = lane >> 5, w = F.wave;
    const int which = unit >> 8, bg = (unit >> 4) & 15, jb = unit & 15, b = bg >> 1, g = bg & 1;
    const bf16* U = (const bf16*)(F.ws + WS_U);
    const bf16* src = U + ((size_t)b * SEQ + 512 * jb) * DINP + (which ? C_VC : C_KC) + g * 64;
    const bf16* W1t = (const bf16*)(F.ws + (which ? WS_WCV1 : WS_WCK1));
    const bf16* W2t = (const bf16*)(F.ws + WS_SMALL + (which ? SM_WCV2 : SM_WCK2));
    const float* cb1 = (const float*)(F.ws + WS_SMALL + (which ? SM_CB1V : SM_CB1K));
    bf16* dst = (bf16*)(F.ws + (which ? WS_VC : WS_KC)) + ((size_t)bg * NCP + 32 * jb) * 64;
    LAS unsigned char* A = F.lds; LAS bf16* H = (LAS bf16*)(F.lds + L_CH);
    for (int p = tid; p < CA_ROWS * 8; p += NWAVES * 64) { const int t = p >> 3, ch = p & 7;
        const v4u val = *(const v4u*)(src + (size_t)t * DINP + ch * 8);
        *(LAS v4u*)(A + t * 128 + ((ch ^ ((t >> 4) & 7)) << 4)) = val; }
    __syncthreads();
    f32x16 acc = {};
    const bf16* wp = W1t + (size_t)(32 * w + r32) * CMPK + 8 * hi;
#pragma unroll 4
    for (int kk = 0; kk < 128; ++kk) { const int tok = kk >> 2, t = 16 * r32 + tok, ch = 2 * (kk & 3) + hi;
        const bf16x8 a = *(const LAS bf16x8*)(A + t * 128 + ((ch ^ ((t >> 4) & 7)) << 4));
        const bf16x8 bw = *(const bf16x8*)(wp + 16 * kk);
        acc = MFMA32(a, bw, acc); }
    { const float cb = cb1[32 * w + r32];
#pragma unroll
      for (int r = 0; r < 16; ++r) H[crow(r, hi) * CH_LD + 32 * w + r32] = (bf16)f2bf(gelu_tanh(acc[r] + cb)); }
    __syncthreads();
    if (w < 2) {
        f32x16 o = {};
        const bf16* w2p = W2t + (size_t)(32 * w + r32) * CMPH + 8 * hi;
#pragma unroll
        for (int kk = 0; kk < 16; ++kk) { const bf16x8 a = *(const LAS bf16x8*)(H + r32 * CH_LD + 16 * kk + 8 * hi); const bf16x8 bw = *(const bf16x8*)(w2p + 16 * kk); o = MFMA32(a, bw, o); }
#pragma unroll
        for (int r = 0; r < 16; ++r) dst[crow(r, hi) * 64 + 32 * w + r32] = (bf16)f2bf(o[r]);
    }
    __syncthreads();
}
#ifdef PROBE_SEC
#define TSTAMP(sec) do { if (unit == 127 && threadIdx.x == 0) { const unsigned long long t_ = __builtin_amdgcn_s_memtime(); atomicAdd((unsigned long long*)((unsigned*)F.ctl + 210000) + (sec), t_ - tprev_); tprev_ = t_; } } while (0)
#define TSTART() unsigned long long tprev_ = __builtin_amdgcn_s_memtime()
#else
#define TSTAMP(sec) do {} while (0)
#define TSTART() do {} while (0)
#endif
__device__ __forceinline__ void nsa_unit(Frame& F, int unit) {
    int tid_ = F.tid; asm volatile("" : "+v"(tid_));
    const int tid = tid_, lane = tid & 63, r32 = lane & 31, hi = lane >> 5, w = F.wave;
    const int bg = unit >> 7, i = unit & 127, b = bg >> 1, g = bg & 1;
    const bf16* U = (const bf16*)(F.ws + WS_U);
    const size_t tok0 = (size_t)b * SEQ + (size_t)i * 64;
    LAS unsigned char* kv = F.lds + L_KV; LAS float* wsf = (LAS float*)(F.lds + L_WSF) + w * 64;
    const LAS float* tbh = (const LAS float*)(F.lds + L_TB) + (4 * g + (r32 & 3)) * 128;
    LAS float* imp = (LAS float*)(F.lds + L_IMP); LAS unsigned* selm = (LAS unsigned*)(F.lds + L_SELM);
    TSTART();
    bf16x8 qr[4]; load_q(qr, U, tok0, g, w, r32, hi);
    const int tql = 8 * w + (r32 >> 2), tq = i * 64 + tql;
    const bf16* KCb = (const bf16*)(F.ws + WS_KC) + (size_t)bg * NCP * 64; const bf16* VCb = (const bf16*)(F.ws + WS_VC) + (size_t)bg * NCP * 64;
    const int ncv = 4 * i + 3, nct = (ncv + 63) >> 6;
    SmState st; st.mhat = NEGBIG; st.lsum = 0.f; st.o0 = (f32x16){}; st.o1 = (f32x16){};
    { const KVRegs r0 = kv_load(KCb, VCb, 64, 0, w, lane); kv_store(kv, r0, tid); }
    __syncthreads();
    for (int s = 0; s < nct; ++s) {
        LAS unsigned char* slot = kv + (s & 1) * 16384;
        KVRegs nx; if (s + 1 < nct) nx = kv_load(KCb, VCb, 64, (s + 1) * 64, w, lane);
        f32x16 p0, p1; qk_tile(slot, qr, p0, p1, r32, hi);
        const int dist0 = tq - 31 - 1024 * s;
        if (64 * i - 31 - 1024 * s - 16 * 63 < 113) { bias_mask<true>(p0, p1, tbh, dist0, 16, 0, 0x7fffffff, true, hi); softmax_pv(st, p0, p1, slot + 8192, wsf, lane, r32, hi); }
        else softmax_pv_fast(st, p0, p1, C2S, tbh[127], slot + 8192, wsf, lane, r32, hi);
        if (s + 1 < nct) kv_store(kv + ((s + 1) & 1) * 16384, nx, tid);
        __syncthreads();
    }
    const bool norow = tq < 31;
    float lc; { float t1; const float t0 = swap_lo(st.lsum, t1); lc = t0 + t1; }
    const float mfin = st.mhat, ilc = norow ? 0.f : __builtin_amdgcn_rcpf(lc);
    finish_rows(st, wsf, r32, hi, norow);
    unsigned ocw[16];
    { const bf16* gp = U + (tok0 + tql) * DINP + C_GN + (4 * g + (r32 & 3)) * 3;
      const float g0 = sigmoidf2(bflo((unsigned)gp[0]));
      if (hi == 0) wsf[r32] = g0;
      LDS_WAIT();
#pragma unroll
      for (int r = 0; r < 16; ++r) { const float gg = wsf[crow(r, hi)]; ocw[r] = cvtpk(st.o0[r] * gg, st.o1[r] * gg); } }
    unsigned* park = (unsigned*)(F.ws + WS_PARK) + ((size_t)blockIdx.x * NWAVES + w) * 4096 + lane;
#pragma unroll
    for (int r = 0; r < 16; ++r) park[r * 64] = ocw[r];
    __syncthreads();
    TSTAMP(0);
    { const KVRegs r0 = kv_load(KCb, VCb, 64, 0, w, lane); kv_store(kv, r0, tid); }
    __syncthreads();
    for (int s = 0; s < nct; ++s) {
        LAS unsigned char* slot = kv + (s & 1) * 16384;
        KVRegs nx; if (s + 1 < nct) nx = kv_load(KCb, VCb, 64, (s + 1) * 64, w, lane);
        f32x16 p0, p1; qk_tile(slot, qr, p0, p1, r32, hi);
        const int dist0 = tq - 31 - 1024 * s;
        if (64 * i - 31 - 1024 * s - 16 * 63 < 113) { bias_mask<true>(p0, p1, tbh, dist0, 16, 0, 0x7fffffff, true, hi);
#pragma unroll
            for (int r = 0; r < 16; ++r) { p0[r] = __builtin_amdgcn_exp2f(p0[r] - mfin) * ilc; p1[r] = __builtin_amdgcn_exp2f(p1[r] - mfin) * ilc; } }
        else { const float nb = tbh[127] - mfin;
#pragma unroll
            for (int r = 0; r < 16; ++r) { p0[r] = __builtin_amdgcn_exp2f(__builtin_fmaf(p0[r], C2S, nb)) * ilc; p1[r] = __builtin_amdgcn_exp2f(__builtin_fmaf(p1[r], C2S, nb)) * ilc; } }
        LAS float* irow = imp + tql * IMP_LD + 16 * s + hi;
#pragma unroll
        for (int A = 0; A < 8; ++A) { const f32x16& p = (A < 4) ? p0 : p1; const int a = A & 3;
            float own = p[4 * a] + p[4 * a + 1] + p[4 * a + 2] + 0.5f * p[4 * a + 3], car = 0.5f * p[4 * a + 3];
            own += __shfl_xor(own, 1); own += __shfl_xor(own, 2); car += __shfl_xor(car, 1); car += __shfl_xor(car, 2);
            if ((r32 & 3) == 0) { irow[2 * A] = own; irow[64 * IMP_LD + 2 * A + 1] = car; } }
        if (s + 1 < nct) kv_store(kv + ((s + 1) & 1) * 16384, nx, tid);
        __syncthreads();
    }
    TSTAMP(1);
    {
        const int tl = 8 * w + (lane >> 3), slot8 = lane & 7; const int cur = i;
        unsigned m0 = 0u, m1 = 0u, m2 = 0u, m3 = 0u;
        if (cur < 16) { m0 = (cur == 31) ? 0xffffffffu : ((1u << (cur + 1)) - 1u); }
        else {
            unsigned key[16];
#pragma unroll
            for (int k = 0; k < 16; ++k) { const int n = slot8 + 8 * k; const float v = (n >= 1 && n <= cur - 2) ? imp[tl * IMP_LD + n] + imp[64 * IMP_LD + tl * IMP_LD + n] : 0.f;
                key[k] = (n >= 1 && n <= cur - 2) ? ((__float_as_uint(v) & ~127u) | (unsigned)(127 - n)) : 0u; }
            for (int it = 0; it < 13; ++it) {
                unsigned mx = key[0];
#pragma unroll
                for (int k = 1; k < 16; ++k) mx = max(mx, key[k]);
                mx = max(mx, (unsigned)__shfl_xor((int)mx, 1)); mx = max(mx, (unsigned)__shfl_xor((int)mx, 2)); mx = max(mx, (unsigned)__shfl_xor((int)mx, 4));
                const int nsel = 127 - (int)(mx & 127u);
#pragma unroll
                for (int k = 0; k < 16; ++k) key[k] = (key[k] == mx) ? 0u : key[k];
                const unsigned bit = 1u << (nsel & 31); const int wd = nsel >> 5;
                m0 |= (wd == 0) ? bit : 0u; m1 |= (wd == 1) ? bit : 0u; m2 |= (wd == 2) ? bit : 0u; m3 |= (wd == 3) ? bit : 0u;
            }
            m0 |= 1u;
            { const int n1 = cur - 1, n2 = cur; const unsigned b1 = 1u << (n1 & 31), b2 = 1u << (n2 & 31);
              m0 |= ((n1 >> 5) == 0 ? b1 : 0u) | ((n2 >> 5) == 0 ? b2 : 0u); m1 |= ((n1 >> 5) == 1 ? b1 : 0u) | ((n2 >> 5) == 1 ? b2 : 0u);
              m2 |= ((n1 >> 5) == 2 ? b1 : 0u) | ((n2 >> 5) == 2 ? b2 : 0u); m3 |= ((n1 >> 5) == 3 ? b1 : 0u) | ((n2 >> 5) == 3 ? b2 : 0u); }
        }
        if (slot8 == 0) { selm[tl * 4 + 0] = m0; selm[tl * 4 + 1] = m1; selm[tl * 4 + 2] = m2; selm[tl * 4 + 3] = m3; }
    }
    LDS_WAIT();
    __syncthreads();
    TSTAMP(2);
    const bool sparse = i >= 16;
    LAS float* mrefs = (LAS float*)(F.lds + L_MREF); LAS bf16* mail = (LAS bf16*)(F.lds + L_MAIL); LAS float* maill = (LAS float*)(F.lds + L_MAILL); LAS unsigned short* wher = (LAS unsigned short*)(F.lds + L_WHERE);
    LAS int* cnt = (LAS int*)(F.lds + L_CNT); LAS int* off = cnt + 128; LAS unsigned short* items = (LAS unsigned short*)(F.lds + L_ITEMS);
    LAS unsigned char* tokl = F.lds + L_TOKL;
    if (sparse) {
        if (tid < 128) { const int n = tid; int c = 0;
            if (n >= 1 && n <= i - 2) { const int wd = n >> 5, bt = n & 31;
                for (int t = 0; t < 64; ++t) if ((selm[t * 4 + wd] >> bt) & 1u) { tokl[n * 64 + c] = (unsigned char)t; ++c; } }
            cnt[n] = c; }
        if (tid < 256) wher[tid] = 0xffffu;
        __syncthreads();
        if (tid == 0) {
            int nr = 0, n = 1;
            while (n <= i - 2) { int nb = 0, tl = 0; const int n0 = n;
                while (n <= i - 2 && nb < 4) { const int tn = (cnt[n] + 7) >> 3; if (nb > 0 && tl + tn > 8) break; tl += tn; ++nb; ++n; }
                items[nr++] = (unsigned short)(n0 | (nb << 8)); }
            off[128] = nr; }
    }
    TSTAMP(3);
    const bf16* Kb = U + (size_t)b * SEQ * DINP + C_KS + g * 64; const bf16* Vb = U + (size_t)b * SEQ * DINP + C_VS + g * 64;
    st.mhat = NEGBIG; st.lsum = 0.f; st.o0 = (f32x16){}; st.o1 = (f32x16){};
    const int nd = sparse ? 3 : i + 1;
    load_q(qr, U, tok0, g, w, r32, hi);
    { const KVRegs r0 = kv_load(Kb, Vb, DINP, 0, w, lane); kv_store(kv, r0, tid); }
    __syncthreads();
    for (int sdx = 0; sdx < nd; ++sdx) {
        const int n = sparse ? (sdx == 0 ? 0 : i - 2 + sdx) : sdx;
        LAS unsigned char* slot = kv + (sdx & 1) * 16384;
        KVRegs nx; if (sdx + 1 < nd) { const int nn = sparse ? (i - 1 + sdx) : sdx + 1; nx = kv_load(Kb, Vb, DINP, nn * 64, w, lane); }
        f32x16 p0, p1; qk_tile(slot, qr, p0, p1, r32, hi);
        const int dist0 = tq - 64 * n;
        if (i - n <= 2) { bias_mask<true>(p0, p1, tbh, dist0, 1, 0, 0x7fffffff, true, hi); softmax_pv(st, p0, p1, slot + 8192, wsf, lane, r32, hi); }
        else softmax_pv_fast(st, p0, p1, C2S, tbh[127], slot + 8192, wsf, lane, r32, hi);
        if (sdx + 1 < nd) kv_store(kv + ((sdx + 1) & 1) * 16384, nx, tid);
        __syncthreads();
    }
    TSTAMP(4);
    if (sparse) {
        if (hi == 0) mrefs[32 * w + r32] = st.mhat;
        __syncthreads();
        const int NR = off[128];
#ifdef PROBE_SEC
        if (unit == 127 && tid == 0) { unsigned long long* tp = (unsigned long long*)((unsigned*)F.ctl + 210000); tp[10] = NR; unsigned long long sc = 0; for (int n = 0; n < 128; ++n) sc += cnt[n]; tp[12] = sc; }
#endif
        KVRegs pf0, pf1, pf2, pf3;
        { const int rr = items[0], n0 = rr & 255, nb = rr >> 8;
          pf0 = kv_load(Kb, Vb, DINP, 64 * n0, w, lane); if (nb > 1) pf1 = kv_load(Kb, Vb, DINP, 64 * (n0 + 1), w, lane);
          if (nb > 2) pf2 = kv_load(Kb, Vb, DINP, 64 * (n0 + 2), w, lane); if (nb > 3) pf3 = kv_load(Kb, Vb, DINP, 64 * (n0 + 3), w, lane); }
        for (int rd = 0; rd < NR; ++rd) {
            const int rr = __builtin_amdgcn_readfirstlane((int)items[rd]); const int n0 = rr & 255, nb = rr >> 8;
            kv_store(F.lds + L_KV, pf0, tid); if (nb > 1) kv_store(F.lds + L_KV + 16384, pf1, tid);
            if (nb > 2) kv_store(F.lds + L_SL2, pf2, tid); if (nb > 3) kv_store(F.lds + L_SL2 + 16384, pf3, tid);
            __syncthreads();
            if (rd + 1 < NR) { const int r2 = __builtin_amdgcn_readfirstlane((int)items[rd + 1]); const int m0 = r2 & 255, mb = r2 >> 8;
                pf0 = kv_load(Kb, Vb, DINP, 64 * m0, w, lane); if (mb > 1) pf1 = kv_load(Kb, Vb, DINP, 64 * (m0 + 1), w, lane);
                if (mb > 2) pf2 = kv_load(Kb, Vb, DINP, 64 * (m0 + 2), w, lane); if (mb > 3) pf3 = kv_load(Kb, Vb, DINP, 64 * (m0 + 3), w, lane); }
            const int t0c = (__builtin_amdgcn_readfirstlane(cnt[n0]) + 7) >> 3;
            const int t1c = nb > 1 ? (__builtin_amdgcn_readfirstlane(cnt[n0 + 1]) + 7) >> 3 : 0;
            const int t2c = nb > 2 ? (__builtin_amdgcn_readfirstlane(cnt[n0 + 2]) + 7) >> 3 : 0;
            const int t3c = nb > 3 ? (__builtin_amdgcn_readfirstlane(cnt[n0 + 3]) + 7) >> 3 : 0;
            const int tot = t0c + t1c + t2c + t3c;
            if (w < tot) { const int t = w;
                int sidx, k;
                if (t < t0c) { sidx = 0; k = t; } else if (t < t0c + t1c) { sidx = 1; k = t - t0c; } else if (t < t0c + t1c + t2c) { sidx = 2; k = t - t0c - t1c; } else { sidx = 3; k = t - t0c - t1c - t2c; }
                const int n = n0 + sidx; const LAS unsigned char* slot = F.lds + (sidx < 2 ? L_KV + sidx * 16384 : L_SL2 + (sidx - 2) * 16384);
                const int cn = __builtin_amdgcn_readfirstlane(cnt[n]);
                const int sl = 8 * k + (r32 >> 2); const bool rowok = sl < cn;
                const int tokq = tokl[n * 64 + (rowok ? sl : 0)]; const int row = tokq * 4 + (r32 & 3);
                bf16x8 q2[4];
                { const bf16* qp = U + (tok0 + tokq) * DINP + C_QN + (4 * g + (r32 & 3)) * 64 + 8 * hi;
#pragma unroll
                  for (int d0 = 0; d0 < 4; ++d0) q2[d0] = *(const bf16x8*)(qp + 16 * d0); }
                f32x16 p0, p1; qk_tile(slot, q2, p0, p1, r32, hi);
                const float mref = mrefs[row];
                if (n == i - 2) { bias_mask<true>(p0, p1, tbh, 64 * i + tokq - 64 * n, 1, 0, 0x7fffffff, rowok, hi);
#pragma unroll
                    for (int r = 0; r < 16; ++r) { p0[r] = __builtin_amdgcn_exp2f(fminf(p0[r] - mref, 100.f)); p1[r] = __builtin_amdgcn_exp2f(fminf(p1[r] - mref, 100.f)); } }
                else { const float sc = rowok ? C2S : 0.f, nbv = rowok ? tbh[127] - mref : NEGBIG;
#pragma unroll
                    for (int r = 0; r < 16; ++r) { p0[r] = __builtin_amdgcn_exp2f(fminf(__builtin_fmaf(p0[r], sc, nbv), 100.f)); p1[r] = __builtin_amdgcn_exp2f(fminf(__builtin_fmaf(p1[r], sc, nbv), 100.f)); } }
                { float sm = 0.f;
#pragma unroll
                  for (int r = 0; r < 16; ++r) sm += p0[r] + p1[r];
                  float t1; const float t0 = swap_lo(sm, t1);
                  if (hi == 0) { maill[32 * w + r32] = t0 + t1; if (rowok && (r32 & 3) == 0) wher[tokq * 4 + sidx] = (unsigned short)((w << 3) | (r32 >> 2)); } }
                SmState s2; s2.o0 = (f32x16){}; s2.o1 = (f32x16){};
                pv_tail(s2, p0, p1, slot + 8192, lane);
                stage_tile(mail + w * 2048, s2.o0, s2.o1, r32, hi);
            }
            __syncthreads();
#pragma unroll
            for (int a = 0; a < 4; ++a) { const int tk = 8 * w + 2 * a + hi;
#pragma unroll
                for (int jj = 0; jj < 4; ++jj) { const unsigned v = wher[tk * 4 + jj];
                    if (v != 0xffffu) { const LAS bf16* mp = mail + (v >> 3) * 2048 + (v & 7) * 256 + r32;
#pragma unroll
                        for (int e = 0; e < 4; ++e) { st.o0[4 * a + e] += bflo((unsigned)mp[e * 64]); st.o1[4 * a + e] += bflo((unsigned)mp[e * 64 + 32]); } } } }
            { const int tk = 8 * w + (r32 >> 2);
#pragma unroll
              for (int jj = 0; jj < 4; ++jj) { const unsigned v = wher[tk * 4 + jj]; if (v != 0xffffu && hi == 0) st.lsum += maill[(v >> 3) * 32 + (v & 7) * 4 + (r32 & 3)]; } }
            LDS_WAIT();
            if (lane < 32) wher[32 * w + lane] = 0xffffu;
        }
    }
    TSTAMP(5);
    finish_rows(st, wsf, r32, hi, false);
    const bf16* OW = (const bf16*)(F.ws + WS_OW); bf16* MIX = (bf16*)(F.ws + WS_MIX);
    { const bf16* gp = U + (tok0 + tql) * DINP + C_GN + (4 * g + (r32 & 3)) * 3;
      const float g1 = sigmoidf2(bflo((unsigned)gp[1]));
      if (hi == 0) wsf[r32] = g1;
      LDS_WAIT();
#pragma unroll
      for (int r = 0; r < 16; ++r) { const float g1r = wsf[crow(r, hi)]; const unsigned oc = park[r * 64]; st.o0[r] = bflo(oc) + g1r * st.o0[r]; st.o1[r] = bfhi(oc) + g1r * st.o1[r]; } }
    LDS_WAIT();
    LAS bf16* stg = (LAS bf16*)(F.lds + L_IMP) + w * 2048;
    stage_tile(stg, st.o0, st.o1, r32, hi);
    LDS_WAIT();
#pragma unroll
    for (int it = 0; it < 4; ++it) { const int row = it * 8 + (lane >> 3), ch = lane & 7;
        const size_t tk = tok0 + 8 * w + (row >> 2); const int hd = 4 * g + (row & 3), col = hd * 64 + ch * 8;
        const v4u t = *(const LAS v4u*)(stg + row * 64 + ch * 8);
        const v4u ow = *(const v4u*)(OW + tk * 512 + col); const v4u zz = *(const v4u*)(U + tk * DINP + C_ZN + col);
        const float g2 = sigmoidf2(bflo((unsigned)U[tk * DINP + C_GN + hd * 3 + 2]));
        const unsigned tw[4] = {t.x, t.y, t.z, t.w}, oww[4] = {ow.x, ow.y, ow.z, ow.w}, zw[4] = {zz.x, zz.y, zz.z, zz.w}; unsigned ov[4];
#pragma unroll
        for (int e = 0; e < 4; ++e) { const float z0 = bflo(zw[e]), z1 = bfhi(zw[e]);
            const float y0 = (bflo(tw[e]) + g2 * bflo(oww[e])) * z0 * sigmoidf2(z0), y1 = (bfhi(tw[e]) + g2 * bfhi(oww[e])) * z1 * sigmoidf2(z1);
            ov[e] = cvtpk(y0, y1); }
        *(v4u*)(MIX + tk * DM + col) = (v4u){ov[0], ov[1], ov[2], ov[3]}; }
    __syncthreads();
    TSTAMP(6);
}
template <class AT> __device__ __forceinline__ void p2_phase(Frame& F, const AT& A) {
    const int gw = F.vcu * NWAVES + F.wave, NGW = F.G * NWAVES;
    build_bias_table(F, A.in[I_RELB]);
    __syncthreads();
    for (int u = F.vcu; u < BATCH * NSA_G * 128; u += F.G) window_unit(F, u);
    __syncthreads();
    for (int u = F.vcu; u < 512; u += F.G) compress_unit(F, u);
    __syncthreads();
    LAS unsigned char* wl = F.lds + RING_OFF + F.wave * 16384;
    for (int cid = gw; cid < BATCH * GLA_H * NCHUNK; cid += NGW) gla_pass_a(F, A.in[I_BA], cid, wl);
}
constexpr int CW_Q = 200000;
template <class AT> __device__ __forceinline__ void p3_phase(Frame& F, const AT& A) {
    build_bias_table(F, A.in[I_RELB]);
    const int xq = (F.vcu >> 5) & 7;
    volatile LAS unsigned* bc = F.MISC + 16;
    if (F.tid == 0) bc[0] = __hip_atomic_fetch_add(F.ctl + CW_Q + 64 * xq, 1u, RLX_AGENT);
    __syncthreads();
    { const int item = (int)bc[0];
      if (item < 4) gla_scan_unit(F, A.in[I_GNW], 4 * xq + item, (LAS float*)(F.lds + RING_OFF)); }
    __syncthreads();
    for (;;) {
        if (F.tid == 0) bc[1] = __hip_atomic_fetch_add(F.ctl + CW_Q + 64 * (8 + xq), 1u, RLX_AGENT);
        __syncthreads();
        const int k = (int)bc[1];
        __syncthreads();
        if (k >= 256) break;
        nsa_unit(F, (2 * xq + (k & 1)) * 128 + 127 - (k >> 1));
    }
}
constexpr int N_LAUNCHES = MK_N_LAUNCHES;
constexpr int PER_PHASE = 7;
struct Args { const float* in[22]; float* out; unsigned char* ws; int ph_lo, ph_hi, li, pad; };
__global__ void __launch_bounds__(NWAVES * 64, 2) hymba_fwd(Args args) {
    extern __shared__ __attribute__((aligned(16))) unsigned char lds[];
    Frame F;
    F.lds = (LAS unsigned char*)lds;
    F.MISC = (volatile LAS unsigned*)(F.lds + MISC_OFF);
    F.tid = threadIdx.x; F.lane = F.tid & 63; F.wave = __builtin_amdgcn_readfirstlane(F.tid >> 6);
    F.G = gridDim.x; { const int bx = blockIdx.x; F.vcu = (F.G % 8 == 0) ? (bx % 8) * (F.G / 8) + bx / 8 : bx; }
    unsigned char* ws = args.ws; F.ws = ws; F.out = args.out;
    F.ctl = (gu32*)(ws + WS_CTL);
    for (int u = F.tid; u < (LDS_BYTES - LDSCTL_OFF) / 4; u += NWAVES * 64) ((LAS unsigned*)(F.lds + LDSCTL_OFF))[u] = 0u;
    __syncthreads();
    XcdBarrier bar; bar.bar = (unsigned*)(F.ctl + CW_BAR) + args.li * XCD_BAR_WORDS; bar.x = 0; bar.st = nullptr;
    if (N_LAUNCHES != PER_PHASE) bar = xcd_barrier_post((unsigned*)(F.ctl + CW_BAR) + args.li * XCD_BAR_WORDS, F.MISC + 8);
#define GRID_BAR() do { if (N_LAUNCHES != PER_PHASE) xcd_barrier(bar); } while (0)
    const int lo = args.ph_lo, hi = args.ph_hi;
#define IN(k) (lo <= (k) && (k) < hi)
#define REFRESH() do { int t_ = threadIdx.x; asm volatile("" : "+v"(t_)); F.tid = t_; F.lane = t_ & 63; } while (0)
#define BOTH(k) (IN(k) && IN((k) + 1))

    if (IN(0)) { REFRESH(); p0_prologue(F, args); if (BOTH(0)) GRID_BAR(); }
    if (IN(1)) { REFRESH();
        pg8::Gemm g{(const pg8::bf16_t*)(ws + WS_XN), (const pg8::bf16_t*)(ws + WS_WIN), M, DINP, DM}; pg8::StaticOrder S; S.init(M, DINP, F.G, (int)blockIdx.x);
        pg8::EpiBf16 E{(pg8::bf16_t*)(ws + WS_U), DINP};
        pg8::gemm_phase<pg8::EpiBf16, pg8::StaticOrder, true, true>(F.lds + RING_OFF, g, S, E);
        if (BOTH(1)) GRID_BAR();
    }
    if (IN(2)) { REFRESH();
        p2_phase(F, args);
        if (BOTH(2)) GRID_BAR();
    }
    if (IN(3)) { REFRESH();
        p3_phase(F, args);
        if (BOTH(3)) GRID_BAR();
    }
    if (IN(4)) { REFRESH();
        { pg8::Gemm g{(const pg8::bf16_t*)(ws + WS_MIX), (const pg8::bf16_t*)(ws + WS_WOUT), M, DM, DM}; pg8::StaticOrder S; S.init(M, DM, F.G, (int)blockIdx.x);
          pg8::EpiResid E{args.in[I_X], (const float*)(ws + WS_STATS), args.in[I_LN0G], args.in[I_LN0B], F.out, (pg8::bf16_t*)(ws + WS_RB), ALPHA_};
          pg8::gemm_phase<pg8::EpiResid, pg8::StaticOrder, true, true>(F.lds + RING_OFF, g, S, E); }
        { pg8::Gemm g{(const pg8::bf16_t*)(ws + WS_PB), (const pg8::bf16_t*)(ws + WS_WPE), M, DM, PLE}; pg8::StaticOrder S; S.init(M, DM, F.G, (int)blockIdx.x);
          pg8::EpiBf16 E{(pg8::bf16_t*)(ws + WS_EB), DM};
          pg8::gemm_phase<pg8::EpiBf16, pg8::StaticOrder, true, true>(F.lds + RING_OFF, g, S, E); }
        if (BOTH(4)) GRID_BAR();
    }
    if (IN(5)) { REFRESH();
        pg8::Gemm g{(const pg8::bf16_t*)(ws + WS_RB), (const pg8::bf16_t*)(ws + WS_WPG), M, DM, DM}; pg8::StaticOrder S; S.init(M, DM, F.G, (int)blockIdx.x);
        pg8::EpiGate E{F.out, (const pg8::bf16_t*)(ws + WS_EB), args.in[I_BPG]};
        pg8::gemm_phase<pg8::EpiGate, pg8::StaticOrder, true, true>(F.lds + RING_OFF, g, S, E);
        if (BOTH(5)) GRID_BAR();
    }
    if (IN(6)) { REFRESH(); final_ln(F, args.in[I_LNG], args.in[I_LNB]); }
#ifdef PROBE_SEC
    if (blockIdx.x == 0 && threadIdx.x == 0) { __threadfence(); const unsigned long long* tp = (const unsigned long long*)((unsigned*)F.ctl + 210000); { float xv = (float)(PROBE_SEC >= 10 ? tp[PROBE_SEC] : tp[PROBE_SEC] / 1000ull); if (PROBE_SEC < 10) xv = exp2f(rintf(2.0f * log2f(xv + 1.0f)) * 0.5f); F.out[0] = xv; } }
#endif
#undef IN
#undef BOTH
}

extern "C" void kernel_launch(void* const* d_in, const int* in_sizes, int n_in, void* d_out, int out_size, void* d_ws, size_t ws_size, hipStream_t stream) {
    static int grid = 0;
    if (grid == 0) {
        if (n_in != 22 || out_size != M * DM || ws_size < WS_END) { fprintf(stderr, "kernel_launch: unexpected shapes (n_in %d out %d ws %zu)\n", n_in, out_size, ws_size); grid = -1; return; }
        int dev = 0, cus = 0, per_cu = 0;
        if (hipGetDevice(&dev) != hipSuccess || hipDeviceGetAttribute(&cus, hipDeviceAttributeMultiprocessorCount, dev) != hipSuccess) { grid = -1; return; }
        if (hipFuncSetAttribute((const void*)hymba_fwd, hipFuncAttributeMaxDynamicSharedMemorySize, LDS_BYTES) != hipSuccess) { fprintf(stderr, "kernel_launch: hipFuncSetAttribute failed\n"); grid = -1; return; }
        if (hipOccupancyMaxActiveBlocksPerMultiprocessor(&per_cu, (const void*)hymba_fwd, NWAVES * 64, LDS_BYTES) != hipSuccess || per_cu < 1)
            fprintf(stderr, "kernel_launch: occupancy query reports %d workgroups per CU\n", per_cu);
        (void)hipGetLastError();
        grid = cus;
    }
    if (grid < 0) return;
    (void)hipMemsetAsync((char*)d_ws + WS_CTL, 0, CTL_ZERO_BYTES, stream);
    Args a{};
    for (int i = 0; i < 22; ++i) a.in[i] = (const float*)d_in[i];
    a.out = (float*)d_out; a.ws = (unsigned char*)d_ws;
#ifdef PROBE_SEQ
    { const int seq[][2] = PROBE_SEQ; const int nseq = (int)(sizeof(seq) / sizeof(seq[0]));
      for (int li = 0; li < nseq; ++li) { a.ph_lo = seq[li][0]; a.ph_hi = seq[li][1]; a.li = li; hipLaunchKernelGGL(hymba_fwd, dim3(grid), dim3(NWAVES * 64), LDS_BYTES, stream, a); } }
#else
    if (N_LAUNCHES == 1) { a.ph_lo = 0; a.ph_hi = PER_PHASE; a.li = 0; hipLaunchKernelGGL(hymba_fwd, dim3(grid), dim3(NWAVES * 64), LDS_BYTES, stream, a); }
    else for (int li = 0; li < PER_PHASE; ++li) { a.ph_lo = li; a.ph_hi = li + 1; a.li = 0; hipLaunchKernelGGL(hymba_fwd, dim3(grid), dim3(NWAVES * 64), LDS_BYTES, stream, a); }
#endif
}
```

```cpp
#include <hip/hip_runtime.h>
#include <hip/hip_bf16.h>
#include <cstdio>
#include <cstdint>
namespace pg8 {
#define PG8_LAS __attribute__((address_space(3)))
typedef unsigned short bf16_t;
typedef short bf16x8 __attribute__((ext_vector_type(8)));
typedef float f32x4 __attribute__((ext_vector_type(4)));
typedef unsigned u32x4 __attribute__((ext_vector_type(4)));
constexpr int BM = 256, BK = 64, HALF = 128, HTB = HALF * BK * 2  , STAGE_BYTES = 8 * HTB, NXCD = 8, WGM = 8;

__host__ __device__ __forceinline__ int lds_byte(int r, int c) { const int st = (r >> 4) * 2 + (c >> 5), rr = r & 15, cc = c & 31, ob = rr * 64 + cc * 2; return st * 1024 + (ob ^ (((ob >> 9) & 1) << 5)); }
__host__ __device__ __forceinline__ void stage_rc(int b, int& R, int& C) { const int st = b / 1024, sb = b % 1024, swz = sb ^ (((sb >> 9) & 1) << 5); R = (st >> 1) * 16 + swz / 64; C = (st & 1) * 32 + (swz % 64) / 2; }
__host__ __device__ __forceinline__ int perm32(int rho) { const int n = rho >> 4, i = rho & 15; return 8 * (i >> 2) + 4 * n + (i & 3); }

struct Unit { int pm, pn; };
struct Gemm { const bf16_t* A; const bf16_t* Bt; int M, N, K; };

struct StaticOrder {
    int nM, nN, nwg, G, c;
    __host__ __device__ void init(int M, int N, int G_, int c_) { nM = M / BM; nN = N / BM; nwg = nM * nN; G = G_; c = c_; }
    __host__ __device__ bool next(int i, Unit& u) const {
        const long L = (long)i * G + c; if (L >= nwg) return false;
        int wgid = (int)L; { const int q = nwg / NXCD, r = nwg % NXCD, xcd = wgid % NXCD, off = wgid / NXCD; wgid = (xcd < r ? xcd * (q + 1) : r * (q + 1) + (xcd - r) * q) + off; }
        const int nig = WGM * nN, gid = wgid / nig, fm = gid * WGM, gsz = (nM - fm) < WGM ? (nM - fm) : WGM;
        u.pm = fm + ((wgid % nig) % gsz); u.pn = (wgid % nig) / gsz; return true;
    }
    __device__ __forceinline__ void a_ready(const Unit&) const {}
    __device__ __forceinline__ void done(const Unit&) const {}
};
__device__ __forceinline__ unsigned cvt_pk_bf16(float lo, float hi) { unsigned r; asm volatile("v_cvt_pk_bf16_f32 %0, %1, %2" : "=v"(r) : "v"(lo), "v"(hi)); return r; }
struct EpiBf16 {
    static constexpr bool PERM = true, AFTER_DRAIN = false;
    bf16_t* O; int ldc;
    __device__ __forceinline__ void operator()(const f32x4 (&acc)[2][2][4][2], const Unit& u, int wr, int wc, int fr, int fq) const {
        const int row0 = u.pm * BM + wr * 64 + fr; const int col0 = u.pn * BM + wc * 32 + 8 * fq;
#pragma unroll
        for (int ai = 0; ai < 2; ++ai)
#pragma unroll
            for (int m = 0; m < 4; ++m) { bf16_t* rowp = O + (size_t)(row0 + ai * HALF + m * 16) * ldc + col0;
#pragma unroll
                for (int bj = 0; bj < 2; ++bj) { const f32x4 v0 = acc[ai][bj][m][0], v1 = acc[ai][bj][m][1];
                    u32x4 w; w.x = cvt_pk_bf16(v0[0], v0[1]); w.y = cvt_pk_bf16(v0[2], v0[3]); w.z = cvt_pk_bf16(v1[0], v1[1]); w.w = cvt_pk_bf16(v1[2], v1[3]);
                    *(u32x4*)(rowp + bj * HALF) = w; } }
    }
};
struct EpiResid {
    static constexpr bool PERM = true, AFTER_DRAIN = false;
    const float* x; const float* stats; const float* g; const float* b; float* out; bf16_t* rb; float alpha;
    __device__ __forceinline__ void operator()(const f32x4 (&acc)[2][2][4][2], const Unit& u, int wr, int wc, int fr, int fq) const {
        const int row0 = u.pm * BM + wr * 64 + fr; const int col0 = u.pn * BM + wc * 32 + 8 * fq;
        f32x4 gv[2][2], bv[2][2];
#pragma unroll
        for (int bj = 0; bj < 2; ++bj)
#pragma unroll
            for (int n = 0; n < 2; ++n) { gv[bj][n] = *(const f32x4*)(g + col0 + bj * HALF + 4 * n) * alpha; bv[bj][n] = *(const f32x4*)(b + col0 + bj * HALF + 4 * n) * alpha; }
#pragma unroll
        for (int ai = 0; ai < 2; ++ai)
#pragma unroll
            for (int m = 0; m < 4; ++m) { const int row = row0 + ai * HALF + m * 16; const size_t off = (size_t)row * 1024 + col0;
                const float mean = stats[2 * row], rstd = stats[2 * row + 1];
#pragma unroll
                for (int bj = 0; bj < 2; ++bj) {
                    const f32x4 x0 = *(const f32x4*)(x + off + bj * HALF), x1 = *(const f32x4*)(x + off + bj * HALF + 4);
                    const f32x4 v0 = ((x0 - mean) * rstd) * gv[bj][0] + bv[bj][0] + acc[ai][bj][m][0];
                    const f32x4 v1 = ((x1 - mean) * rstd) * gv[bj][1] + bv[bj][1] + acc[ai][bj][m][1];
                    *(f32x4*)(out + off + bj * HALF) = v0; *(f32x4*)(out + off + bj * HALF + 4) = v1;
                    u32x4 w; w.x = cvt_pk_bf16(v0[0], v0[1]); w.y = cvt_pk_bf16(v0[2], v0[3]); w.z = cvt_pk_bf16(v1[0], v1[1]); w.w = cvt_pk_bf16(v1[2], v1[3]);
                    *(u32x4*)(rb + off + bj * HALF) = w; } }
    }
};
__device__ __forceinline__ float bf_lo(unsigned w) { return __uint_as_float(w << 16); }
__device__ __forceinline__ float bf_hi(unsigned w) { return __uint_as_float(w & 0xffff0000u); }
__device__ __forceinline__ float sigmoidf_(float v) { return __builtin_amdgcn_rcpf(1.0f + __builtin_amdgcn_exp2f(-1.4426950408889634f * v)); }
struct EpiGate {
    static constexpr bool PERM = true, AFTER_DRAIN = false;
    float* out; const bf16_t* E; const float* bias;
    __device__ __forceinline__ void operator()(const f32x4 (&acc)[2][2][4][2], const Unit& u, int wr, int wc, int fr, int fq) const {
        const int row0 = u.pm * BM + wr * 64 + fr; const int col0 = u.pn * BM + wc * 32 + 8 * fq;
        f32x4 bv[2][2];
#pragma unroll
        for (int bj = 0; bj < 2; ++bj)
#pragma unroll
            for (int n = 0; n < 2; ++n) bv[bj][n] = *(const f32x4*)(bias + col0 + bj * HALF + 4 * n);
#pragma unroll
        for (int ai = 0; ai < 2; ++ai)
#pragma unroll
            for (int m = 0; m < 4; ++m) { const int row = row0 + ai * HALF + m * 16; const size_t off = (size_t)row * 1024 + col0;
#pragma unroll
                for (int bj = 0; bj < 2; ++bj) {
                    const f32x4 r0 = *(const f32x4*)(out + off + bj * HALF), r1 = *(const f32x4*)(out + off + bj * HALF + 4);
                    const u32x4 e = *(const u32x4*)(E + off + bj * HALF);
                    const f32x4 a0 = acc[ai][bj][m][0] + bv[bj][0], a1 = acc[ai][bj][m][1] + bv[bj][1];
                    f32x4 v0, v1;
                    v0[0] = r0[0] + sigmoidf_(a0[0]) * bf_lo(e.x); v0[1] = r0[1] + sigmoidf_(a0[1]) * bf_hi(e.x);
                    v0[2] = r0[2] + sigmoidf_(a0[2]) * bf_lo(e.y); v0[3] = r0[3] + sigmoidf_(a0[3]) * bf_hi(e.y);
                    v1[0] = r1[0] + sigmoidf_(a1[0]) * bf_lo(e.z); v1[1] = r1[1] + sigmoidf_(a1[1]) * bf_hi(e.z);
                    v1[2] = r1[2] + sigmoidf_(a1[2]) * bf_lo(e.w); v1[3] = r1[3] + sigmoidf_(a1[3]) * bf_hi(e.w);
                    *(f32x4*)(out + off + bj * HALF) = v0; *(f32x4*)(out + off + bj * HALF + 4) = v1; } }
    }
};
template <class Epi, class Sched, bool ALIGN_EPI = false, bool SP2 = false>
__device__ __forceinline__ void gemm_phase(PG8_LAS unsigned char* lds, const Gemm g, const Sched& S, const Epi& E) {
    const int tid = threadIdx.x, wid = __builtin_amdgcn_readfirstlane(tid >> 6), lane = tid & 63, wr = wid >> 2, wc = wid & 3, fr = lane & 15, fq = lane >> 4;
    const int K = g.K, nt = K / BK;
    unsigned voffA[2], voffB[2];
#pragma unroll
    for (int i = 0; i < 2; ++i) { int R, C; stage_rc(tid * 16 + i * 8192, R, C); const int Rb = Epi::PERM ? ((R & ~31) + perm32(R & 31)) : R;
        voffA[i] = (unsigned)(R * K + C) * 2u; voffB[i] = (unsigned)(Rb * K + C) * 2u; }
    const size_t kstep = (size_t)(BK * 2);
    const size_t hstep = (size_t)HALF * K * 2;
    const size_t tstep = 2 * hstep;
    const unsigned ldsw = (unsigned)wid * 1024u;
    const int aoff = lds_byte(wr * 64 + fr, fq * 8), boff = lds_byte(wc * 32 + fr, fq * 8);
#define PG8_SA(b, h) (((b) * 2 + (h)) * HTB)
#define PG8_SB(b, h) ((4 + (b) * 2 + (h)) * HTB)
#define PG8_STAGE(bufoff, gbase, voff) do { _Pragma("unroll") for (int _i = 0; _i < 2; ++_i) \
        __builtin_amdgcn_global_load_lds((const unsigned*)((const char*)(gbase) + (voff)[_i]), (PG8_LAS unsigned*)(lds + (bufoff) + ldsw + _i * 8192), 16, 0, 0); } while (0)
#define PG8_LDA(dst, b, h) do { _Pragma("unroll") for (int m = 0; m < 4; ++m) _Pragma("unroll") for (int k = 0; k < 2; ++k) dst[m][k] = *(const PG8_LAS bf16x8*)(lds + PG8_SA(b, h) + aoff + m * 2048 + k * 1024); } while (0)
#define PG8_LDB(dst, b, h) do { _Pragma("unroll") for (int n = 0; n < 2; ++n) _Pragma("unroll") for (int k = 0; k < 2; ++k) dst[n][k] = *(const PG8_LAS bf16x8*)(lds + PG8_SB(b, h) + boff + n * 2048 + k * 1024); } while (0)
#define PG8_MMA(ai, bj, At, Bt) do { __builtin_amdgcn_s_setprio(1); _Pragma("unroll") for (int m = 0; m < 4; ++m) _Pragma("unroll") for (int n = 0; n < 2; ++n) _Pragma("unroll") for (int k = 0; k < 2; ++k) \
        acc[ai][bj][m][n] = __builtin_amdgcn_mfma_f32_16x16x32_bf16(Bt[n][k], At[m][k], acc[ai][bj][m][n], 0, 0, 0); __builtin_amdgcn_s_setprio(0); } while (0)
#define PG8_WAIT_V(n) asm volatile("s_waitcnt vmcnt(" #n ")" ::: "memory")
#define PG8_WAIT_L(n) asm volatile("s_waitcnt lgkmcnt(" #n ")" ::: "memory")
#define PG8_BAR __builtin_amdgcn_s_barrier()
#define PG8_SCHED __builtin_amdgcn_sched_barrier(0)
    Unit cur, nxt; int ui = 0;
    if (!S.next(0, cur)) return;
    f32x4 acc[2][2][4][2];
#pragma unroll
    for (int a = 0; a < 2; ++a)
#pragma unroll
        for (int b = 0; b < 2; ++b)
#pragma unroll
            for (int m = 0; m < 4; ++m)
#pragma unroll
                for (int n = 0; n < 2; ++n) acc[a][b][m][n] = (f32x4){0.f, 0.f, 0.f, 0.f};
    bf16x8 At[4][2], B0[2][2], B1[2][2];
    const char* cA = (const char*)g.A + (size_t)cur.pm * tstep; const char* cB = (const char*)g.Bt + (size_t)cur.pn * tstep;
    S.a_ready(cur);
    if constexpr (SP2) {
        PG8_STAGE(PG8_SB(0, 0), cB, voffB); PG8_STAGE(PG8_SB(0, 1), cB + hstep, voffB); PG8_STAGE(PG8_SA(0, 0), cA, voffA); PG8_STAGE(PG8_SA(0, 1), cA + hstep, voffA);
        if (wr == 1) PG8_BAR;
        PG8_WAIT_V(2); PG8_BAR;
        PG8_STAGE(PG8_SB(1, 0), cB + kstep, voffB); PG8_STAGE(PG8_SA(1, 0), cA + kstep, voffA); PG8_STAGE(PG8_SB(1, 1), cB + hstep + kstep, voffB);
        PG8_WAIT_V(6); PG8_BAR;
    } else {
        PG8_STAGE(PG8_SB(0, 0), cB, voffB); PG8_STAGE(PG8_SA(0, 0), cA, voffA); PG8_STAGE(PG8_SB(0, 1), cB + hstep, voffB); PG8_STAGE(PG8_SA(0, 1), cA + hstep, voffA);
        if (wr == 1) PG8_BAR;
        PG8_WAIT_V(4); PG8_BAR;
        PG8_STAGE(PG8_SB(1, 0), cB + kstep, voffB); PG8_STAGE(PG8_SA(1, 0), cA + kstep, voffA); PG8_STAGE(PG8_SB(1, 1), cB + hstep + kstep, voffB);
        PG8_WAIT_V(6); PG8_BAR;
    }
    for (;;) {
        const bool has_next = S.next(ui + 1, nxt);
        const char* nA = has_next ? (const char*)g.A + (size_t)nxt.pm * tstep : cA; const char* nB = has_next ? (const char*)g.Bt + (size_t)nxt.pn * tstep : cB;
        for (int t = 0; t < nt; t += 2) {
            const bool last = (t == nt - 2);
            const char* a1 = cA + (size_t)(t + 1) * kstep;
            const char* a2 = last ? nA : cA + (size_t)(t + 2) * kstep; const char* b2 = last ? nB : cB + (size_t)(t + 2) * kstep;
            const char* a3 = a2 + kstep; const char* b3 = b2 + kstep;
            if (last && has_next) S.a_ready(nxt);
            if constexpr (SP2) {
            PG8_LDB(B0, 0, 0); PG8_LDB(B1, 0, 1); PG8_SCHED; PG8_LDA(At, 0, 0); PG8_STAGE(PG8_SA(1, 1), a1 + hstep, voffA);
            PG8_WAIT_V(8); PG8_WAIT_L(0); PG8_BAR; PG8_MMA(0, 0, At, B0); PG8_MMA(0, 1, At, B1); PG8_BAR; PG8_SCHED;
            PG8_LDA(At, 0, 1); PG8_STAGE(PG8_SB(0, 0), b2, voffB); PG8_STAGE(PG8_SB(0, 1), b2 + hstep, voffB); PG8_STAGE(PG8_SA(0, 0), a2, voffA);
            PG8_WAIT_V(8); PG8_WAIT_L(0); PG8_BAR; PG8_MMA(1, 0, At, B0); PG8_MMA(1, 1, At, B1); PG8_BAR; PG8_SCHED;
            PG8_LDB(B0, 1, 0); PG8_LDB(B1, 1, 1); PG8_SCHED; PG8_LDA(At, 1, 0); PG8_STAGE(PG8_SA(0, 1), a2 + hstep, voffA);
            PG8_WAIT_V(8); PG8_WAIT_L(0); PG8_BAR; PG8_MMA(0, 0, At, B0); PG8_MMA(0, 1, At, B1); PG8_BAR; PG8_SCHED;
            PG8_LDA(At, 1, 1); PG8_STAGE(PG8_SB(1, 0), b3, voffB); PG8_STAGE(PG8_SB(1, 1), b3 + hstep, voffB); PG8_STAGE(PG8_SA(1, 0), a3, voffA);
            PG8_WAIT_V(8); PG8_WAIT_L(0); PG8_BAR; PG8_MMA(1, 0, At, B0); PG8_MMA(1, 1, At, B1); PG8_BAR; PG8_SCHED;
            } else {
            PG8_LDB(B0, 0, 0); PG8_SCHED; PG8_LDA(At, 0, 0); PG8_STAGE(PG8_SA(1, 1), a1 + hstep, voffA);
            PG8_WAIT_L(8); PG8_BAR; PG8_WAIT_L(0); PG8_MMA(0, 0, At, B0); PG8_BAR; PG8_SCHED;
            PG8_LDB(B1, 0, 1); PG8_STAGE(PG8_SB(0, 0), b2, voffB);
            PG8_BAR; PG8_WAIT_L(0); PG8_MMA(0, 1, At, B1); PG8_BAR;
            PG8_LDA(At, 0, 1); PG8_STAGE(PG8_SA(0, 0), a2, voffA);
            PG8_BAR; PG8_WAIT_L(0); PG8_MMA(1, 0, At, B0); PG8_BAR; PG8_SCHED;
            PG8_STAGE(PG8_SB(0, 1), b2 + hstep, voffB);
            PG8_WAIT_V(6); PG8_BAR; PG8_MMA(1, 1, At, B1); PG8_BAR;
            PG8_LDB(B0, 1, 0); PG8_SCHED; PG8_LDA(At, 1, 0); PG8_STAGE(PG8_SA(0, 1), a2 + hstep, voffA);
            PG8_WAIT_L(8); PG8_BAR; PG8_WAIT_L(0); PG8_MMA(0, 0, At, B0); PG8_BAR; PG8_SCHED;
            PG8_LDB(B1, 1, 1); PG8_STAGE(PG8_SB(1, 0), b3, voffB);
            PG8_BAR; PG8_WAIT_L(0); PG8_MMA(0, 1, At, B1); PG8_BAR;
            PG8_LDA(At, 1, 1); PG8_STAGE(PG8_SA(1, 0), a3, voffA);
            PG8_BAR; PG8_WAIT_L(0); PG8_MMA(1, 0, At, B0); PG8_BAR; PG8_SCHED;
            PG8_STAGE(PG8_SB(1, 1), b3 + hstep, voffB);
            PG8_WAIT_V(6); PG8_BAR; PG8_MMA(1, 1, At, B1); PG8_BAR;
            }
        }
        if constexpr (ALIGN_EPI) { if (wr == 0) PG8_BAR; }
        if constexpr (!Epi::AFTER_DRAIN) { E(acc, cur, wr, wc, fr, fq); S.done(cur); }
        if (!has_next) break;
#pragma unroll
        for (int a = 0; a < 2; ++a)
#pragma unroll
            for (int b = 0; b < 2; ++b)
#pragma unroll
                for (int m = 0; m < 4; ++m)
#pragma unroll
                    for (int n = 0; n < 2; ++n) acc[a][b][m][n] = (f32x4){0.f, 0.f, 0.f, 0.f};
        cur = nxt; cA = nA; cB = nB; ++ui;
        if constexpr (ALIGN_EPI) { if (wr == 1) PG8_BAR; }
    }
    PG8_WAIT_V(0);
    if constexpr (!ALIGN_EPI) { if (wr == 0) PG8_BAR; }
    PG8_BAR;
    if constexpr (Epi::AFTER_DRAIN) { E.fused(acc, cur, wr, wc, fr, fq, lds, wid, lane); S.done(cur); }
#undef PG8_SA
#undef PG8_SB
#undef PG8_STAGE
#undef PG8_LDA
#undef PG8_LDB
#undef PG8_MMA
#undef PG8_WAIT_V
#undef PG8_WAIT_L
#undef PG8_BAR
#undef PG8_SCHED
}
}
constexpr int NWAVES = 8;
#ifndef MK_N_LAUNCHES
#define MK_N_LAUNCHES 1
#endif
constexpr int BATCH = 8, SEQ = 8192, DM = 1024, M = BATCH * SEQ;
constexpr int PLE = 256, DIN = 3368, DINP = 3584;
constexpr int NSA_H = 8, NSA_G = 2, NSA_R = 4, DH = 64, NC = 511, NCP = 512;
constexpr int CMPH = 256, CMPK = 2048;
constexpr int GLA_H = 4, GDK = 64, GDV = 128, GRANK = 16, GCH = 64, NCHUNK = SEQ / GCH;
constexpr int C_QN = 0, C_KC = 512, C_VC = 640, C_KS = 768, C_VS = 896, C_KW = 1024, C_VW = 1152, C_GN = 1280, C_ZN = 1304,
              C_QG = 1816, C_KG = 2072, C_VG = 2328, C_AL = 2840, C_ZG = 2856;
constexpr float LN_EPS = 1e-5f;
constexpr float ALPHA_ = 1.189207115002721f;
constexpr float LOG2E = 1.4426950408889634f;

constexpr size_t MiB = 1u << 20;
constexpr size_t WS_CTL = 0, CTL_ZERO_BYTES = 1 * MiB;
constexpr size_t WS_WIN = 1 * MiB;
constexpr size_t WS_WOUT = 8 * MiB, WS_WPG = 10 * MiB;
constexpr size_t WS_WPE = 12 * MiB;
constexpr size_t WS_WCK1 = 13 * MiB, WS_WCV1 = 14 * MiB;
constexpr size_t WS_SMALL = 15 * MiB;
constexpr size_t SM_WCK2 = 0, SM_WCV2 = 32768, SM_WA2 = 65536, SM_CB1K = 73728, SM_CB1V = 74752;
constexpr size_t WS_STATS = 16 * MiB;
constexpr size_t WS_KC = 17 * MiB, WS_VC = 18 * MiB;
constexpr size_t WS_DEC = 19 * MiB;
constexpr size_t WS_XN = 20 * MiB;
constexpr size_t WS_MIX = WS_XN;
constexpr size_t WS_PB = 148 * MiB;
constexpr size_t WS_U = 180 * MiB;
constexpr size_t WS_EB = WS_U;
constexpr size_t WS_OW = 629 * MiB;
constexpr size_t WS_QE = 693 * MiB;
constexpr size_t WS_KV = 725 * MiB;
constexpr size_t WS_RB = WS_KV;
constexpr size_t WS_OI = 853 * MiB;
constexpr size_t WS_VST = 917 * MiB;
constexpr size_t WS_PARK = 933 * MiB;
constexpr size_t WS_END = 965 * MiB;
constexpr int CW_BAR = 4096;

constexpr int RING_OFF = 0, RING_BYTES = 155648;
constexpr int LDSCTL_OFF = RING_BYTES, MISC_OFF = LDSCTL_OFF + 320;
constexpr int LDS_BYTES = 163840;

#define GAS __attribute__((address_space(1)))
#define LAS __attribute__((address_space(3)))
typedef unsigned short bf16;
typedef unsigned v4u __attribute__((ext_vector_type(4)));
typedef unsigned v2u __attribute__((ext_vector_type(2)));
typedef float f32x4 __attribute__((ext_vector_type(4)));
typedef float f32x16 __attribute__((ext_vector_type(16)));
typedef short bf16x8 __attribute__((ext_vector_type(8)));
typedef GAS unsigned gu32;
#define RLX_AGENT __ATOMIC_RELAXED, __HIP_MEMORY_SCOPE_AGENT
#define LDS_WAIT() asm volatile("s_waitcnt lgkmcnt(0)" ::: "memory")
#define VM_WAIT() asm volatile("s_waitcnt vmcnt(0)" ::: "memory")
__device__ __forceinline__ unsigned f2bf(float f) { unsigned u = __builtin_bit_cast(unsigned, f); return (u + 0x7fffu + ((u >> 16) & 1u)) >> 16; }
__device__ __forceinline__ unsigned pk2(float lo, float hi) { return f2bf(lo) | (f2bf(hi) << 16); }
__device__ __forceinline__ float bflo(unsigned w) { return __uint_as_float(w << 16); }
__device__ __forceinline__ float bfhi(unsigned w) { return __uint_as_float(w & 0xffff0000u); }
__device__ __forceinline__ float sigmoidf2(float v) { return __builtin_amdgcn_rcpf(1.0f + __builtin_amdgcn_exp2f(-1.4426950408889634f * v)); }
#define XB_TMO      128
#define XB_XCNT(j)  (256  + 64 * (j))
#define XB_XSUB(j)  (1280 + 64 * (j))
#define XB_XGEN(j)  (2304 + 64 * (j))
#define XB_TOP      3328
#define XB_TOPGEN   3392
#define XCD_BAR_WORDS 3456
#define XB_SPIN_CAP (1u << 18)

__device__ __forceinline__ unsigned xb_ld(unsigned* p)              { return __hip_atomic_load(p, __ATOMIC_RELAXED, __HIP_MEMORY_SCOPE_AGENT); }
__device__ __forceinline__ unsigned xb_add(unsigned* p, unsigned v) { return __hip_atomic_fetch_add(p, v, __ATOMIC_RELAXED, __HIP_MEMORY_SCOPE_AGENT); }
__device__ __forceinline__ unsigned xb_xcc_id() { return (unsigned)__builtin_amdgcn_s_getreg((3 << 11) | 20) & 0xFu; }
#define XB_SPIN(cond, bar) do { unsigned _sp = 0; while (cond) { __builtin_amdgcn_s_sleep(1); \
    if ((++_sp & 255u) == 0u) { if (xb_ld(&(bar)[XB_TMO])) break; if (_sp > XB_SPIN_CAP) { atomicAdd(&(bar)[XB_TMO], 1u); break; } } } } while (0)

struct XcdBarrier {
    unsigned* bar; unsigned x;
    volatile LAS unsigned* st;
};

__device__ __forceinline__ XcdBarrier xcd_barrier_post(unsigned* bar, volatile LAS unsigned* st) {
    XcdBarrier b; b.bar = bar; b.x = xb_xcc_id(); b.st = st;
    if (threadIdx.x == 0) (void)xb_add(&bar[XB_XCNT(b.x)], 1u);
    return b;
}
__device__ __forceinline__ void xcd_barrier_complete(unsigned* bar, unsigned x, unsigned& nloc, unsigned& nx) {
    const unsigned G = gridDim.x * gridDim.y * gridDim.z;
    unsigned sum, cnt, mine, sp = 0u;
    for (;;) {
        sum = 0u; cnt = 0u; mine = 0u;
#pragma unroll
        for (unsigned j = 0; j < 16; ++j) { const unsigned c = xb_ld(&bar[XB_XCNT(j)]); sum += c; cnt += (c > 0u) ? 1u : 0u; mine = (j == x) ? c : mine; }
        if (sum == G) break;
        __builtin_amdgcn_s_sleep(1);
        if ((++sp & 255u) == 0u) { if (xb_ld(&bar[XB_TMO])) break; if (sp > XB_SPIN_CAP) { atomicAdd(&bar[XB_TMO], 1u); break; } }
    }
    nloc = mine > 0u ? mine : 1u; nx = cnt > 0u ? cnt : 1u;
}

__device__ __forceinline__ void xcd_barrier(const XcdBarrier& b) {
    asm volatile("s_waitcnt vmcnt(0)" ::: "memory");
    __syncthreads();
    if (threadIdx.x == 0) {
        unsigned* bar = b.bar;
        __builtin_amdgcn_s_waitcnt(0);
        unsigned nloc = b.st[0], nx = b.st[1];
        if (nloc == 0u) { xcd_barrier_complete(bar, b.x, nloc, nx); b.st[0] = nloc; b.st[1] = nx; }
        const unsigned old = xb_add(&bar[XB_XSUB(b.x)], 1u);
        const unsigned gen = old / nloc;
        if (old + 1u == (gen + 1u) * nloc) {
            __builtin_amdgcn_fence(__ATOMIC_RELEASE, "agent");
            asm volatile("s_waitcnt vmcnt(0)" ::: "memory");
            const unsigned og = xb_add(&bar[XB_TOP], 1u);
            const unsigned tg = og / nx;
            if (og + 1u == (tg + 1u) * nx) xb_add(&bar[XB_TOPGEN], 1u);
            else XB_SPIN(xb_ld(&bar[XB_TOPGEN]) == tg, bar);
            __builtin_amdgcn_fence(__ATOMIC_ACQUIRE, "agent");
            xb_add(&bar[XB_XGEN(b.x)], 1u);
            asm volatile("s_waitcnt vmcnt(0)" ::: "memory");
        } else {
            XB_SPIN(xb_ld(&bar[XB_XGEN(b.x)]) == gen, bar);
            __builtin_amdgcn_fence(__ATOMIC_ACQUIRE, "agent");
            asm volatile("s_waitcnt vmcnt(0)" ::: "memory");
        }
    }
    __syncthreads();
}
struct Frame {
    LAS unsigned char* lds;
    volatile LAS unsigned* MISC;
    gu32* ctl;
    int tid, lane, wave;
    int vcu, G;
    float* out; unsigned char* ws;
};
enum { I_X = 0, I_P, I_LN0G, I_LN0B, I_RELB, I_WIN, I_WA2, I_BA, I_GNW, I_POS, I_WCK1, I_BCK1, I_WCK2, I_WCV1, I_BCV1, I_WCV2, I_WOUT, I_WPE, I_WPG, I_BPG, I_LNG, I_LNB };

__device__ __forceinline__ float wave_sum(float v) {
#pragma unroll
    for (int o = 1; o < 64; o <<= 1) v += __shfl_xor(v, o);
    return v;
}
__device__ __forceinline__ void p0_transpose_item(const float* W, int K, int N, int nblk, bf16* WT, LAS float* scr, int item, int lane) {
    const int kb = item / nblk, nb = item % nblk, k0 = 64 * kb, n0 = 32 * nb;
    const int nn = n0 + (lane & 31);
#pragma unroll 8
    for (int i = 0; i < 32; ++i) { const int kk = 2 * i + (lane >> 5); scr[kk * 33 + (lane & 31)] = (nn < N) ? W[(size_t)(k0 + kk) * N + nn] : 0.f; }
    LDS_WAIT(); asm volatile("" ::: "memory");
    const int c = lane & 7;
#pragma unroll
    for (int j = 0; j < 4; ++j) { const int n = (lane >> 3) + 8 * j; const LAS float* s = scr + (8 * c) * 33 + n;
        v4u o; o.x = pk2(s[0 * 33], s[1 * 33]); o.y = pk2(s[2 * 33], s[3 * 33]); o.z = pk2(s[4 * 33], s[5 * 33]); o.w = pk2(s[6 * 33], s[7 * 33]);
        *(v4u*)(WT + (size_t)(n0 + n) * K + k0 + 8 * c) = o; }
    LDS_WAIT(); asm volatile("" ::: "memory");
}
__device__ __forceinline__ void ln0_row(const float* xrow, const float* g, const float* b, bf16* orow, float* st, int lane) {
    const f32x4* xr = (const f32x4*)xrow + lane;
    f32x4 v[4]; float s = 0.f;
#pragma unroll
    for (int j = 0; j < 4; ++j) { v[j] = xr[64 * j]; s += (v[j].x + v[j].y) + (v[j].z + v[j].w); }
    const float mean = wave_sum(s) * (1.f / DM); float s2 = 0.f;
#pragma unroll
    for (int j = 0; j < 4; ++j) { v[j] = v[j] - mean; s2 += (v[j].x * v[j].x + v[j].y * v[j].y) + (v[j].z * v[j].z + v[j].w * v[j].w); }
    const float rstd = 1.f / sqrtf(wave_sum(s2) * (1.f / DM) + LN_EPS);
    if (lane == 0) { st[0] = mean; st[1] = rstd; }
    unsigned long long* o8 = (unsigned long long*)orow + lane;
#pragma unroll
    for (int j = 0; j < 4; ++j) { const f32x4 gg = ((const f32x4*)g)[lane + 64 * j], bb = ((const f32x4*)b)[lane + 64 * j]; const f32x4 y = v[j] * rstd * gg + bb;
        o8[64 * j] = (unsigned long long)pk2(y.x, y.y) | ((unsigned long long)pk2(y.z, y.w) << 32); }
}
template <class AT> __device__ __forceinline__ void p0_prologue(Frame& F, const AT& A) {
    LAS float* scr = (LAS float*)(F.lds + RING_OFF + F.wave * 16384);
    const int gw = F.vcu * NWAVES + F.wave, NGW = F.G * NWAVES;
    unsigned char* ws = F.ws;
    constexpr int I_IN = (DM / 64) * (DINP / 32), I_SQ = (DM / 64) * (DM / 32), I_PE = (PLE / 64) * (DM / 32), I_C1 = (CMPK / 64) * (CMPH / 32), I_C2 = (CMPH / 64) * (DH / 32);
    constexpr int NITEMS = I_IN + 2 * I_SQ + I_PE + 2 * I_C1 + 2 * I_C2;
    for (int it = gw; it < NITEMS; it += NGW) {
        int r = it;
        if (r < I_IN) { p0_transpose_item(A.in[I_WIN], DM, DIN, DINP / 32, (bf16*)(ws + WS_WIN), scr, r, F.lane); continue; } r -= I_IN;
        if (r < I_SQ) { p0_transpose_item(A.in[I_WOUT], DM, DM, DM / 32, (bf16*)(ws + WS_WOUT), scr, r, F.lane); continue; } r -= I_SQ;
        if (r < I_SQ) { p0_transpose_item(A.in[I_WPG], DM, DM, DM / 32, (bf16*)(ws + WS_WPG), scr, r, F.lane); continue; } r -= I_SQ;
        if (r < I_PE) { p0_transpose_item(A.in[I_WPE], PLE, DM, DM / 32, (bf16*)(ws + WS_WPE), scr, r, F.lane); continue; } r -= I_PE;
        if (r < I_C1) { p0_transpose_item(A.in[I_WCK1], CMPK, CMPH, CMPH / 32, (bf16*)(ws + WS_WCK1), scr, r, F.lane); continue; } r -= I_C1;
        if (r < I_C1) { p0_transpose_item(A.in[I_WCV1], CMPK, CMPH, CMPH / 32, (bf16*)(ws + WS_WCV1), scr, r, F.lane); continue; } r -= I_C1;
        if (r < I_C2) { p0_transpose_item(A.in[I_WCK2], CMPH, DH, DH / 32, (bf16*)(ws + WS_SMALL + SM_WCK2), scr, r, F.lane); continue; } r -= I_C2;
        p0_transpose_item(A.in[I_WCV2], CMPH, DH, DH / 32, (bf16*)(ws + WS_SMALL + SM_WCV2), scr, r, F.lane);
    }
    { const int gt = gw * 64 + F.lane; if (gt < 256 * 16) { const int n = gt >> 4, k = gt & 15; ((bf16*)(ws + WS_SMALL + SM_WA2))[gt] = (bf16)f2bf(A.in[I_WA2][k * 256 + n]); } }
    { const int w2 = NGW - 1 - gw; if (w2 >= 0 && w2 < 512) { const int which = w2 >> 8, hcol = w2 & 255; const float* W1 = A.in[which ? I_WCV1 : I_WCK1]; const float* pos = A.in[I_POS];
        float s = 0.f;
        for (int k = F.lane; k < CMPK; k += 64) s += pos[k] * W1[(size_t)k * CMPH + hcol];
        s = wave_sum(s);
        if (F.lane == 0) ((float*)(ws + WS_SMALL + (which ? SM_CB1V : SM_CB1K)))[hcol] = s + A.in[which ? I_BCV1 : I_BCK1][hcol]; } }
    for (int m = gw; m < M; m += NGW) ln0_row(A.in[I_X] + (size_t)m * DM, A.in[I_LN0G], A.in[I_LN0B], (bf16*)(ws + WS_XN) + (size_t)m * DM, (float*)(ws + WS_STATS) + 2 * m, F.lane);
    { const f32x4* ps = (const f32x4*)A.in[I_P]; v2u* pd = (v2u*)(ws + WS_PB); const size_t n4 = (size_t)M * PLE / 4;
      for (size_t i = (size_t)gw * 64 + F.lane; i < n4; i += (size_t)NGW * 64) { const f32x4 v = ps[i]; v2u o; o.x = pk2(v.x, v.y); o.y = pk2(v.z, v.w); pd[i] = o; } }
}
__device__ __forceinline__ void final_ln(Frame& F, const float* g, const float* b) {
    const int gw = F.vcu * NWAVES + F.wave, NGW = F.G * NWAVES; const int lane = F.lane;
    for (int m = gw; m < M; m += NGW) {
        f32x4* xr = (f32x4*)(F.out + (size_t)m * DM) + lane;
        f32x4 v[4]; float s = 0.f;
#pragma unroll
        for (int j = 0; j < 4; ++j) { v[j] = xr[64 * j]; s += (v[j].x + v[j].y) + (v[j].z + v[j].w); }
        const float mean = wave_sum(s) * (1.f / DM); float s2 = 0.f;
#pragma unroll
        for (int j = 0; j < 4; ++j) { v[j] = v[j] - mean; s2 += (v[j].x * v[j].x + v[j].y * v[j].y) + (v[j].z * v[j].z + v[j].w * v[j].w); }
        const float rstd = 1.f / sqrtf(wave_sum(s2) * (1.f / DM) + LN_EPS);
#pragma unroll
        for (int j = 0; j < 4; ++j) { const f32x4 gg = ((const f32x4*)g)[lane + 64 * j], bb = ((const f32x4*)b)[lane + 64 * j]; xr[64 * j] = v[j] * rstd * gg + bb; }
    }
}
typedef short v4i16_t __attribute__((ext_vector_type(4)));
#define MFMA32(a, b, c) __builtin_amdgcn_mfma_f32_32x32x16_bf16(a, b, c, 0, 0, 0)
__device__ __forceinline__ int crow(int r, int hi) { return (r & 3) + 8 * (r >> 2) + 4 * hi; }
__device__ __forceinline__ unsigned cvtpk(float lo, float hi) { typedef float f2_t __attribute__((ext_vector_type(2))); typedef __bf16 b2_t __attribute__((ext_vector_type(2)));
    f2_t v = {lo, hi}; b2_t b = __builtin_convertvector(v, b2_t); return __builtin_bit_cast(unsigned, b); }
__device__ __forceinline__ bf16x8 pack8(float a0, float a1, float a2, float a3, float a4, float a5, float a6, float a7) {
    v4u w; w.x = cvtpk(a0, a1); w.y = cvtpk(a2, a3); w.z = cvtpk(a4, a5); w.w = cvtpk(a6, a7); return __builtin_bit_cast(bf16x8, w); }
__device__ __forceinline__ bf16x8 pack8r(const f32x16& p, int base) { return pack8(p[base], p[base + 1], p[base + 2], p[base + 3], p[base + 4], p[base + 5], p[base + 6], p[base + 7]); }
__device__ __forceinline__ v4i16_t vtr(const LAS unsigned char* p) { return __builtin_amdgcn_ds_read_tr16_b64_v4i16((LAS v4i16_t*)p); }
__device__ __forceinline__ float swap_lo(float v, float& hiv) { auto rr = __builtin_amdgcn_permlane32_swap(__float_as_uint(v), __float_as_uint(v), false, false); hiv = __uint_as_float(rr[1]); return __uint_as_float(rr[0]); }
__device__ __forceinline__ float fexp(float v) { return __builtin_amdgcn_exp2f(v * LOG2E); }
__device__ __forceinline__ void stage_tr_image(const bf16* src, int pitch, LAS unsigned char* img, int lane_in) {
    int lane = lane_in; asm volatile("" : "+v"(lane));
    const bf16* sp = src + (size_t)(lane >> 3) * pitch + (lane & 7) * 8;
    LAS unsigned char* dp = img + ((lane & 7) >> 2) * 4096 + (lane >> 3) * 64 + (lane & 3) * 16;
    v4u val[8];
#pragma unroll
    for (int i = 0; i < 8; ++i) { val[i] = *(const v4u*)sp; sp += (size_t)8 * pitch; }
#pragma unroll
    for (int i = 0; i < 8; ++i) *(LAS v4u*)(dp + i * 512) = val[i];
}
__device__ __forceinline__ bf16x8 tr_frag(const LAS unsigned char* img, int ch32, int ks, int lane) {
    const int hi = lane >> 5;
    const LAS unsigned char* p = img + ch32 * 4096 + ks * 1024 + ((lane >> 4) & 1) * 32 + (lane & 3) * 8 + (4 * hi + ((lane & 15) >> 2)) * 64;
    const v4i16_t lo = vtr(p), hv = vtr(p + 512);
    return (bf16x8){lo[0], lo[1], lo[2], lo[3], hv[0], hv[1], hv[2], hv[3]};
}
__device__ __forceinline__ void gla_pass_a(Frame& F, const float* b_a, int cid, LAS unsigned char* wl) {
    int lane_ = F.lane; asm volatile("" : "+v"(lane_));
    const int lane = lane_, r32 = lane & 31, hi = lane >> 5;
    const int bh = cid >> 7, n = cid & 127, b = bh >> 2, h = bh & 3;
    const size_t T0 = (size_t)b * SEQ + (size_t)n * GCH;
    const bf16* U = (const bf16*)(F.ws + WS_U);
    const bf16* wa2t = (const bf16*)(F.ws + WS_SMALL + SM_WA2);
    LAS unsigned char* kimg = wl; LAS unsigned char* vimg = wl + 8192;
    stage_tr_image(U + T0 * DINP + C_KG + h * 64, DINP, kimg, lane);
    asm volatile("" ::: "memory");
    f32x16 bC[2][2];
    {
        bf16x8 af[2], wf[2];
#pragma unroll
        for (int ct = 0; ct < 2; ++ct) af[ct] = *(const bf16x8*)(U + (T0 + 32 * ct + r32) * DINP + C_AL + 8 * hi);
#pragma unroll
        for (int dt = 0; dt < 2; ++dt) wf[dt] = *(const bf16x8*)(wa2t + (h * 64 + 32 * dt + r32) * 16 + 8 * hi);
        const f32x16 z16 = {};
#pragma unroll
        for (int ct = 0; ct < 2; ++ct)
#pragma unroll
            for (int dt = 0; dt < 2; ++dt) bC[ct][dt] = MFMA32(af[ct], wf[dt], z16);
#pragma unroll
        for (int dt = 0; dt < 2; ++dt) { const float ba = b_a[h * 64 + 32 * dt + r32];
#pragma unroll
            for (int ct = 0; ct < 2; ++ct)
#pragma unroll
                for (int r = 0; r < 16; ++r) { const float xv = bC[ct][dt][r] + ba;
                    const float ls = fminf(xv, 0.f) - __logf(1.0f + fexp(-fabsf(xv)));
                    bC[ct][dt][r] = ls * (1.0f / 16.0f); } }
    }
    asm volatile("" ::: "memory");
    f32x16 bT[2][2];
    {
#pragma unroll
        for (int ct = 0; ct < 2; ++ct) {
            f32x16 acc0 = {}, acc1 = {};
#pragma unroll
            for (int ks = 0; ks < 4; ++ks) { if (ct == 0 && ks >= 2) continue;
                v4u tw;
                { unsigned e[8];
#pragma unroll
                  for (int j = 0; j < 8; ++j) { const int cp = 16 * ks + 8 * (j >> 2) + 4 * hi + (j & 3); e[j] = (cp <= 32 * ct + r32) ? 0x3F80u : 0u; }
                  tw.x = e[0] | (e[1] << 16); tw.y = e[2] | (e[3] << 16); tw.z = e[4] | (e[5] << 16); tw.w = e[6] | (e[7] << 16); }
                const bf16x8 LT = __builtin_bit_cast(bf16x8, tw);
#pragma unroll
                for (int dt = 0; dt < 2; ++dt) { const f32x16& x = bC[ks >> 1][dt]; const int base = 8 * (ks & 1);
                    float hv[8], lv[8];
#pragma unroll
                    for (int j = 0; j < 8; ++j) { hv[j] = __uint_as_float(f2bf(x[base + j]) << 16); lv[j] = x[base + j] - hv[j]; }
                    const bf16x8 ah = pack8(hv[0], hv[1], hv[2], hv[3], hv[4], hv[5], hv[6], hv[7]);
                    const bf16x8 al = pack8(lv[0], lv[1], lv[2], lv[3], lv[4], lv[5], lv[6], lv[7]);
                    if (dt == 0) { acc0 = MFMA32(ah, LT, acc0); acc0 = MFMA32(al, LT, acc0); } else { acc1 = MFMA32(ah, LT, acc1); acc1 = MFMA32(al, LT, acc1); } }
            }
            bT[0][ct] = acc0; bT[1][ct] = acc1;
        }
    }
    asm volatile("" ::: "memory");
    float blast[2];
#pragma unroll
    for (int dt = 0; dt < 2; ++dt) { float run = 0.f;
#pragma unroll
        for (int ct = 0; ct < 2; ++ct)
#pragma unroll
            for (int a = 0; a < 4; ++a) { f32x16& x = bC[ct][dt];
                const float g0 = x[4 * a], g1 = g0 + x[4 * a + 1], g2 = g1 + x[4 * a + 2], g3 = g2 + x[4 * a + 3];
                float t1; const float t0 = swap_lo(g3, t1);
                const float off = run + (hi ? t0 : 0.f);
                x[4 * a] = off + g0; x[4 * a + 1] = off + g1; x[4 * a + 2] = off + g2; x[4 * a + 3] = off + g3;
                run += t0 + t1; }
        blast[dt] = run; }
    asm volatile("" ::: "memory");
    bf16x8 kl[2][4];
#pragma unroll
    for (int dt = 0; dt < 2; ++dt)
#pragma unroll
        for (int ks = 0; ks < 4; ++ks) { const bf16x8 kf = tr_frag(kimg, dt, ks, lane); float o8[8];
#pragma unroll
            for (int j = 0; j < 8; ++j) o8[j] = __uint_as_float(((unsigned)(unsigned short)kf[j]) << 16) * fexp(blast[dt] - bC[ks >> 1][dt][8 * (ks & 1) + j]);
            kl[dt][ks] = pack8(o8[0], o8[1], o8[2], o8[3], o8[4], o8[5], o8[6], o8[7]); }
    if (hi == 0) { float* dec = (float*)(F.ws + WS_DEC) + (size_t)cid * 64; dec[r32] = fexp(blast[0]); dec[32 + r32] = fexp(blast[1]); }
    asm volatile("" ::: "memory");
    bf16x8 qe[2][4], ke[2][4];
    bf16* QE = (bf16*)(F.ws + WS_QE) + (size_t)cid * 4096;
#pragma unroll
    for (int ct = 0; ct < 2; ++ct) { const bf16* rowp = U + (T0 + 32 * ct + r32) * DINP;
#pragma unroll
        for (int ds = 0; ds < 4; ++ds) {
            const v2u q0 = *(const v2u*)(rowp + C_QG + h * 64 + 16 * ds + 4 * hi), q1 = *(const v2u*)(rowp + C_QG + h * 64 + 16 * ds + 8 + 4 * hi);
            const v2u k0 = *(const v2u*)(rowp + C_KG + h * 64 + 16 * ds + 4 * hi), k1 = *(const v2u*)(rowp + C_KG + h * 64 + 16 * ds + 8 + 4 * hi);
            const float qv[8] = {bflo(q0.x), bfhi(q0.x), bflo(q0.y), bfhi(q0.y), bflo(q1.x), bfhi(q1.x), bflo(q1.y), bfhi(q1.y)};
            const float kv_[8] = {bflo(k0.x), bfhi(k0.x), bflo(k0.y), bfhi(k0.y), bflo(k1.x), bfhi(k1.x), bflo(k1.y), bfhi(k1.y)};
            float qo[8], ko[8];
#pragma unroll
            for (int j = 0; j < 8; ++j) { const float e = bT[ds >> 1][ct][8 * (ds & 1) + j]; qo[j] = qv[j] * 0.125f * fexp(e); ko[j] = kv_[j] * fexp(-e); }
            qe[ct][ds] = pack8(qo[0], qo[1], qo[2], qo[3], qo[4], qo[5], qo[6], qo[7]);
            ke[ct][ds] = pack8(ko[0], ko[1], ko[2], ko[3], ko[4], ko[5], ko[6], ko[7]);
            *(bf16x8*)(QE + ((ct * 4 + ds) * 64 + lane) * 8) = qe[ct][ds];
            if (ds & 1) asm volatile("" ::: "memory");
        } }
    asm volatile("" ::: "memory");
    bf16x8 at0[2], at1[4];
    {
        f32x16 a00 = {}, a01 = {}, a11 = {};
#pragma unroll
        for (int ds = 0; ds < 4; ++ds) { a00 = MFMA32(ke[0][ds], qe[0][ds], a00); a01 = MFMA32(ke[0][ds], qe[1][ds], a01); a11 = MFMA32(ke[1][ds], qe[1][ds], a11); }
#pragma unroll
        for (int r = 0; r < 16; ++r) { const bool keep = crow(r, hi) <= r32; a00[r] = keep ? a00[r] : 0.f; a11[r] = keep ? a11[r] : 0.f; }
        at0[0] = pack8r(a00, 0); at0[1] = pack8r(a00, 8);
        at1[0] = pack8r(a01, 0); at1[1] = pack8r(a01, 8); at1[2] = pack8r(a11, 0); at1[3] = pack8r(a11, 8);
    }
    asm volatile("" ::: "memory");
    bf16* KVF = (bf16*)(F.ws + WS_KV) + (size_t)cid * 8192;
    bf16* OI = (bf16*)(F.ws + WS_OI) + (size_t)cid * 8192;
#pragma unroll
    for (int vh = 0; vh < 2; ++vh) {
        stage_tr_image(U + T0 * DINP + C_VG + h * 128 + vh * 64, DINP, vimg, lane);
#pragma unroll
        for (int v2 = 0; v2 < 2; ++v2) { const int vt = 2 * vh + v2;
            bf16x8 vf[4];
#pragma unroll
            for (int ks = 0; ks < 4; ++ks) vf[ks] = tr_frag(vimg, v2, ks, lane);
            f32x16 o0 = {}, o1 = {};
#pragma unroll
            for (int ks = 0; ks < 4; ++ks) { if (ks < 2) o0 = MFMA32(vf[ks], at0[ks], o0); o1 = MFMA32(vf[ks], at1[ks], o1); }
            { v4u w0, w1;
              w0.x = cvtpk(o0[0], o0[1]); w0.y = cvtpk(o0[2], o0[3]); w0.z = cvtpk(o0[4], o0[5]); w0.w = cvtpk(o0[6], o0[7]);
              w1.x = cvtpk(o0[8], o0[9]); w1.y = cvtpk(o0[10], o0[11]); w1.z = cvtpk(o0[12], o0[13]); w1.w = cvtpk(o0[14], o0[15]);
              v4u* d0 = (v4u*)(OI + ((vt * 2 + 0) * 64 + lane) * 16); d0[0] = w0; d0[1] = w1;
              w0.x = cvtpk(o1[0], o1[1]); w0.y = cvtpk(o1[2], o1[3]); w0.z = cvtpk(o1[4], o1[5]); w0.w = cvtpk(o1[6], o1[7]);
              w1.x = cvtpk(o1[8], o1[9]); w1.y = cvtpk(o1[10], o1[11]); w1.z = cvtpk(o1[12], o1[13]); w1.w = cvtpk(o1[14], o1[15]);
              v4u* d1 = (v4u*)(OI + ((vt * 2 + 1) * 64 + lane) * 16); d1[0] = w0; d1[1] = w1; }
            f32x16 kv0 = {}, kv1 = {};
#pragma unroll
            for (int ks = 0; ks < 4; ++ks) { kv0 = MFMA32(kl[0][ks], vf[ks], kv0); kv1 = MFMA32(kl[1][ks], vf[ks], kv1); }
            { v4u w0, w1;
              w0.x = cvtpk(kv0[0], kv0[1]); w0.y = cvtpk(kv0[2], kv0[3]); w0.z = cvtpk(kv0[4], kv0[5]); w0.w = cvtpk(kv0[6], kv0[7]);
              w1.x = cvtpk(kv0[8], kv0[9]); w1.y = cvtpk(kv0[10], kv0[11]); w1.z = cvtpk(kv0[12], kv0[13]); w1.w = cvtpk(kv0[14], kv0[15]);
              v4u* d0 = (v4u*)(KVF + ((vt * 2 + 0) * 64 + lane) * 16); d0[0] = w0; d0[1] = w1;
              w0.x = cvtpk(kv1[0], kv1[1]); w0.y = cvtpk(kv1[2], kv1[3]); w0.z = cvtpk(kv1[4], kv1[5]); w0.w = cvtpk(kv1[6], kv1[7]);
              w1.x = cvtpk(kv1[8], kv1[9]); w1.y = cvtpk(kv1[10], kv1[11]); w1.z = cvtpk(kv1[12], kv1[13]); w1.w = cvtpk(kv1[14], kv1[15]);
              v4u* d1 = (v4u*)(KVF + ((vt * 2 + 1) * 64 + lane) * 16); d1[0] = w0; d1[1] = w1; }
        }
    }
}
struct ScanLoads { bf16x8 qf[4]; v4u k0a, k0b, k1a, k1b; v4u oi0, oi1; v2u zz[4]; };
__device__ __forceinline__ void scan_load(ScanLoads& L, const unsigned char* ws, int cid, size_t tok, int h, int ct, int vt, int lane, int hi) {
    const bf16* QE = (const bf16*)(ws + WS_QE) + (size_t)cid * 4096;
    const bf16* KVF = (const bf16*)(ws + WS_KV) + (size_t)cid * 8192;
    const bf16* OI = (const bf16*)(ws + WS_OI) + (size_t)cid * 8192;
    const bf16* U = (const bf16*)(ws + WS_U);
#pragma unroll
    for (int ds = 0; ds < 4; ++ds) L.qf[ds] = *(const bf16x8*)(QE + ((ct * 4 + ds) * 64 + lane) * 8);
    { const v4u* p0 = (const v4u*)(KVF + ((vt * 2 + 0) * 64 + lane) * 16); const v4u* p1 = (const v4u*)(KVF + ((vt * 2 + 1) * 64 + lane) * 16);
      L.k0a = p0[0]; L.k0b = p0[1]; L.k1a = p1[0]; L.k1b = p1[1]; }
    L.oi0 = *(const v4u*)(OI + ((vt * 2 + ct) * 64 + lane) * 16); L.oi1 = *(const v4u*)(OI + ((vt * 2 + ct) * 64 + lane) * 16 + 8);
#pragma unroll
    for (int a = 0; a < 4; ++a) L.zz[a] = *(const v2u*)(U + tok * DINP + C_ZG + h * 128 + 32 * vt + 8 * a + 4 * hi);
}
__device__ __forceinline__ void scan_step(const ScanLoads& L, f32x16& S0, f32x16& S1, const LAS float* gnl, LAS float* part, const LAS float* decb, bf16* MIX, size_t tok, int n, int h, int ct, int vt, int r32, int hi) {
    f32x16 o = {};
    o = MFMA32(pack8r(S0, 0), L.qf[0], o); o = MFMA32(pack8r(S0, 8), L.qf[1], o); o = MFMA32(pack8r(S1, 0), L.qf[2], o); o = MFMA32(pack8r(S1, 8), L.qf[3], o);
    const unsigned oiw[8] = {L.oi0.x, L.oi0.y, L.oi0.z, L.oi0.w, L.oi1.x, L.oi1.y, L.oi1.z, L.oi1.w};
    float ss = 0.f;
#pragma unroll
    for (int r = 0; r < 16; ++r) { const float add = (r & 1) ? bfhi(oiw[r >> 1]) : bflo(oiw[r >> 1]); o[r] += add; ss += o[r] * o[r]; }
    { const unsigned k0w[8] = {L.k0a.x, L.k0a.y, L.k0a.z, L.k0a.w, L.k0b.x, L.k0b.y, L.k0b.z, L.k0b.w}, k1w[8] = {L.k1a.x, L.k1a.y, L.k1a.z, L.k1a.w, L.k1b.x, L.k1b.y, L.k1b.z, L.k1b.w};
#pragma unroll
      for (int a = 0; a < 4; ++a) { const f32x4 x0 = *(const LAS f32x4*)(decb + 8 * a + 4 * hi), x1 = *(const LAS f32x4*)(decb + 32 + 8 * a + 4 * hi);
        S0[4 * a] = x0.x * S0[4 * a] + bflo(k0w[2 * a]); S0[4 * a + 1] = x0.y * S0[4 * a + 1] + bfhi(k0w[2 * a]); S0[4 * a + 2] = x0.z * S0[4 * a + 2] + bflo(k0w[2 * a + 1]); S0[4 * a + 3] = x0.w * S0[4 * a + 3] + bfhi(k0w[2 * a + 1]);
        S1[4 * a] = x1.x * S1[4 * a] + bflo(k1w[2 * a]); S1[4 * a + 1] = x1.y * S1[4 * a + 1] + bfhi(k1w[2 * a]); S1[4 * a + 2] = x1.z * S1[4 * a + 2] + bflo(k1w[2 * a + 1]); S1[4 * a + 3] = x1.w * S1[4 * a + 3] + bfhi(k1w[2 * a + 1]); } }
    { float t1; const float t0 = swap_lo(ss, t1); ss = t0 + t1; }
    LAS float* pb = part + (n & 1) * 256;
    if (hi == 0) pb[vt * 64 + 32 * ct + r32] = ss;
    __syncthreads();
    const float tot = (pb[32 * ct + r32] + pb[64 + 32 * ct + r32]) + (pb[128 + 32 * ct + r32] + pb[192 + 32 * ct + r32]);
    const float rstd = 1.0f / sqrtf(tot * (1.0f / GDV) + LN_EPS);
#pragma unroll
    for (int a = 0; a < 4; ++a) { const float z0 = bflo(L.zz[a].x), z1 = bfhi(L.zz[a].x), z2 = bflo(L.zz[a].y), z3 = bfhi(L.zz[a].y); const f32x4 gna = *(const LAS f32x4*)(gnl + 32 * vt + 8 * a + 4 * hi);
        const float y0 = o[4 * a] * rstd * gna.x * z0 * sigmoidf2(z0), y1 = o[4 * a + 1] * rstd * gna.y * z1 * sigmoidf2(z1);
        const float y2 = o[4 * a + 2] * rstd * gna.z * z2 * sigmoidf2(z2), y3 = o[4 * a + 3] * rstd * gna.w * z3 * sigmoidf2(z3);
        v2u ov; ov.x = cvtpk(y0, y1); ov.y = cvtpk(y2, y3);
        *(v2u*)(MIX + tok * DM + 512 + h * 128 + 32 * vt + 8 * a + 4 * hi) = ov; }
}
__device__ __forceinline__ void gla_scan_unit(Frame& F, const float* gnw, int bh, LAS float* part) {
    const int lane = F.lane, r32 = lane & 31, hi = lane >> 5, w = F.wave, ct = w & 1, vt = w >> 1;
    const int b = bh >> 2, h = bh & 3;
    bf16* MIX = (bf16*)(F.ws + WS_MIX);
    LAS float* decb = part + 512;
    const float* DEC = (const float*)(F.ws + WS_DEC) + (size_t)bh * NCHUNK * 64;
    f32x16 S0 = {}, S1 = {};
    LAS float* gnl = part + 640;
    if (w == 1) { gnl[lane] = gnw[lane]; gnl[64 + lane] = gnw[64 + lane]; }
    const size_t tokb = (size_t)b * SEQ + 32 * ct + r32;
    ScanLoads LA, LB;
    scan_load(LA, F.ws, bh * NCHUNK, tokb, h, ct, vt, lane, hi);
    if (w == 0) decb[lane] = DEC[lane];
    __syncthreads();
    for (int n = 0; n < NCHUNK; n += 2) {
        scan_load(LB, F.ws, bh * NCHUNK + n + 1, tokb + (size_t)(n + 1) * GCH, h, ct, vt, lane, hi);
        if (w == 0) decb[64 + lane] = DEC[(n + 1) * 64 + lane];
        scan_step(LA, S0, S1, gnl, part, decb, MIX, tokb + (size_t)n * GCH, n, h, ct, vt, r32, hi);
        if (n + 2 < NCHUNK) { scan_load(LA, F.ws, bh * NCHUNK + n + 2, tokb + (size_t)(n + 2) * GCH, h, ct, vt, lane, hi); if (w == 0) decb[lane] = DEC[(n + 2) * 64 + lane]; }
        scan_step(LB, S0, S1, gnl, part, decb + 64, MIX, tokb + (size_t)(n + 1) * GCH, n + 1, h, ct, vt, r32, hi);
    }
    __syncthreads();
}
constexpr int L_KV = 0;
constexpr int L_TB = 32768;
constexpr int L_WSF = 36864;
constexpr int L_SELM = 38912;
constexpr int L_MREF = 39936;
constexpr int L_LACC = 40960;
constexpr int L_CNT = 41984;
constexpr int L_ITEMS = 43520;
constexpr int L_TOKL = 44032;
constexpr int L_SL2 = 52224;
constexpr int L_OACC = 84992;
constexpr int L_IMP = L_OACC;
constexpr int L_MAIL = L_OACC;
constexpr int L_MAILL = L_MAIL + 32768;
constexpr int L_WHERE = L_MAILL + 1024;
constexpr int L_Q2 = 119808;
constexpr int L_RTAB = L_ITEMS;
constexpr int IMP_LD = 129;
constexpr float NEGBIG = -1e30f;
constexpr float C2S = 0.125f * LOG2E;
constexpr float THR_RESC = 8.0f;

__device__ __forceinline__ int t5_bucket(int n) {
    if (n < 16) return n;
    const int th[15] = {19, 21, 24, 27, 31, 35, 40, 46, 52, 59, 67, 77, 87, 99, 113};
    int b = 16;
#pragma unroll
    for (int i = 0; i < 15; ++i) b += (n >= th[i]) ? 1 : 0;
    return b;
}
__device__ __forceinline__ void build_bias_table(Frame& F, const float* rel_bias) {
    LAS float* tb = (LAS float*)(F.lds + L_TB);
    for (int i = F.tid; i < 8 * 128; i += NWAVES * 64) { const int hd = i >> 7, n = i & 127; tb[i] = rel_bias[t5_bucket(n) * 8 + hd] * LOG2E; }
}
struct KVRegs { v4u k, v; };
__device__ __forceinline__ KVRegs kv_load(const bf16* Kb, const bf16* Vb, size_t pitch, int row0, int w, int lane) {
    KVRegs r; const size_t off = (size_t)(row0 + 8 * w + (lane >> 3)) * pitch + (lane & 7) * 8;
    r.k = *(const v4u*)(Kb + off); r.v = *(const v4u*)(Vb + off);
    return r;
}
__device__ __forceinline__ void kv_store(LAS unsigned char* slot, const KVRegs& r, int tid) {
    const int row = tid >> 3, c = tid & 7;
    *(LAS v4u*)(slot + row * 128 + ((c ^ (row & 7)) << 4)) = r.k;
    *(LAS v4u*)(slot + 8192 + (c >> 2) * 4096 + row * 64 + (c & 3) * 16) = r.v;
}
struct SmState { float mhat, lsum; f32x16 o0, o1; };
__device__ __forceinline__ void qk_tile(const LAS unsigned char* kslot, const bf16x8 (&qr)[4], f32x16& p0, f32x16& p1, int r32, int hi) {
    const LAS unsigned char* kp = kslot + r32 * 128; const int sw = r32 & 7;
    p0 = (f32x16){}; p1 = (f32x16){};
#pragma unroll
    for (int d0 = 0; d0 < 4; ++d0) { const int co = ((2 * d0 + hi) ^ sw) << 4;
        const bf16x8 k0 = *(const LAS bf16x8*)(kp + co), k1 = *(const LAS bf16x8*)(kp + 4096 + co);
        p0 = MFMA32(k0, qr[d0], p0); p1 = MFMA32(k1, qr[d0], p1); }
}
__device__ __forceinline__ float rowmax32(const f32x16& p0, const f32x16& p1) {
    float a = fmaxf(p0[0], p1[0]);
#pragma unroll
    for (int r = 1; r < 16; ++r) a = fmaxf(a, fmaxf(p0[r], p1[r]));
    float t1; const float t0 = swap_lo(a, t1); return fmaxf(t0, t1);
}
__device__ __forceinline__ void pv_tail(SmState& st, const f32x16& p0, const f32x16& p1, const LAS unsigned char* vslot, int lane) {
    const bf16x8 pa0 = pack8r(p0, 0), pa1 = pack8r(p0, 8), pa2 = pack8r(p1, 0), pa3 = pack8r(p1, 8);
#pragma unroll
    for (int d0 = 0; d0 < 2; ++d0) {
        const bf16x8 v0 = tr_frag(vslot, d0, 0, lane), v1 = tr_frag(vslot, d0, 1, lane), v2 = tr_frag(vslot, d0, 2, lane), v3 = tr_frag(vslot, d0, 3, lane);
        f32x16 o = d0 ? st.o1 : st.o0;
        o = MFMA32(pa0, v0, o); o = MFMA32(pa1, v1, o); o = MFMA32(pa2, v2, o); o = MFMA32(pa3, v3, o);
        if (d0) st.o1 = o; else st.o0 = o;
    }
}
__device__ __forceinline__ void softmax_pv(SmState& st, f32x16& p0, f32x16& p1, const LAS unsigned char* vslot, LAS float* wsf, int lane, int r32, int hi) {
    const float rm = rowmax32(p0, p1);
    if (__any(rm > st.mhat + THR_RESC)) {
        const float mnew = fmaxf(st.mhat, rm); const float f = __builtin_amdgcn_exp2f(st.mhat - mnew);
        st.lsum *= f; st.mhat = mnew;
        if (hi == 0) wsf[r32] = f;
        LDS_WAIT();
#pragma unroll
        for (int r = 0; r < 16; ++r) { const float fr = wsf[crow(r, hi)]; st.o0[r] *= fr; st.o1[r] *= fr; }
    }
    float s = 0.f;
#pragma unroll
    for (int r = 0; r < 16; ++r) { p0[r] = __builtin_amdgcn_exp2f(p0[r] - st.mhat); p1[r] = __builtin_amdgcn_exp2f(p1[r] - st.mhat); s += p0[r] + p1[r]; }
    st.lsum += s;
    pv_tail(st, p0, p1, vslot, lane);
}
__device__ __forceinline__ void softmax_pv_fast(SmState& st, f32x16& p0, f32x16& p1, float sc, float bias, const LAS unsigned char* vslot, LAS float* wsf, int lane, int r32, int hi) {
    const float rm = __builtin_fmaf(rowmax32(p0, p1), sc, bias);
    if (__any(rm > st.mhat + THR_RESC)) {
        const float mnew = fmaxf(st.mhat, rm); const float f = __builtin_amdgcn_exp2f(st.mhat - mnew);
        st.lsum *= f; st.mhat = mnew;
        if (hi == 0) wsf[r32] = f;
        LDS_WAIT();
#pragma unroll
        for (int r = 0; r < 16; ++r) { const float fr = wsf[crow(r, hi)]; st.o0[r] *= fr; st.o1[r] *= fr; }
    }
    const float nb = bias - st.mhat; float s = 0.f;
#pragma unroll
    for (int r = 0; r < 16; ++r) { p0[r] = __builtin_amdgcn_exp2f(__builtin_fmaf(p0[r], sc, nb)); p1[r] = __builtin_amdgcn_exp2f(__builtin_fmaf(p1[r], sc, nb)); s += p0[r] + p1[r]; }
    st.lsum += s;
    pv_tail(st, p0, p1, vslot, lane);
}
__device__ __forceinline__ void stage_tile(LAS bf16* stg, const f32x16& a0, const f32x16& a1, int r32, int hi) {
#pragma unroll
    for (int r = 0; r < 16; ++r) { stg[crow(r, hi) * 64 + r32] = (bf16)f2bf(a0[r]); stg[crow(r, hi) * 64 + 32 + r32] = (bf16)f2bf(a1[r]); }
}
__device__ __forceinline__ void finish_rows(SmState& st, LAS float* wsf, int r32, int hi, bool zero_row) {
    float t1; const float t0 = swap_lo(st.lsum, t1); const float l = t0 + t1;
    if (hi == 0) wsf[32 + r32] = zero_row ? 0.f : __builtin_amdgcn_rcpf(l);
    LDS_WAIT();
#pragma unroll
    for (int r = 0; r < 16; ++r) { const float il = wsf[32 + crow(r, hi)]; st.o0[r] *= il; st.o1[r] *= il; }
}
__device__ __forceinline__ void load_q(bf16x8 (&qr)[4], const bf16* U, size_t tok0, int g, int w, int r32, int hi) {
    const bf16* qp = U + (tok0 + 8 * w + (r32 >> 2)) * DINP + C_QN + (4 * g + (r32 & 3)) * 64 + 8 * hi;
#pragma unroll
    for (int d0 = 0; d0 < 4; ++d0) qr[d0] = *(const bf16x8*)(qp + 16 * d0);
}
template <bool NEAR>
__device__ __forceinline__ void bias_mask(f32x16& p0, f32x16& p1, const LAS float* tbh, int dist0, int kstep, int loD, int hiD, bool rowok, int hi) {
    const float cfar = tbh[127];
#pragma unroll
    for (int r = 0; r < 16; ++r) {
        const int k0 = crow(r, hi), k1 = k0 + 32;
        const int dA = dist0 - kstep * k0, dB = dist0 - kstep * k1;
        float bA, bB;
        if (NEAR) { bA = tbh[min(max(dA, 0), 127)]; bB = tbh[min(max(dB, 0), 127)]; } else { bA = cfar; bB = cfar; }
        const bool vA = rowok && dA >= loD && dA < hiD, vB = rowok && dB >= loD && dB < hiD;
        p0[r] = vA ? __builtin_fmaf(p0[r], C2S, bA) : NEGBIG;
        p1[r] = vB ? __builtin_fmaf(p1[r], C2S, bB) : NEGBIG;
    }
}
__device__ __forceinline__ void window_unit(Frame& F, int unit) {
    int tid_ = F.tid; asm volatile("" : "+v"(tid_));
    const int tid = tid_, lane = tid & 63, r32 = lane & 31, hi = lane >> 5, w = F.wave;
    const int bg = unit >> 7, i = unit & 127, b = bg >> 1, g = bg & 1;
    const bf16* U = (const bf16*)(F.ws + WS_U);
    const size_t tok0 = (size_t)b * SEQ + (size_t)i * 64;
    const bf16* Kb = U + (size_t)b * SEQ * DINP + C_KW + g * 64; const bf16* Vb = U + (size_t)b * SEQ * DINP + C_VW + g * 64;
    LAS unsigned char* kv = F.lds + L_KV; LAS float* wsf = (LAS float*)(F.lds + L_WSF) + w * 64;
    const LAS float* tbh = (const LAS float*)(F.lds + L_TB) + (4 * g + (r32 & 3)) * 128;
    bf16x8 qr[4]; load_q(qr, U, tok0, g, w, r32, hi);
    SmState st; st.mhat = NEGBIG; st.lsum = 0.f; st.o0 = (f32x16){}; st.o1 = (f32x16){};
    const int tql = 8 * w + (r32 >> 2);
    const int nb = (i < 8 ? i : 8) + 1;
    { const KVRegs r0 = kv_load(Kb, Vb, DINP, i * 64, w, lane); kv_store(kv, r0, tid); }
    __syncthreads();
    for (int s = 0; s < nb; ++s) {
        const int blk = i - s; LAS unsigned char* slot = kv + (s & 1) * 16384;
        KVRegs nx; if (s + 1 < nb) nx = kv_load(Kb, Vb, DINP, (blk - 1) * 64, w, lane);
        f32x16 p0, p1; qk_tile(slot, qr, p0, p1, r32, hi);
        const int dist0 = 64 * s + tql;
        if (s <= 2) { bias_mask<true>(p0, p1, tbh, dist0, 1, 0, 512, true, hi); softmax_pv(st, p0, p1, slot + 8192, wsf, lane, r32, hi); }
        else if (s == 8) { bias_mask<false>(p0, p1, tbh, dist0, 1, 0, 512, true, hi); softmax_pv(st, p0, p1, slot + 8192, wsf, lane, r32, hi); }
        else softmax_pv_fast(st, p0, p1, C2S, tbh[127], slot + 8192, wsf, lane, r32, hi);
        if (s + 1 < nb) kv_store(kv + ((s + 1) & 1) * 16384, nx, tid);
        __syncthreads();
    }
    finish_rows(st, wsf, r32, hi, false);
    bf16* OW = (bf16*)(F.ws + WS_OW);
    LAS bf16* stg = (LAS bf16*)(F.lds + L_IMP) + w * 2048;
    stage_tile(stg, st.o0, st.o1, r32, hi);
    LDS_WAIT();
#pragma unroll
    for (int it = 0; it < 4; ++it) { const int row = it * 8 + (lane >> 3), ch = lane & 7;
        const v4u t = *(const LAS v4u*)(stg + row * 64 + ch * 8);
        *(v4u*)(OW + (tok0 + 8 * w + (row >> 2)) * 512 + (4 * g + (row & 3)) * 64 + ch * 8) = t; }
    LDS_WAIT();
}
constexpr int CA_ROWS = 528, L_CH = 69632, CH_LD = 264;
__device__ __forceinline__ float gelu_tanh(float x) { const float u = 0.7978845608028654f * (x + 0.044715f * x * x * x); const float e = __builtin_amdgcn_exp2f(2.0f * LOG2E * u); return x * (1.0f - __builtin_amdgcn_rcpf(e + 1.0f)); }
__device__ __forceinline__ void compress_unit(Frame& F, int unit) {
    int tid_ = F.tid; asm volatile("" : "+v"(tid_));
    const int tid = tid_, lane = tid & 63, r32 = lane & 31, hi = lane >> 5, w = F.wave;
    const int which = unit >> 8, bg = (unit >> 4) & 15, jb = unit & 15, b = bg >> 1, g = bg & 1;
    const bf16* U = (const bf16*)(F.ws + WS_U);
    const bf16* src = U + ((size_t)b * SEQ + 512 * jb) * DINP + (which ? C_VC : C_KC) + g * 64;
    const bf16* W1t = (const bf16*)(F.ws + (which ? WS_WCV1 : WS_WCK1));
    const bf16* W2t = (const bf16*)(F.ws + WS_SMALL + (which ? SM_WCV2 : SM_WCK2));
    const float* cb1 = (const float*)(F.ws + WS_SMALL + (which ? SM_CB1V : SM_CB1K));
    bf16* dst = (bf16*)(F.ws + (which ? WS_VC : WS_KC)) + ((size_t)bg * NCP + 32 * jb) * 64;
    LAS unsigned char* A = F.lds; LAS bf16* H = (LAS bf16*)(F.lds + L_CH);
    for (int p = tid; p < CA_ROWS * 8; p += NWAVES * 64) { const int t = p >> 3, ch = p & 7;
        const v4u val = *(const v4u*)(src + (size_t)t * DINP + ch * 8);
        *(LAS v4u*)(A + t * 128 + ((ch ^ ((t >> 4) & 7)) << 4)) = val; }
    __syncthreads();
    f32x16 acc = {};
    const bf16* wp = W1t + (size_t)(32 * w + r32) * CMPK + 8 * hi;
#pragma unroll 4
    for (int kk = 0; kk < 128; ++kk) { const int tok = kk >> 2, t = 16 * r32 + tok, ch = 2 * (kk & 3) + hi;
        const bf16x8 a = *(const LAS bf16x8*)(A + t * 128 + ((ch ^ ((t >> 4) & 7)) << 4));
        const bf16x8 bw = *(const bf16x8*)(wp + 16 * kk);
        acc = MFMA32(a, bw, acc); }
    { const float cb = cb1[32 * w + r32];
#pragma unroll
      for (int r = 0; r < 16; ++r) H[crow(r, hi) * CH_LD + 32 * w + r32] = (bf16)f2bf(gelu_tanh(acc[r] + cb)); }
    __syncthreads();
    if (w < 2) {
        f32x16 o = {};
        const bf16* w2p = W2t + (size_t)(32 * w + r32) * CMPH + 8 * hi;
#pragma unroll
        for (int kk = 0; kk < 16; ++kk) { const bf16x8 a = *(const LAS bf16x8*)(H + r32 * CH_LD + 16 * kk + 8 * hi); const bf16x8 bw = *(const bf16x8*)(w2p + 16 * kk); o = MFMA32(a, bw, o); }
#pragma unroll
        for (int r = 0; r < 16; ++r) dst[crow(r, hi) * 64 + 32 * w + r32] = (bf16)f2bf(o[r]);
    }
    __syncthreads();
}
#ifdef PROBE_SEC
#define TSTAMP(sec) do { if (unit == 127 && threadIdx.x == 0) { const unsigned long long t_ = __builtin_amdgcn_s_memtime(); atomicAdd((unsigned long long*)((unsigned*)F.ctl + 210000) + (sec), t_ - tprev_); tprev_ = t_; } } while (0)
#define TSTART() unsigned long long tprev_ = __builtin_amdgcn_s_memtime()
#else
#define TSTAMP(sec) do {} while (0)
#define TSTART() do {} while (0)
#endif
__device__ __forceinline__ void nsa_unit(Frame& F, int unit) {
    int tid_ = F.tid; asm volatile("" : "+v"(tid_));
    const int tid = tid_, lane = tid & 63, r32 = lane & 31, hi = lane >> 5, w = F.wave;
    const int bg = unit >> 7, i = unit & 127, b = bg >> 1, g = bg & 1;
    const bf16* U = (const bf16*)(F.ws + WS_U);
    const size_t tok0 = (size_t)b * SEQ + (size_t)i * 64;
    LAS unsigned char* kv = F.lds + L_KV; LAS float* wsf = (LAS float*)(F.lds + L_WSF) + w * 64;
    const LAS float* tbh = (const LAS float*)(F.lds + L_TB) + (4 * g + (r32 & 3)) * 128;
    LAS float* imp = (LAS float*)(F.lds + L_IMP); LAS unsigned* selm = (LAS unsigned*)(F.lds + L_SELM);
    TSTART();
    bf16x8 qr[4]; load_q(qr, U, tok0, g, w, r32, hi);
    const int tql = 8 * w + (r32 >> 2), tq = i * 64 + tql;
    const bf16* KCb = (const bf16*)(F.ws + WS_KC) + (size_t)bg * NCP * 64; const bf16* VCb = (const bf16*)(F.ws + WS_VC) + (size_t)bg * NCP * 64;
    const int ncv = 4 * i + 3, nct = (ncv + 63) >> 6;
    SmState st; st.mhat = NEGBIG; st.lsum = 0.f; st.o0 = (f32x16){}; st.o1 = (f32x16){};
    { const KVRegs r0 = kv_load(KCb, VCb, 64, 0, w, lane); kv_store(kv, r0, tid); }
    __syncthreads();
    for (int s = 0; s < nct; ++s) {
        LAS unsigned char* slot = kv + (s & 1) * 16384;
        KVRegs nx; if (s + 1 < nct) nx = kv_load(KCb, VCb, 64, (s + 1) * 64, w, lane);
        f32x16 p0, p1; qk_tile(slot, qr, p0, p1, r32, hi);
        const int dist0 = tq - 31 - 1024 * s;
        if (64 * i - 31 - 1024 * s - 16 * 63 < 113) { bias_mask<true>(p0, p1, tbh, dist0, 16, 0, 0x7fffffff, true, hi); softmax_pv(st, p0, p1, slot + 8192, wsf, lane, r32, hi); }
        else softmax_pv_fast(st, p0, p1, C2S, tbh[127], slot + 8192, wsf, lane, r32, hi);
        if (s + 1 < nct) kv_store(kv + ((s + 1) & 1) * 16384, nx, tid);
        __syncthreads();
    }
    const bool norow = tq < 31;
    float lc; { float t1; const float t0 = swap_lo(st.lsum, t1); lc = t0 + t1; }
    const float mfin = st.mhat, ilc = norow ? 0.f : __builtin_amdgcn_rcpf(lc);
    finish_rows(st, wsf, r32, hi, norow);
    unsigned ocw[16];
    { const bf16* gp = U + (tok0 + tql) * DINP + C_GN + (4 * g + (r32 & 3)) * 3;
      const float g0 = sigmoidf2(bflo((unsigned)gp[0]));
      if (hi == 0) wsf[r32] = g0;
      LDS_WAIT();
#pragma unroll
      for (int r = 0; r < 16; ++r) { const float gg = wsf[crow(r, hi)]; ocw[r] = cvtpk(st.o0[r] * gg, st.o1[r] * gg); } }
    unsigned* park = (unsigned*)(F.ws + WS_PARK) + ((size_t)blockIdx.x * NWAVES + w) * 4096 + lane;
#pragma unroll
    for (int r = 0; r < 16; ++r) park[r * 64] = ocw[r];
    __syncthreads();
    TSTAMP(0);
    { const KVRegs r0 = kv_load(KCb, VCb, 64, 0, w, lane); kv_store(kv, r0, tid); }
    __syncthreads();
    for (int s = 0; s < nct; ++s) {
        LAS unsigned char* slot = kv + (s & 1) * 16384;
        KVRegs nx; if (s + 1 < nct) nx = kv_load(KCb, VCb, 64, (s + 1) * 64, w, lane);
        f32x16 p0, p1; qk_tile(slot, qr, p0, p1, r32, hi);
        const int dist0 = tq - 31 - 1024 * s;
        if (64 * i - 31 - 1024 * s - 16 * 63 < 113) { bias_mask<true>(p0, p1, tbh, dist0, 16, 0, 0x7fffffff, true, hi);
#pragma unroll
            for (int r = 0; r < 16; ++r) { p0[r] = __builtin_amdgcn_exp2f(p0[r] - mfin) * ilc; p1[r] = __builtin_amdgcn_exp2f(p1[r] - mfin) * ilc; } }
        else { const float nb = tbh[127] - mfin;
#pragma unroll
            for (int r = 0; r < 16; ++r) { p0[r] = __builtin_amdgcn_exp2f(__builtin_fmaf(p0[r], C2S, nb)) * ilc; p1[r] = __builtin_amdgcn_exp2f(__builtin_fmaf(p1[r], C2S, nb)) * ilc; } }
        LAS float* irow = imp + tql * IMP_LD + 16 * s + hi;
#pragma unroll
        for (int A = 0; A < 8; ++A) { const f32x16& p = (A < 4) ? p0 : p1; const int a = A & 3;
            float own = p[4 * a] + p[4 * a + 1] + p[4 * a + 2] + 0.5f * p[4 * a + 3], car = 0.5f * p[4 * a + 3];
            own += __shfl_xor(own, 1); own += __shfl_xor(own, 2); car += __shfl_xor(car, 1); car += __shfl_xor(car, 2);
            if ((r32 & 3) == 0) { irow[2 * A] = own; irow[64 * IMP_LD + 2 * A + 1] = car; } }
        if (s + 1 < nct) kv_store(kv + ((s + 1) & 1) * 16384, nx, tid);
        __syncthreads();
    }
    TSTAMP(1);
    {
        const int tl = 8 * w + (lane >> 3), slot8 = lane & 7; const int cur = i;
        unsigned m0 = 0u, m1 = 0u, m2 = 0u, m3 = 0u;
        if (cur < 16) { m0 = (cur == 31) ? 0xffffffffu : ((1u << (cur + 1)) - 1u); }
        else {
            unsigned key[16];
#pragma unroll
            for (int k = 0; k < 16; ++k) { const int n = slot8 + 8 * k; const float v = (n >= 1 && n <= cur - 2) ? imp[tl * IMP_LD + n] + imp[64 * IMP_LD + tl * IMP_LD + n] : 0.f;
                key[k] = (n >= 1 && n <= cur - 2) ? ((__float_as_uint(v) & ~127u) | (unsigned)(127 - n)) : 0u; }
            for (int it = 0; it < 13; ++it) {
                unsigned mx = key[0];
#pragma unroll
                for (int k = 1; k < 16; ++k) mx = max(mx, key[k]);
                mx = max(mx, (unsigned)__shfl_xor((int)mx, 1)); mx = max(mx, (unsigned)__shfl_xor((int)mx, 2)); mx = max(mx, (unsigned)__shfl_xor((int)mx, 4));
                const int nsel = 127 - (int)(mx & 127u);
#pragma unroll
                for (int k = 0; k < 16; ++k) key[k] = (key[k] == mx) ? 0u : key[k];
                const unsigned bit = 1u << (nsel & 31); const int wd = nsel >> 5;
                m0 |= (wd == 0) ? bit : 0u; m1 |= (wd == 1) ? bit : 0u; m2 |= (wd == 2) ? bit : 0u; m3 |= (wd == 3) ? bit : 0u;
            }
            m0 |= 1u;
            { const int n1 = cur - 1, n2 = cur; const unsigned b1 = 1u << (n1 & 31), b2 = 1u << (n2 & 31);
              m0 |= ((n1 >> 5) == 0 ? b1 : 0u) | ((n2 >> 5) == 0 ? b2 : 0u); m1 |= ((n1 >> 5) == 1 ? b1 : 0u) | ((n2 >> 5) == 1 ? b2 : 0u);
              m2 |= ((n1 >> 5) == 2 ? b1 : 0u) | ((n2 >> 5) == 2 ? b2 : 0u); m3 |= ((n1 >> 5) == 3 ? b1 : 0u) | ((n2 >> 5) == 3 ? b2 : 0u); }
        }
        if (slot8 == 0) { selm[tl * 4 + 0] = m0; selm[tl * 4 + 1] = m1; selm[tl * 4 + 2] = m2; selm[tl * 4 + 3] = m3; }
    }
    LDS_WAIT();
    __syncthreads();
    TSTAMP(2);
    const bool sparse = i >= 16;
    LAS float* mrefs = (LAS float*)(F.lds + L_MREF); LAS bf16* mail = (LAS bf16*)(F.lds + L_MAIL); LAS float* maill = (LAS float*)(F.lds + L_MAILL); LAS unsigned short* wher = (LAS unsigned short*)(F.lds + L_WHERE);
    LAS int* cnt = (LAS int*)(F.lds + L_CNT); LAS int* off = cnt + 128; LAS unsigned short* items = (LAS unsigned short*)(F.lds + L_ITEMS);
    LAS unsigned char* tokl = F.lds + L_TOKL;
    LAS unsigned* rtab = (LAS unsigned*)(F.lds + L_RTAB);
    if (sparse) {
        if (tid < 128 && (tid < 1 || tid > i - 2)) cnt[tid] = 0;
        if (tid < 256) wher[tid] = 0xffffu;
        for (int p = tid; p < 2048; p += NWAVES * 64) { const int row = p >> 3, ch = p & 7;
            *(LAS v4u*)(F.lds + L_Q2 + row * 128 + ((ch ^ (row & 7)) << 4)) = *(const v4u*)(U + (tok0 + (row >> 2)) * DINP + C_QN + (4 * g + (row & 3)) * 64 + ch * 8); }
        { const v4u mw = *(const LAS v4u*)(selm + lane * 4);
          for (int n = (w == 0 ? 8 : w); n <= i - 2; n += NWAVES) { const int wd = n >> 5; const unsigned word = wd == 0 ? mw.x : wd == 1 ? mw.y : wd == 2 ? mw.z : mw.w;
              const bool bit = (word >> (n & 31)) & 1u; const unsigned long long bm = __ballot(bit);
              const unsigned rank = __builtin_amdgcn_mbcnt_hi((unsigned)(bm >> 32), __builtin_amdgcn_mbcnt_lo((unsigned)bm, 0u));
              if (bit) tokl[n * 64 + rank] = (unsigned char)lane;
              if (lane == 0) cnt[n] = __popcll(bm); }
        }
        __syncthreads();
        if (w == 0) {
            const int tl0 = (cnt[lane] + 7) >> 3, tl1 = (cnt[64 + lane] + 7) >> 3;
            int nr = 0, n = 1;
            while (n <= i - 2) { int nb = 0, tl = 0; unsigned ent = (unsigned)n;
                while (n <= i - 2 && nb < 4) { const int nn = __builtin_amdgcn_readfirstlane(n); const int tn = nn < 64 ? __builtin_amdgcn_readlane(tl0, nn) : __builtin_amdgcn_readlane(tl1, nn - 64);
                    if (nb > 0 && tl + tn > 8) break; tl += tn; ent |= (unsigned)tn << (12 + 4 * nb); ++nb; ++n; }
                ent |= (unsigned)nb << 8; if (lane == 0) rtab[nr] = ent; ++nr; }
            if (lane == 0) off[128] = nr; }
    }
    TSTAMP(3);
    const bf16* Kb = U + (size_t)b * SEQ * DINP + C_KS + g * 64; const bf16* Vb = U + (size_t)b * SEQ * DINP + C_VS + g * 64;
    st.mhat = NEGBIG; st.lsum = 0.f; st.o0 = (f32x16){}; st.o1 = (f32x16){};
    const int nd = sparse ? 3 : i + 1;
    load_q(qr, U, tok0, g, w, r32, hi);
    { const KVRegs r0 = kv_load(Kb, Vb, DINP, 0, w, lane); kv_store(kv, r0, tid); }
    __syncthreads();
    for (int sdx = 0; sdx < nd; ++sdx) {
        const int n = sparse ? (sdx == 0 ? 0 : i - 2 + sdx) : sdx;
        LAS unsigned char* slot = kv + (sdx & 1) * 16384;
        KVRegs nx; if (sdx + 1 < nd) { const int nn = sparse ? (i - 1 + sdx) : sdx + 1; nx = kv_load(Kb, Vb, DINP, nn * 64, w, lane); }
        f32x16 p0, p1; qk_tile(slot, qr, p0, p1, r32, hi);
        const int dist0 = tq - 64 * n;
        if (i - n <= 2) { bias_mask<true>(p0, p1, tbh, dist0, 1, 0, 0x7fffffff, true, hi); softmax_pv(st, p0, p1, slot + 8192, wsf, lane, r32, hi); }
        else softmax_pv_fast(st, p0, p1, C2S, tbh[127], slot + 8192, wsf, lane, r32, hi);
        if (sdx + 1 < nd) kv_store(kv + ((sdx + 1) & 1) * 16384, nx, tid);
        __syncthreads();
    }
    TSTAMP(4);
    if (sparse) {
        if (hi == 0) mrefs[32 * w + r32] = st.mhat;
        __syncthreads();
        const int NR = off[128];
#ifdef PROBE_SEC
        if (unit == 127 && tid == 0) { unsigned long long* tp = (unsigned long long*)((unsigned*)F.ctl + 210000); tp[10] = NR; unsigned long long sc = 0; for (int n = 0; n < 128; ++n) sc += cnt[n]; tp[12] = sc; }
#endif
        KVRegs pf0, pf1, pf2, pf3;
        { const unsigned rr = rtab[0]; const int n0 = rr & 255, nb = (rr >> 8) & 15;
          pf0 = kv_load(Kb, Vb, DINP, 64 * n0, w, lane); if (nb > 1) pf1 = kv_load(Kb, Vb, DINP, 64 * (n0 + 1), w, lane);
          if (nb > 2) pf2 = kv_load(Kb, Vb, DINP, 64 * (n0 + 2), w, lane); if (nb > 3) pf3 = kv_load(Kb, Vb, DINP, 64 * (n0 + 3), w, lane); }
        for (int rd = 0; rd < NR; ++rd) {
            const unsigned rr = (unsigned)__builtin_amdgcn_readfirstlane((int)rtab[rd]); const int n0 = rr & 255, nb = (rr >> 8) & 15;
            const unsigned r2 = (unsigned)__builtin_amdgcn_readfirstlane((int)rtab[rd + 1]);
            TSTAMP(7);
            kv_store(F.lds + L_KV, pf0, tid); if (nb > 1) kv_store(F.lds + L_KV + 16384, pf1, tid);
            if (nb > 2) kv_store(F.lds + L_SL2, pf2, tid); if (nb > 3) kv_store(F.lds + L_SL2 + 16384, pf3, tid);
            __syncthreads();
            TSTAMP(8);
            if (rd + 1 < NR) { const int m0 = r2 & 255, mb = (r2 >> 8) & 15;
                pf0 = kv_load(Kb, Vb, DINP, 64 * m0, w, lane); if (mb > 1) pf1 = kv_load(Kb, Vb, DINP, 64 * (m0 + 1), w, lane);
                if (mb > 2) pf2 = kv_load(Kb, Vb, DINP, 64 * (m0 + 2), w, lane); if (mb > 3) pf3 = kv_load(Kb, Vb, DINP, 64 * (m0 + 3), w, lane); }
            const int t0c = (rr >> 12) & 15, t1c = (rr >> 16) & 15, t2c = (rr >> 20) & 15, t3c = (rr >> 24) & 15;
            const int tot = t0c + t1c + t2c + t3c;
            TSTAMP(9);
            if (w < tot) { const int t = w;
                int sidx, k;
                if (t < t0c) { sidx = 0; k = t; } else if (t < t0c + t1c) { sidx = 1; k = t - t0c; } else if (t < t0c + t1c + t2c) { sidx = 2; k = t - t0c - t1c; } else { sidx = 3; k = t - t0c - t1c - t2c; }
                const int n = n0 + sidx; const LAS unsigned char* slot = F.lds + (sidx < 2 ? L_KV + sidx * 16384 : L_SL2 + (sidx - 2) * 16384);
                const int cn = __builtin_amdgcn_readfirstlane(cnt[n]);
                const int sl = 8 * k + (r32 >> 2); const bool rowok = sl < cn;
                const int tokq = tokl[n * 64 + (rowok ? sl : 0)]; const int row = tokq * 4 + (r32 & 3);
                bf16x8 q2[4];
#pragma unroll
                for (int d0 = 0; d0 < 4; ++d0) q2[d0] = *(const LAS bf16x8*)(F.lds + L_Q2 + row * 128 + (((2 * d0 + hi) ^ (row & 7)) << 4));
                f32x16 p0, p1; qk_tile(slot, q2, p0, p1, r32, hi);
                const float mref = mrefs[row];
                if (n == i - 2) { bias_mask<true>(p0, p1, tbh, 64 * i + tokq - 64 * n, 1, 0, 0x7fffffff, rowok, hi);
#pragma unroll
                    for (int r = 0; r < 16; ++r) { p0[r] = __builtin_amdgcn_exp2f(fminf(p0[r] - mref, 100.f)); p1[r] = __builtin_amdgcn_exp2f(fminf(p1[r] - mref, 100.f)); } }
                else { const float sc = rowok ? C2S : 0.f, nbv = rowok ? tbh[127] - mref : NEGBIG;
#pragma unroll
                    for (int r = 0; r < 16; ++r) { p0[r] = __builtin_amdgcn_exp2f(fminf(__builtin_fmaf(p0[r], sc, nbv), 100.f)); p1[r] = __builtin_amdgcn_exp2f(fminf(__builtin_fmaf(p1[r], sc, nbv), 100.f)); } }
                { float sm = 0.f;
#pragma unroll
                  for (int r = 0; r < 16; ++r) sm += p0[r] + p1[r];
                  float t1; const float t0 = swap_lo(sm, t1);
                  if (hi == 0) { maill[32 * w + r32] = t0 + t1; if (rowok && (r32 & 3) == 0) wher[tokq * 4 + sidx] = (unsigned short)((w << 3) | (r32 >> 2)); } }
                SmState s2; s2.o0 = (f32x16){}; s2.o1 = (f32x16){};
                pv_tail(s2, p0, p1, slot + 8192, lane);
                stage_tile(mail + w * 2048, s2.o0, s2.o1, r32, hi);
            }
            TSTAMP(13);
            __syncthreads();
            TSTAMP(14);
            { v2u wv[4];
#pragma unroll
              for (int a = 0; a < 4; ++a) wv[a] = *(const LAS v2u*)(wher + (8 * w + 2 * a + hi) * 4);
              const v2u wl = *(const LAS v2u*)(wher + (8 * w + (r32 >> 2)) * 4);
#pragma unroll
              for (int a = 0; a < 4; ++a) { const unsigned vv[4] = {wv[a].x & 0xffffu, wv[a].x >> 16, wv[a].y & 0xffffu, wv[a].y >> 16};
#pragma unroll
                  for (int jj = 0; jj < 4; ++jj) { const unsigned v = vv[jj];
                      if (v != 0xffffu) { const LAS bf16* mp = mail + (v >> 3) * 2048 + (v & 7) * 256 + r32;
#pragma unroll
                          for (int e = 0; e < 4; ++e) { st.o0[4 * a + e] += bflo((unsigned)mp[e * 64]); st.o1[4 * a + e] += bflo((unsigned)mp[e * 64 + 32]); } } } }
              { const unsigned vv[4] = {wl.x & 0xffffu, wl.x >> 16, wl.y & 0xffffu, wl.y >> 16};
#pragma unroll
                for (int jj = 0; jj < 4; ++jj) { const unsigned v = vv[jj]; if (v != 0xffffu && hi == 0) st.lsum += maill[(v >> 3) * 32 + (v & 7) * 4 + (r32 & 3)]; } } }
            LDS_WAIT();
            if (lane < 32) wher[32 * w + lane] = 0xffffu;
            TSTAMP(15);
        }
    }
    TSTAMP(5);
    finish_rows(st, wsf, r32, hi, false);
    const bf16* OW = (const bf16*)(F.ws + WS_OW); bf16* MIX = (bf16*)(F.ws + WS_MIX);
    { const bf16* gp = U + (tok0 + tql) * DINP + C_GN + (4 * g + (r32 & 3)) * 3;
      const float g1 = sigmoidf2(bflo((unsigned)gp[1]));
      if (hi == 0) wsf[r32] = g1;
      LDS_WAIT();
#pragma unroll
      for (int r = 0; r < 16; ++r) { const float g1r = wsf[crow(r, hi)]; const unsigned oc = park[r * 64]; st.o0[r] = bflo(oc) + g1r * st.o0[r]; st.o1[r] = bfhi(oc) + g1r * st.o1[r]; } }
    LDS_WAIT();
    LAS bf16* stg = (LAS bf16*)(F.lds + L_IMP) + w * 2048;
    stage_tile(stg, st.o0, st.o1, r32, hi);
    LDS_WAIT();
#pragma unroll
    for (int it = 0; it < 4; ++it) { const int row = it * 8 + (lane >> 3), ch = lane & 7;
        const size_t tk = tok0 + 8 * w + (row >> 2); const int hd = 4 * g + (row & 3), col = hd * 64 + ch * 8;
        const v4u t = *(const LAS v4u*)(stg + row * 64 + ch * 8);
        const v4u ow = *(const v4u*)(OW + tk * 512 + col); const v4u zz = *(const v4u*)(U + tk * DINP + C_ZN + col);
        const float g2 = sigmoidf2(bflo((unsigned)U[tk * DINP + C_GN + hd * 3 + 2]));
        const unsigned tw[4] = {t.x, t.y, t.z, t.w}, oww[4] = {ow.x, ow.y, ow.z, ow.w}, zw[4] = {zz.x, zz.y, zz.z, zz.w}; unsigned ov[4];
#pragma unroll
        for (int e = 0; e < 4; ++e) { const float z0 = bflo(zw[e]), z1 = bfhi(zw[e]);
            const float y0 = (bflo(tw[e]) + g2 * bflo(oww[e])) * z0 * sigmoidf2(z0), y1 = (bfhi(tw[e]) + g2 * bfhi(oww[e])) * z1 * sigmoidf2(z1);
            ov[e] = cvtpk(y0, y1); }
        *(v4u*)(MIX + tk * DM + col) = (v4u){ov[0], ov[1], ov[2], ov[3]}; }
    __syncthreads();
    TSTAMP(6);
}
template <class AT> __device__ __forceinline__ void p2_phase(Frame& F, const AT& A) {
    const int gw = F.vcu * NWAVES + F.wave, NGW = F.G * NWAVES;
    build_bias_table(F, A.in[I_RELB]);
    __syncthreads();
    for (int u = F.vcu; u < BATCH * NSA_G * 128; u += F.G) window_unit(F, u);
    __syncthreads();
    for (int u = F.vcu; u < 512; u += F.G) compress_unit(F, u);
    __syncthreads();
    LAS unsigned char* wl = F.lds + RING_OFF + F.wave * 16384;
    for (int cid = gw; cid < BATCH * GLA_H * NCHUNK; cid += NGW) gla_pass_a(F, A.in[I_BA], cid, wl);
}
constexpr int CW_Q = 200000;
template <class AT> __device__ __forceinline__ void p3_phase(Frame& F, const AT& A) {
    build_bias_table(F, A.in[I_RELB]);
    const int xq = (F.vcu >> 5) & 7;
    volatile LAS unsigned* bc = F.MISC + 16;
    if (F.tid == 0) bc[0] = __hip_atomic_fetch_add(F.ctl + CW_Q + 64 * xq, 1u, RLX_AGENT);
    __syncthreads();
    { const int item = (int)bc[0];
      if (item < 4) gla_scan_unit(F, A.in[I_GNW], 4 * xq + item, (LAS float*)(F.lds + RING_OFF)); }
    __syncthreads();
    for (;;) {
        if (F.tid == 0) bc[1] = __hip_atomic_fetch_add(F.ctl + CW_Q + 64 * (8 + xq), 1u, RLX_AGENT);
        __syncthreads();
        const int k = (int)bc[1];
        __syncthreads();
        if (k >= 256) break;
        nsa_unit(F, (2 * xq + (k & 1)) * 128 + 127 - (k >> 1));
    }
}
constexpr int N_LAUNCHES = MK_N_LAUNCHES;
constexpr int PER_PHASE = 7;
struct Args { const float* in[22]; float* out; unsigned char* ws; int ph_lo, ph_hi, li, pad; };
__global__ void __launch_bounds__(NWAVES * 64, 2) hymba_fwd(Args args) {
    extern __shared__ __attribute__((aligned(16))) unsigned char lds[];
    Frame F;
    F.lds = (LAS unsigned char*)lds;
    F.MISC = (volatile LAS unsigned*)(F.lds + MISC_OFF);
    F.tid = threadIdx.x; F.lane = F.tid & 63; F.wave = __builtin_amdgcn_readfirstlane(F.tid >> 6);
    F.G = gridDim.x; { const int bx = blockIdx.x; F.vcu = (F.G % 8 == 0) ? (bx % 8) * (F.G / 8) + bx / 8 : bx; }
    unsigned char* ws = args.ws; F.ws = ws; F.out = args.out;
    F.ctl = (gu32*)(ws + WS_CTL);
    for (int u = F.tid; u < (LDS_BYTES - LDSCTL_OFF) / 4; u += NWAVES * 64) ((LAS unsigned*)(F.lds + LDSCTL_OFF))[u] = 0u;
    __syncthreads();
    XcdBarrier bar; bar.bar = (unsigned*)(F.ctl + CW_BAR) + args.li * XCD_BAR_WORDS; bar.x = 0; bar.st = nullptr;
    if (N_LAUNCHES != PER_PHASE) bar = xcd_barrier_post((unsigned*)(F.ctl + CW_BAR) + args.li * XCD_BAR_WORDS, F.MISC + 8);
#define GRID_BAR() do { if (N_LAUNCHES != PER_PHASE) xcd_barrier(bar); } while (0)
    const int lo = args.ph_lo, hi = args.ph_hi;
#define IN(k) (lo <= (k) && (k) < hi)
#define REFRESH() do { int t_ = threadIdx.x; asm volatile("" : "+v"(t_)); F.tid = t_; F.lane = t_ & 63; } while (0)
#define BOTH(k) (IN(k) && IN((k) + 1))

    if (IN(0)) { REFRESH(); p0_prologue(F, args); if (BOTH(0)) GRID_BAR(); }
    if (IN(1)) { REFRESH();
        pg8::Gemm g{(const pg8::bf16_t*)(ws + WS_XN), (const pg8::bf16_t*)(ws + WS_WIN), M, DINP, DM}; pg8::StaticOrder S; S.init(M, DINP, F.G, (int)blockIdx.x);
        pg8::EpiBf16 E{(pg8::bf16_t*)(ws + WS_U), DINP};
        pg8::gemm_phase<pg8::EpiBf16, pg8::StaticOrder, true, true>(F.lds + RING_OFF, g, S, E);
        if (BOTH(1)) GRID_BAR();
    }
    if (IN(2)) { REFRESH();
        p2_phase(F, args);
        if (BOTH(2)) GRID_BAR();
    }
    if (IN(3)) { REFRESH();
        p3_phase(F, args);
        if (BOTH(3)) GRID_BAR();
    }
    if (IN(4)) { REFRESH();
        { pg8::Gemm g{(const pg8::bf16_t*)(ws + WS_MIX), (const pg8::bf16_t*)(ws + WS_WOUT), M, DM, DM}; pg8::StaticOrder S; S.init(M, DM, F.G, (int)blockIdx.x);
          pg8::EpiResid E{args.in[I_X], (const float*)(ws + WS_STATS), args.in[I_LN0G], args.in[I_LN0B], F.out, (pg8::bf16_t*)(ws + WS_RB), ALPHA_};
          pg8::gemm_phase<pg8::EpiResid, pg8::StaticOrder, true, true>(F.lds + RING_OFF, g, S, E); }
        { pg8::Gemm g{(const pg8::bf16_t*)(ws + WS_PB), (const pg8::bf16_t*)(ws + WS_WPE), M, DM, PLE}; pg8::StaticOrder S; S.init(M, DM, F.G, (int)blockIdx.x);
          pg8::EpiBf16 E{(pg8::bf16_t*)(ws + WS_EB), DM};
          pg8::gemm_phase<pg8::EpiBf16, pg8::StaticOrder, true, true>(F.lds + RING_OFF, g, S, E); }
        if (BOTH(4)) GRID_BAR();
    }
    if (IN(5)) { REFRESH();
        pg8::Gemm g{(const pg8::bf16_t*)(ws + WS_RB), (const pg8::bf16_t*)(ws + WS_WPG), M, DM, DM}; pg8::StaticOrder S; S.init(M, DM, F.G, (int)blockIdx.x);
        pg8::EpiGate E{F.out, (const pg8::bf16_t*)(ws + WS_EB), args.in[I_BPG]};
        pg8::gemm_phase<pg8::EpiGate, pg8::StaticOrder, true, true>(F.lds + RING_OFF, g, S, E);
        if (BOTH(5)) GRID_BAR();
    }
    if (IN(6)) { REFRESH(); final_ln(F, args.in[I_LNG], args.in[I_LNB]); }
#ifdef PROBE_SEC
    if (blockIdx.x == 0 && threadIdx.x == 0) { __threadfence(); const unsigned long long* tp = (const unsigned long long*)((unsigned*)F.ctl + 210000); { float xv = (float)((PROBE_SEC >= 10 && PROBE_SEC <= 12) ? tp[PROBE_SEC] : tp[PROBE_SEC] / 1000ull); if (!(PROBE_SEC >= 10 && PROBE_SEC <= 12)) xv = exp2f(rintf(2.0f * log2f(xv + 1.0f)) * 0.5f); F.out[0] = xv; } }
#endif
#undef IN
#undef BOTH
}

extern "C" void kernel_launch(void* const* d_in, const int* in_sizes, int n_in, void* d_out, int out_size, void* d_ws, size_t ws_size, hipStream_t stream) {
    static int grid = 0;
    if (grid == 0) {
        if (n_in != 22 || out_size != M * DM || ws_size < WS_END) { fprintf(stderr, "kernel_launch: unexpected shapes (n_in %d out %d ws %zu)\n", n_in, out_size, ws_size); grid = -1; return; }
        int dev = 0, cus = 0, per_cu = 0;
        if (hipGetDevice(&dev) != hipSuccess || hipDeviceGetAttribute(&cus, hipDeviceAttributeMultiprocessorCount, dev) != hipSuccess) { grid = -1; return; }
        if (hipFuncSetAttribute((const void*)hymba_fwd, hipFuncAttributeMaxDynamicSharedMemorySize, LDS_BYTES) != hipSuccess) { fprintf(stderr, "kernel_launch: hipFuncSetAttribute failed\n"); grid = -1; return; }
        if (hipOccupancyMaxActiveBlocksPerMultiprocessor(&per_cu, (const void*)hymba_fwd, NWAVES * 64, LDS_BYTES) != hipSuccess || per_cu < 1)
            fprintf(stderr, "kernel_launch: occupancy query reports %d workgroups per CU\n", per_cu);
        (void)hipGetLastError();
        grid = cus;
    }
    if (grid < 0) return;
    (void)hipMemsetAsync((char*)d_ws + WS_CTL, 0, CTL_ZERO_BYTES, stream);
    Args a{};
    for (int i = 0; i < 22; ++i) a.in[i] = (const float*)d_in[i];
    a.out = (float*)d_out; a.ws = (unsigned char*)d_ws;
#ifdef PROBE_SEQ
    { const int seq[][2] = PROBE_SEQ; const int nseq = (int)(sizeof(seq) / sizeof(seq[0]));
      for (int li = 0; li < nseq; ++li) { a.ph_lo = seq[li][0]; a.ph_hi = seq[li][1]; a.li = li; hipLaunchKernelGGL(hymba_fwd, dim3(grid), dim3(NWAVES * 64), LDS_BYTES, stream, a); } }
#else
    if (N_LAUNCHES == 1) { a.ph_lo = 0; a.ph_hi = PER_PHASE; a.li = 0; hipLaunchKernelGGL(hymba_fwd, dim3(grid), dim3(NWAVES * 64), LDS_BYTES, stream, a); }
    else for (int li = 0; li < PER_PHASE; ++li) { a.ph_lo = li; a.ph_hi = li + 1; a.li = 0; hipLaunchKernelGGL(hymba_fwd, dim3(grid), dim3(NWAVES * 64), LDS_BYTES, stream, a); }
#endif
}
```
